# Optimizing an MI355X kernel written in HIP

```python
import jax, jax.numpy as jnp
from jax import lax
import numpy as np

D_MODEL = 1024
BATCH = 4
SEQ = 4096
DEPTH = 1

CHUNK = 64
RET_HEADS = 4
RET_QK_DIM = 128
RET_V_DIM = 256
RET_QK = RET_HEADS * RET_QK_DIM
RET_V = RET_HEADS * RET_V_DIM
CONV_WIDTH = D_MODEL
CONV_K = 3
D_FF = 4 * D_MODEL
N_MOD = 6
ROPE_BASE = 10000.0
EPS = 1e-6
SPLITS = (RET_QK, RET_QK, RET_V, RET_V, CONV_WIDTH, CONV_WIDTH, CONV_WIDTH, D_MODEL, D_MODEL)
IN_WIDTH = sum(SPLITS)

kernel_name = "hybrid_retention_shortconv_block"


def _rmsnorm(t, w):
    tf = t.astype(jnp.float32)
    y = tf * lax.rsqrt(jnp.mean(tf * tf, axis=-1, keepdims=True) + EPS)
    return (y * w.astype(jnp.float32)).astype(t.dtype)


def _rotary(t, positions):
    d = t.shape[-1]
    inv_freq = ROPE_BASE ** (-jnp.arange(0, d, 2, dtype=jnp.float32) / d)
    ang = positions.astype(jnp.float32)[..., None] * inv_freq
    cos = jnp.cos(ang)[:, :, None, :]
    sin = jnp.sin(ang)[:, :, None, :]
    t1, t2 = t[..., : d // 2], t[..., d // 2:]
    return jnp.concatenate([t1 * cos - t2 * sin, t1 * sin + t2 * cos], axis=-1)


def _retention(q, k, v):
    B, S, H, dk = q.shape
    dv = v.shape[-1]
    nc = S // CHUNK
    log_g = jnp.log1p(-jnp.exp2(-5.0 - jnp.arange(H, dtype=jnp.float32)))
    idx = jnp.arange(CHUNK, dtype=jnp.float32)
    intra_dec = jnp.exp(jnp.abs(idx[:, None] - idx[None, :])[None] * log_g[:, None, None])
    q_dec = jnp.exp((idx + 1.0)[:, None] * log_g[None, :])
    k_dec = jnp.exp((CHUNK - 1.0 - idx)[:, None] * log_g[None, :])
    chunk_dec = jnp.exp(CHUNK * log_g)

    qc = q.reshape(B, nc, CHUNK, H, dk)
    kc = k.reshape(B, nc, CHUNK, H, dk)
    vc = v.reshape(B, nc, CHUNK, H, dv)

    scores = jnp.einsum('bnchd,bnshd->bnhcs', qc, kc) * intra_dec
    o_intra = jnp.einsum('bnhcs,bnshv->bnchv', scores, vc)

    def step(state, inp):
        qi, ki, vi = inp
        o = jnp.einsum('bchk,bhkv->bchv', qi * q_dec[None, :, :, None], state)
        state = chunk_dec[None, :, None, None] * state + jnp.einsum(
            'bchk,bchv->bhkv', ki * k_dec[None, :, :, None], vi)
        return state, o

    xs = (jnp.moveaxis(qc, 1, 0), jnp.moveaxis(kc, 1, 0), jnp.moveaxis(vc, 1, 0))
    s0 = jnp.zeros((B, H, dk, dv), jnp.float32)
    _, o_cross = lax.scan(step, s0, xs)
    o = o_intra + jnp.moveaxis(o_cross, 0, 1)
    return o.reshape(B, S, H, dv)


def _head_groupnorm(o, w):
    mu = jnp.mean(o, axis=-1, keepdims=True)
    var = jnp.mean(jnp.square(o - mu), axis=-1, keepdims=True)
    y = (o - mu) * lax.rsqrt(var + EPS)
    B, S = o.shape[0], o.shape[1]
    return y.reshape(B, S, -1) * w.astype(jnp.float32)


def _causal_conv(z, w):
    S = z.shape[1]
    zp = jnp.pad(z, ((0, 0), (CONV_K - 1, 0), (0, 0)))
    out = zp[:, 0:S] * w[0]
    for j in range(1, CONV_K):
        out = out + zp[:, j:j + S] * w[j]
    return out


def setup_inputs(seed: int = 0) -> dict:
    key = jax.random.key(seed)
    ks = jax.random.split(key, 18)
    f32 = jnp.float32
    nrm = lambda k, shape, s: jax.random.normal(k, shape, f32) * s
    x = jax.random.normal(ks[0], (BATCH, SEQ, D_MODEL), f32)
    c = jax.random.normal(ks[1], (BATCH, D_MODEL), f32)
    positions = jnp.broadcast_to(jnp.arange(SEQ, dtype=jnp.int32)[None, :], (BATCH, SEQ))
    return {
        "x": x,
        "c": c,
        "positions": positions,
        "w_ada": nrm(ks[2], (DEPTH, D_MODEL, N_MOD * D_MODEL), 0.5 * D_MODEL ** -0.5),
        "b_ada": nrm(ks[3], (DEPTH, N_MOD * D_MODEL), 0.01),
        "norm1_w": 1.0 + nrm(ks[4], (DEPTH, D_MODEL), 0.02),
        "w_in": nrm(ks[5], (DEPTH, D_MODEL, IN_WIDTH), D_MODEL ** -0.5),
        "ret_gn_w": 1.0 + nrm(ks[6], (DEPTH, RET_V), 0.02),
        "conv_w": nrm(ks[7], (DEPTH, CONV_K, CONV_WIDTH), CONV_K ** -0.5),
        "w_ret_out": nrm(ks[8], (DEPTH, RET_V, D_MODEL), RET_V ** -0.5),
        "w_conv_out": nrm(ks[9], (DEPTH, CONV_WIDTH, D_MODEL), CONV_WIDTH ** -0.5),
        "w_o": nrm(ks[10], (DEPTH, D_MODEL, D_MODEL), D_MODEL ** -0.5),
        "norm2_w": 1.0 + nrm(ks[11], (DEPTH, D_MODEL), 0.02),
        "w_ff1": nrm(ks[12], (DEPTH, D_MODEL, D_FF), D_MODEL ** -0.5),
        "w_ff2": nrm(ks[13], (DEPTH, D_FF, D_MODEL), D_FF ** -0.5),
        "final_norm_w": 1.0 + nrm(ks[14], (D_MODEL,), 0.02),
    }


def reference(x, c, positions, w_ada, b_ada, norm1_w, w_in, ret_gn_w, conv_w,
              w_ret_out, w_conv_out, w_o, norm2_w, w_ff1, w_ff2, final_norm_w):
    B, S, _ = x.shape
    split_points = [int(i) for i in np.cumsum(SPLITS)[:-1]]
    h = x
    for l in range(DEPTH):
        mod = jnp.einsum('bd,de->be', jax.nn.silu(c), w_ada[l]) + b_ada[l]
        sh1, sc1, g1, sh2, sc2, g2 = jnp.split(mod[:, None, :], N_MOD, axis=-1)

        u = _rmsnorm(h, norm1_w[l]) * (1.0 + sc1) + sh1
        proj = jnp.einsum('bsd,de->bse', u, w_in[l])
        q, k, v, og, cb, cc, cx, ga, gb = jnp.split(proj, split_points, axis=-1)

        qh = _rotary(q.astype(jnp.float32).reshape(B, S, RET_HEADS, RET_QK_DIM), positions)
        kh = _rotary(k.astype(jnp.float32).reshape(B, S, RET_HEADS, RET_QK_DIM), positions) * (RET_QK_DIM ** -0.5)
        vh = v.astype(jnp.float32).reshape(B, S, RET_HEADS, RET_V_DIM)
        ret = _head_groupnorm(_retention(qh, kh, vh), ret_gn_w[l]).astype(x.dtype)
        y_ret = jnp.einsum('bse,ed->bsd', jax.nn.silu(og) * ret, w_ret_out[l])

        y_conv = jnp.einsum('bse,ed->bsd', cb * _causal_conv(cc * cx, conv_w[l]), w_conv_out[l])

        merged = jax.nn.sigmoid(ga) * y_ret + jax.nn.sigmoid(gb) * y_conv
        h = h + g1 * jnp.einsum('bsd,de->bse', merged, w_o[l])

        u2 = _rmsnorm(h, norm2_w[l]) * (1.0 + sc2) + sh2
        hid = jnp.square(jax.nn.relu(jnp.einsum('bsd,df->bsf', u2, w_ff1[l])))
        h = h + g2 * jnp.einsum('bsf,fd->bsd', hid, w_ff2[l])
    return _rmsnorm(h, final_norm_w)
```

```cpp
#include <hip/hip_runtime.h>
#include <cstdio>
#include <cstdint>
namespace pg8 {
#define PG8_LAS __attribute__((address_space(3)))
typedef unsigned short bf16_t;
typedef short bf16x8 __attribute__((ext_vector_type(8)));
typedef float f32x4 __attribute__((ext_vector_type(4)));
typedef unsigned u32x4 __attribute__((ext_vector_type(4)));
constexpr int BM = 256, BK = 64, HALF = 128, HTB = HALF * BK * 2  , STAGE_BYTES = 8 * HTB, NXCD = 8, WGM = 8;

__host__ __device__ __forceinline__ int lds_byte(int r, int c) { const int st = (r >> 4) * 2 + (c >> 5), rr = r & 15, cc = c & 31, ob = rr * 64 + cc * 2; return st * 1024 + (ob ^ (((ob >> 9) & 1) << 5)); }
__host__ __device__ __forceinline__ void stage_rc(int b, int& R, int& C) { const int st = b / 1024, sb = b % 1024, swz = sb ^ (((sb >> 9) & 1) << 5); R = (st >> 1) * 16 + swz / 64; C = (st & 1) * 32 + (swz % 64) / 2; }
__host__ __device__ __forceinline__ int perm32(int rho) { const int n = rho >> 4, i = rho & 15; return 8 * (i >> 2) + 4 * n + (i & 3); }

struct Unit { int pm, pn; };
struct Gemm { const bf16_t* A; const bf16_t* Bt; int M, N, K; };

struct StaticOrder {
    int nM, nN, nwg, G, c;
    __host__ __device__ void init(int M, int N, int G_, int c_) { nM = M / BM; nN = N / BM; nwg = nM * nN; G = G_; c = c_; }
    __host__ __device__ bool next(int i, Unit& u) const {
        const long L = (long)i * G + c; if (L >= nwg) return false;
        int wgid = (int)L; { const int q = nwg / NXCD, r = nwg % NXCD, xcd = wgid % NXCD, off = wgid / NXCD; wgid = (xcd < r ? xcd * (q + 1) : r * (q + 1) + (xcd - r) * q) + off; }
        const int nig = WGM * nN, gid = wgid / nig, fm = gid * WGM, gsz = (nM - fm) < WGM ? (nM - fm) : WGM;
        u.pm = fm + ((wgid % nig) % gsz); u.pn = (wgid % nig) / gsz; return true;
    }
    __device__ __forceinline__ void a_ready(const Unit&) const {}
    __device__ __forceinline__ void done(const Unit&) const {}
};

__device__ __forceinline__ unsigned cvt_pk_bf16(float lo, float hi) { unsigned r; asm volatile("v_cvt_pk_bf16_f32 %0, %1, %2" : "=v"(r) : "v"(lo), "v"(hi)); return r; }
typedef float f32x2 __attribute__((ext_vector_type(2)));
__device__ __forceinline__ int lane_id_v() { int l; asm volatile("v_mbcnt_lo_u32_b32 %0, -1, 0\n\tv_mbcnt_hi_u32_b32 %0, -1, %0" : "=v"(l)); return l; }
typedef unsigned u32x2 __attribute__((ext_vector_type(2)));
__device__ __forceinline__ unsigned cvtpk(float lo, float hi) { typedef float f2_t __attribute__((ext_vector_type(2))); typedef __bf16 b2_t __attribute__((ext_vector_type(2))); f2_t v = {lo, hi}; b2_t b = __builtin_convertvector(v, b2_t); return __builtin_bit_cast(unsigned, b); }
__device__ __forceinline__ float bflo(unsigned w) { return __builtin_bit_cast(float, w << 16); }
__device__ __forceinline__ float bfhi(unsigned w) { return __builtin_bit_cast(float, w & 0xffff0000u); }
__device__ __forceinline__ float fast_rcp(float x) { return __builtin_amdgcn_rcpf(x); }
__device__ __forceinline__ float sigmoidf_(float x) { return fast_rcp(1.0f + __expf(-x)); }
__device__ __forceinline__ void sincos_rev(float ang, float& s, float& c) {
    const float I2P = 0.15915493667125702f, I2P_LO = 6.420638326565253e-09f;
    const float r = ang * I2P; float e = __builtin_fmaf(ang, I2P, -r); e = __builtin_fmaf(ang, I2P_LO, e);
    const float k = __builtin_rintf(r); const float f = (r - k) + e;
    s = __builtin_amdgcn_sinf(f); c = __builtin_amdgcn_cosf(f);
}
__device__ __forceinline__ u32x4 pack8(const f32x4 a, const f32x4 b) { u32x4 w; w.x = cvtpk(a[0], a[1]); w.y = cvtpk(a[2], a[3]); w.z = cvtpk(b[0], b[1]); w.w = cvtpk(b[2], b[3]); return w; }

struct EpiProj {
    static constexpr bool PERM = true, AFTER_DRAIN = false, HAS_MID = false;
    bf16_t* QK; bf16_t* V; bf16_t* OGCB; bf16_t* Z; bf16_t* GATES; const int* pos;
    __device__ __forceinline__ void mid(f32x4 (&)[2][2][4][2], const Unit&, int, int, int, int) const {}
    __device__ __forceinline__ void operator()(const f32x4 (&acc)[2][2][4][2], const Unit& u, int wr, int wc, int fr, int fq) const {
        const int row0 = u.pm * BM + wr * 64 + fr, cw = wc * 32 + 8 * fq, pn = u.pn;
        if (pn < 4) {
            const float ksc = pn >= 2 ? 0.08838834764831845f : 1.0f;
            const int g = 4 * wc + fq; float invf[4];
#pragma unroll
            for (int i = 0; i < 4; ++i) invf[i] = exp2f(-(float)(4 * g + i) * (13.287712379549449f / 64.0f));
#pragma unroll
            for (int ai = 0; ai < 2; ++ai)
#pragma unroll
                for (int m = 0; m < 4; ++m) { const int row = row0 + ai * HALF + m * 16; const float p = (float)pos[row];
                    f32x4 cs, sn;
#pragma unroll
                    for (int i = 0; i < 4; ++i) { float s_, c_; sincos_rev(p * invf[i], s_, c_); cs[i] = c_ * ksc; sn[i] = s_ * ksc; }
                    bf16_t* rowp = QK + (size_t)row * 1024 + pn * 256 + cw;
#pragma unroll
                    for (int bj = 0; bj < 2; ++bj) { const f32x4 x1 = acc[ai][bj][m][0], x2 = acc[ai][bj][m][1];
                        const f32x4 o1 = x1 * cs - x2 * sn, o2 = x1 * sn + x2 * cs;
                        *(u32x4*)(rowp + bj * HALF) = pack8(o1, o2); } }
        } else if (pn >= 16 && pn < 24) {
#pragma unroll
            for (int ai = 0; ai < 2; ++ai)
#pragma unroll
                for (int m = 0; m < 4; ++m) { const int row = row0 + ai * HALF + m * 16; bf16_t* rowp = Z + (size_t)row * 1024 + (((pn - 16) * 256 + cw) >> 1);
#pragma unroll
                    for (int bj = 0; bj < 2; ++bj) { const f32x4 z = acc[ai][bj][m][0] * acc[ai][bj][m][1]; u32x2 w; w.x = cvtpk(z[0], z[1]); w.y = cvtpk(z[2], z[3]);
                        *(u32x2*)(rowp + bj * (HALF / 2)) = w; } }
        } else {
            bf16_t* base; int ld, mode;
            if (pn < 8) { base = V + (pn - 4) * 256; ld = 1024; mode = 0; }
            else if (pn < 12) { base = OGCB + (pn - 8) * 256; ld = 2048; mode = 1; }
            else if (pn < 16) { base = OGCB + 1024 + (pn - 12) * 256; ld = 2048; mode = 0; }
            else { base = GATES + (pn - 24) * 256; ld = 2048; mode = 2; }
#pragma unroll
            for (int ai = 0; ai < 2; ++ai)
#pragma unroll
                for (int m = 0; m < 4; ++m) { const int row = row0 + ai * HALF + m * 16; bf16_t* rowp = base + (size_t)row * ld + cw;
#pragma unroll
                    for (int bj = 0; bj < 2; ++bj) { f32x4 v0 = acc[ai][bj][m][0], v1 = acc[ai][bj][m][1];
                        if (mode != 0) {
#pragma unroll
                            for (int i = 0; i < 4; ++i) { const float s0 = sigmoidf_(v0[i]), s1 = sigmoidf_(v1[i]); v0[i] = mode == 1 ? v0[i] * s0 : s0; v1[i] = mode == 1 ? v1[i] * s1 : s1; } }
                        *(u32x4*)(rowp + bj * HALF) = pack8(v0, v1); } }
        }
    }
};

struct EpiMerge {
    static constexpr bool PERM = true, AFTER_DRAIN = false, HAS_MID = true;
    const bf16_t* GATES; bf16_t* MERGED;
    __device__ __forceinline__ void mid(f32x4 (&acc)[2][2][4][2], const Unit& u, int wr, int wc, int fr, int fq) const {
        const int row0 = u.pm * BM + wr * 64 + fr, col0 = u.pn * BM + wc * 32 + 8 * fq;
#pragma unroll
        for (int ai = 0; ai < 2; ++ai)
#pragma unroll
            for (int m = 0; m < 4; ++m) { const bf16_t* rowp = GATES + (size_t)(row0 + ai * HALF + m * 16) * 2048 + col0;
#pragma unroll
                for (int bj = 0; bj < 2; ++bj) { const u32x4 ga = *(const u32x4*)(rowp + bj * HALF), gb = *(const u32x4*)(rowp + 1024 + bj * HALF);
#pragma unroll
                    for (int j = 0; j < 4; ++j) { const float a0 = bflo(ga[j]), a1 = bfhi(ga[j]); const float b0 = fmaxf(bflo(gb[j]), 1e-30f), b1 = fmaxf(bfhi(gb[j]), 1e-30f);
                        acc[ai][bj][m][j >> 1][2 * (j & 1)] *= a0 * fast_rcp(b0); acc[ai][bj][m][j >> 1][2 * (j & 1) + 1] *= a1 * fast_rcp(b1); } } }
    }
    __device__ __forceinline__ void operator()(const f32x4 (&acc)[2][2][4][2], const Unit& u, int wr, int wc, int fr, int fq) const {
        const int row0 = u.pm * BM + wr * 64 + fr, col0 = u.pn * BM + wc * 32 + 8 * fq;
#pragma unroll
        for (int ai = 0; ai < 2; ++ai)
#pragma unroll
            for (int m = 0; m < 4; ++m) { const int row = row0 + ai * HALF + m * 16; const bf16_t* gp = GATES + (size_t)row * 2048 + 1024 + col0; bf16_t* op = MERGED + (size_t)row * 1024 + col0;
#pragma unroll
                for (int bj = 0; bj < 2; ++bj) { const u32x4 gb = *(const u32x4*)(gp + bj * HALF); f32x4 v0 = acc[ai][bj][m][0], v1 = acc[ai][bj][m][1];
                    v0[0] *= fmaxf(bflo(gb[0]), 1e-30f); v0[1] *= fmaxf(bfhi(gb[0]), 1e-30f); v0[2] *= fmaxf(bflo(gb[1]), 1e-30f); v0[3] *= fmaxf(bfhi(gb[1]), 1e-30f);
                    v1[0] *= fmaxf(bflo(gb[2]), 1e-30f); v1[1] *= fmaxf(bfhi(gb[2]), 1e-30f); v1[2] *= fmaxf(bflo(gb[3]), 1e-30f); v1[3] *= fmaxf(bfhi(gb[3]), 1e-30f);
                    *(u32x4*)(op + bj * HALF) = pack8(v0, v1); } }
    }
};

struct EpiRes1 {
    static constexpr bool PERM = true, AFTER_DRAIN = false, HAS_MID = false;
    const float* x; float* h1; bf16_t* hhat; const float* modf; const float* norm2w; float* ssq;
    __device__ __forceinline__ void mid(f32x4 (&)[2][2][4][2], const Unit&, int, int, int, int) const {}
    __device__ __forceinline__ void operator()(const f32x4 (&acc)[2][2][4][2], const Unit& u, int wr, int wc, int fr, int fq) const {
        const int row0 = u.pm * BM + wr * 64 + fr, col0 = u.pn * BM + wc * 32 + 8 * fq, b = u.pm >> 4;
        f32x4 g1[2][2], cs[2][2];
#pragma unroll
        for (int bj = 0; bj < 2; ++bj)
#pragma unroll
            for (int n = 0; n < 2; ++n) { const int c = col0 + bj * HALF + 4 * n; g1[bj][n] = *(const f32x4*)(modf + b * 6144 + 2048 + c);
                const f32x4 sc = *(const f32x4*)(modf + b * 6144 + 4096 + c), w = *(const f32x4*)(norm2w + c); cs[bj][n] = w * (sc + 1.0f); }
#pragma unroll
        for (int ai = 0; ai < 2; ++ai)
#pragma unroll
            for (int m = 0; m < 4; ++m) { const int row = row0 + ai * HALF + m * 16; const size_t off = (size_t)row * 1024 + col0; float q = 0.f;
#pragma unroll
                for (int bj = 0; bj < 2; ++bj) { const f32x4 x0 = *(const f32x4*)(x + off + bj * HALF), x1 = *(const f32x4*)(x + off + bj * HALF + 4);
                    const f32x4 h0 = x0 + g1[bj][0] * acc[ai][bj][m][0], hb = x1 + g1[bj][1] * acc[ai][bj][m][1];
                    *(f32x4*)(h1 + off + bj * HALF) = h0; *(f32x4*)(h1 + off + bj * HALF + 4) = hb;
                    q += (h0[0] * h0[0] + h0[1] * h0[1]) + (h0[2] * h0[2] + h0[3] * h0[3]) + (hb[0] * hb[0] + hb[1] * hb[1]) + (hb[2] * hb[2] + hb[3] * hb[3]);
                    *(u32x4*)(hhat + off + bj * HALF) = pack8(h0 * cs[bj][0], hb * cs[bj][1]); }
                q += __shfl_xor(q, 16); q += __shfl_xor(q, 32);
                if (fq == 0) ssq[(size_t)row * 16 + u.pn * 4 + wc] = q; }
    }
};

struct EpiFF1 {
    static constexpr bool PERM = true, AFTER_DRAIN = false, HAS_MID = false;
    const float* bias2; const PG8_LAS float* rstd; bf16_t* HID;
    __device__ __forceinline__ void mid(f32x4 (&)[2][2][4][2], const Unit&, int, int, int, int) const {}
    __device__ __forceinline__ void operator()(const f32x4 (&acc)[2][2][4][2], const Unit& u, int wr, int wc, int fr, int fq) const {
        const int rl0 = wr * 64 + fr, col0 = u.pn * BM + wc * 32 + 8 * fq, b = u.pm >> 4;
        f32x4 bv[2][2];
#pragma unroll
        for (int bj = 0; bj < 2; ++bj)
#pragma unroll
            for (int n = 0; n < 2; ++n) bv[bj][n] = *(const f32x4*)(bias2 + b * 4096 + col0 + bj * HALF + 4 * n);
#pragma unroll
        for (int ai = 0; ai < 2; ++ai)
#pragma unroll
            for (int m = 0; m < 4; ++m) { const int rl = rl0 + ai * HALF + m * 16; const float rs = rstd[rl]; bf16_t* op = HID + (size_t)(u.pm * BM + rl) * 4096 + col0;
#pragma unroll
                for (int bj = 0; bj < 2; ++bj) { f32x4 v0 = acc[ai][bj][m][0] * rs + bv[bj][0], v1 = acc[ai][bj][m][1] * rs + bv[bj][1];
#pragma unroll
                    for (int i = 0; i < 4; ++i) { const float a = fmaxf(v0[i], 0.f), c = fmaxf(v1[i], 0.f); v0[i] = a * a; v1[i] = c * c; }
                    *(u32x4*)(op + bj * HALF) = pack8(v0, v1); } }
    }
};

struct EpiRes2 {
    static constexpr bool PERM = true, AFTER_DRAIN = false, HAS_MID = false;
    float* h; const float* modf; float* ssq;
    __device__ __forceinline__ void mid(f32x4 (&)[2][2][4][2], const Unit&, int, int, int, int) const {}
    __device__ __forceinline__ void operator()(const f32x4 (&acc)[2][2][4][2], const Unit& u, int wr, int wc, int fr, int fq) const {
        const int row0 = u.pm * BM + wr * 64 + fr, col0 = u.pn * BM + wc * 32 + 8 * fq, b = u.pm >> 4;
        f32x4 g2[2][2];
#pragma unroll
        for (int bj = 0; bj < 2; ++bj)
#pragma unroll
            for (int n = 0; n < 2; ++n) g2[bj][n] = *(const f32x4*)(modf + b * 6144 + 5120 + col0 + bj * HALF + 4 * n);
#pragma unroll
        for (int ai = 0; ai < 2; ++ai)
#pragma unroll
            for (int m = 0; m < 4; ++m) { const int row = row0 + ai * HALF + m * 16; const size_t off = (size_t)row * 1024 + col0; float q = 0.f;
#pragma unroll
                for (int bj = 0; bj < 2; ++bj) { const f32x4 x0 = *(const f32x4*)(h + off + bj * HALF), x1 = *(const f32x4*)(h + off + bj * HALF + 4);
                    const f32x4 h0 = x0 + g2[bj][0] * acc[ai][bj][m][0], hb = x1 + g2[bj][1] * acc[ai][bj][m][1];
                    *(f32x4*)(h + off + bj * HALF) = h0; *(f32x4*)(h + off + bj * HALF + 4) = hb;
                    q += (h0[0] * h0[0] + h0[1] * h0[1]) + (h0[2] * h0[2] + h0[3] * h0[3]) + (hb[0] * hb[0] + hb[1] * hb[1]) + (hb[2] * hb[2] + hb[3] * hb[3]); }
                q += __shfl_xor(q, 16); q += __shfl_xor(q, 32);
                if (fq == 0) ssq[(size_t)row * 16 + u.pn * 4 + wc] = q; }
    }
};

template <class Epi, class Sched, bool ALIGN_EPI = false, bool SP2 = false>
__device__ __forceinline__ void gemm_phase(PG8_LAS unsigned char* lds, const Gemm g, const Sched& S, const Epi& E, const int wid) {
    const int lane = lane_id_v(), tid = wid * 64 + lane, wr = wid >> 2, wc = wid & 3, fr = lane & 15, fq = lane >> 4;
    const int K = g.K, nt = K / BK;
    unsigned voffA[2], voffB[2];
#pragma unroll
    for (int i = 0; i < 2; ++i) { int R, C; stage_rc(tid * 16 + i * 8192, R, C); const int Rb = Epi::PERM ? ((R & ~31) + perm32(R & 31)) : R;
        voffA[i] = (unsigned)(R * K + C) * 2u; voffB[i] = (unsigned)(Rb * K + C) * 2u; }
    const size_t kstep = (size_t)(BK * 2);
    const size_t hstep = (size_t)HALF * K * 2;
    const size_t tstep = 2 * hstep;
    const unsigned ldsw = (unsigned)wid * 1024u;
    const int aoff = lds_byte(wr * 64 + fr, fq * 8), boff = lds_byte(wc * 32 + fr, fq * 8);
#define PG8_SA(b, h) (((b) * 2 + (h)) * HTB)
#define PG8_SB(b, h) ((4 + (b) * 2 + (h)) * HTB)
#define PG8_STAGE(bufoff, gbase, voff) do { _Pragma("unroll") for (int _i = 0; _i < 2; ++_i) \
        __builtin_amdgcn_global_load_lds((const unsigned*)((const char*)(gbase) + (voff)[_i]), (PG8_LAS unsigned*)(lds + (bufoff) + ldsw + _i * 8192), 16, 0, 0); } while (0)
#define PG8_LDA(dst, b, h) do { _Pragma("unroll") for (int m = 0; m < 4; ++m) _Pragma("unroll") for (int k = 0; k < 2; ++k) dst[m][k] = *(const PG8_LAS bf16x8*)(lds + PG8_SA(b, h) + aoff + m * 2048 + k * 1024); } while (0)
#define PG8_LDB(dst, b, h) do { _Pragma("unroll") for (int n = 0; n < 2; ++n) _Pragma("unroll") for (int k = 0; k < 2; ++k) dst[n][k] = *(const PG8_LAS bf16x8*)(lds + PG8_SB(b, h) + boff + n * 2048 + k * 1024); } while (0)
#define PG8_MMA(ai, bj, At, Bt) do { __builtin_amdgcn_s_setprio(1); _Pragma("unroll") for (int m = 0; m < 4; ++m) _Pragma("unroll") for (int n = 0; n < 2; ++n) _Pragma("unroll") for (int k = 0; k < 2; ++k) \
        acc[ai][bj][m][n] = __builtin_amdgcn_mfma_f32_16x16x32_bf16(Bt[n][k], At[m][k], acc[ai][bj][m][n], 0, 0, 0); __builtin_amdgcn_s_setprio(0); } while (0)
#define PG8_WAIT_V(n) asm volatile("s_waitcnt vmcnt(" #n ")" ::: "memory")
#define PG8_WAIT_L(n) asm volatile("s_waitcnt lgkmcnt(" #n ")" ::: "memory")
#define PG8_BAR __builtin_amdgcn_s_barrier()
#define PG8_SCHED __builtin_amdgcn_sched_barrier(0)
    Unit cur, nxt; int ui = 0;
    if (!S.next(0, cur)) return;
    f32x4 acc[2][2][4][2];
#pragma unroll
    for (int a = 0; a < 2; ++a)
#pragma unroll
        for (int b = 0; b < 2; ++b)
#pragma unroll
            for (int m = 0; m < 4; ++m)
#pragma unroll
                for (int n = 0; n < 2; ++n) acc[a][b][m][n] = (f32x4){0.f, 0.f, 0.f, 0.f};
    bf16x8 At[4][2], B0[2][2], B1[2][2];
    const char* cA = (const char*)g.A + (size_t)cur.pm * tstep; const char* cB = (const char*)g.Bt + (size_t)cur.pn * tstep;
    S.a_ready(cur);
    if constexpr (SP2) {
        PG8_STAGE(PG8_SB(0, 0), cB, voffB); PG8_STAGE(PG8_SB(0, 1), cB + hstep, voffB); PG8_STAGE(PG8_SA(0, 0), cA, voffA); PG8_STAGE(PG8_SA(0, 1), cA + hstep, voffA);
        if (wr == 1) PG8_BAR;
        PG8_WAIT_V(2); PG8_BAR;
        PG8_STAGE(PG8_SB(1, 0), cB + kstep, voffB); PG8_STAGE(PG8_SA(1, 0), cA + kstep, voffA); PG8_STAGE(PG8_SB(1, 1), cB + hstep + kstep, voffB);
        PG8_WAIT_V(6); PG8_BAR;
    } else {
        PG8_STAGE(PG8_SB(0, 0), cB, voffB); PG8_STAGE(PG8_SA(0, 0), cA, voffA); PG8_STAGE(PG8_SB(0, 1), cB + hstep, voffB); PG8_STAGE(PG8_SA(0, 1), cA + hstep, voffA);
        if (wr == 1) PG8_BAR;
        PG8_WAIT_V(4); PG8_BAR;
        PG8_STAGE(PG8_SB(1, 0), cB + kstep, voffB); PG8_STAGE(PG8_SA(1, 0), cA + kstep, voffA); PG8_STAGE(PG8_SB(1, 1), cB + hstep + kstep, voffB);
        PG8_WAIT_V(6); PG8_BAR;
    }
    for (;;) {
        const bool has_next = S.next(ui + 1, nxt);
        const char* nA = has_next ? (const char*)g.A + (size_t)nxt.pm * tstep : cA; const char* nB = has_next ? (const char*)g.Bt + (size_t)nxt.pn * tstep : cB;
        for (int t = 0; t < nt; t += 2) {
            if constexpr (Epi::HAS_MID) { if (t == (nt >> 1)) E.mid(acc, cur, wr, wc, fr, fq); }
            const bool last = (t == nt - 2);
            const char* a1 = cA + (size_t)(t + 1) * kstep;
            const char* a2 = last ? nA : cA + (size_t)(t + 2) * kstep; const char* b2 = last ? nB : cB + (size_t)(t + 2) * kstep;
            const char* a3 = a2 + kstep; const char* b3 = b2 + kstep;
            if (last && has_next) S.a_ready(nxt);
            if constexpr (SP2) {
            PG8_LDB(B0, 0, 0); PG8_LDB(B1, 0, 1); PG8_SCHED; PG8_LDA(At, 0, 0); PG8_STAGE(PG8_SA(1, 1), a1 + hstep, voffA);
            PG8_WAIT_V(8); PG8_WAIT_L(0); PG8_BAR; PG8_MMA(0, 0, At, B0); PG8_MMA(0, 1, At, B1); PG8_BAR; PG8_SCHED;
            PG8_LDA(At, 0, 1); PG8_STAGE(PG8_SB(0, 0), b2, voffB); PG8_STAGE(PG8_SB(0, 1), b2 + hstep, voffB); PG8_STAGE(PG8_SA(0, 0), a2, voffA);
            PG8_WAIT_V(8); PG8_WAIT_L(0); PG8_BAR; PG8_MMA(1, 0, At, B0); PG8_MMA(1, 1, At, B1); PG8_BAR; PG8_SCHED;
            PG8_LDB(B0, 1, 0); PG8_LDB(B1, 1, 1); PG8_SCHED; PG8_LDA(At, 1, 0); PG8_STAGE(PG8_SA(0, 1), a2 + hstep, voffA);
            PG8_WAIT_V(8); PG8_WAIT_L(0); PG8_BAR; PG8_MMA(0, 0, At, B0); PG8_MMA(0, 1, At, B1); PG8_BAR; PG8_SCHED;
            PG8_LDA(At, 1, 1); PG8_STAGE(PG8_SB(1, 0), b3, voffB); PG8_STAGE(PG8_SB(1, 1), b3 + hstep, voffB); PG8_STAGE(PG8_SA(1, 0), a3, voffA);
            PG8_WAIT_V(8); PG8_WAIT_L(0); PG8_BAR; PG8_MMA(1, 0, At, B0); PG8_MMA(1, 1, At, B1); PG8_BAR; PG8_SCHED;
            } else {
            PG8_LDB(B0, 0, 0); PG8_SCHED; PG8_LDA(At, 0, 0); PG8_STAGE(PG8_SA(1, 1), a1 + hstep, voffA);
            PG8_WAIT_L(8); PG8_BAR; PG8_WAIT_L(0); PG8_MMA(0, 0, At, B0); PG8_BAR; PG8_SCHED;
            PG8_LDB(B1, 0, 1); PG8_STAGE(PG8_SB(0, 0), b2, voffB);
            PG8_BAR; PG8_WAIT_L(0); PG8_MMA(0, 1, At, B1); PG8_BAR;
            PG8_LDA(At, 0, 1); PG8_STAGE(PG8_SA(0, 0), a2, voffA);
            PG8_BAR; PG8_WAIT_L(0); PG8_MMA(1, 0, At, B0); PG8_BAR; PG8_SCHED;
            PG8_STAGE(PG8_SB(0, 1), b2 + hstep, voffB);
            PG8_WAIT_V(6); PG8_BAR; PG8_MMA(1, 1, At, B1); PG8_BAR;
            PG8_LDB(B0, 1, 0); PG8_SCHED; PG8_LDA(At, 1, 0); PG8_STAGE(PG8_SA(0, 1), a2 + hstep, voffA);
            PG8_WAIT_L(8); PG8_BAR; PG8_WAIT_L(0); PG8_MMA(0, 0, At, B0); PG8_BAR; PG8_SCHED;
            PG8_LDB(B1, 1, 1); PG8_STAGE(PG8_SB(1, 0), b3, voffB);
            PG8_BAR; PG8_WAIT_L(0); PG8_MMA(0, 1, At, B1); PG8_BAR;
            PG8_LDA(At, 1, 1); PG8_STAGE(PG8_SA(1, 0), a3, voffA);
            PG8_BAR; PG8_WAIT_L(0); PG8_MMA(1, 0, At, B0); PG8_BAR; PG8_SCHED;
            PG8_STAGE(PG8_SB(1, 1), b3 + hstep, voffB);
            PG8_WAIT_V(6); PG8_BAR; PG8_MMA(1, 1, At, B1); PG8_BAR;
            }
        }
        if constexpr (ALIGN_EPI) { if (wr == 0) PG8_BAR; }
        if constexpr (!Epi::AFTER_DRAIN) { E(acc, cur, wr, wc, fr, fq); S.done(cur); }
        if (!has_next) break;
#pragma unroll
        for (int a = 0; a < 2; ++a)
#pragma unroll
            for (int b = 0; b < 2; ++b)
#pragma unroll
                for (int m = 0; m < 4; ++m)
#pragma unroll
                    for (int n = 0; n < 2; ++n) acc[a][b][m][n] = (f32x4){0.f, 0.f, 0.f, 0.f};
        cur = nxt; cA = nA; cB = nB; ++ui;
        if constexpr (ALIGN_EPI) { if (wr == 1) PG8_BAR; }
    }
    PG8_WAIT_V(0);
    if constexpr (!ALIGN_EPI) { if (wr == 0) PG8_BAR; }
    PG8_BAR;
    if constexpr (Epi::AFTER_DRAIN) { E.fused(acc, cur, wr, wc, fr, fq, lds, wid, lane); S.done(cur); }
#undef PG8_SA
#undef PG8_SB
#undef PG8_STAGE
#undef PG8_LDA
#undef PG8_LDB
#undef PG8_MMA
#undef PG8_WAIT_V
#undef PG8_WAIT_L
#undef PG8_BAR
#undef PG8_SCHED
}
}

#define GAS __attribute__((address_space(1)))
#define LAS __attribute__((address_space(3)))
typedef unsigned short bf16;
typedef unsigned v4u __attribute__((ext_vector_type(4)));
typedef float f32x4 __attribute__((ext_vector_type(4)));
typedef short bf16x8 __attribute__((ext_vector_type(8)));
typedef GAS unsigned gu32;
typedef GAS unsigned long long gu64;
#define RLX_AGENT __ATOMIC_RELAXED, __HIP_MEMORY_SCOPE_AGENT
#define LDS_WAIT() asm volatile("s_waitcnt lgkmcnt(0)" ::: "memory")
#define VM_WAIT() asm volatile("s_waitcnt vmcnt(0)" ::: "memory")
__device__ __forceinline__ unsigned long long rt() { return __builtin_amdgcn_s_memrealtime(); }
__device__ __forceinline__ unsigned f2bf(float f) { unsigned u = __builtin_bit_cast(unsigned, f); return (u + 0x7fffu + ((u >> 16) & 1u)) >> 16; }
__device__ __forceinline__ unsigned pk2(float lo, float hi) { return f2bf(lo) | (f2bf(hi) << 16); }

#define XB_TMO      128
#define XB_XCNT(j)  (256  + 64 * (j))
#define XB_XSUB(j)  (1280 + 64 * (j))
#define XB_XGEN(j)  (2304 + 64 * (j))
#define XB_TOP      3328
#define XB_TOPGEN   3392
#define XCD_BAR_WORDS 3456
#define XB_SPIN_CAP (1u << 18)

__device__ __forceinline__ unsigned xb_ld(unsigned* p)              { return __hip_atomic_load(p, __ATOMIC_RELAXED, __HIP_MEMORY_SCOPE_AGENT); }
__device__ __forceinline__ unsigned xb_add(unsigned* p, unsigned v) { return __hip_atomic_fetch_add(p, v, __ATOMIC_RELAXED, __HIP_MEMORY_SCOPE_AGENT); }
__device__ __forceinline__ unsigned xb_xcc_id() { return (unsigned)__builtin_amdgcn_s_getreg((3 << 11) | 20) & 0xFu; }
#define XB_SPIN(cond, bar) do { unsigned _sp = 0; while (cond) { __builtin_amdgcn_s_sleep(1); \
    if ((++_sp & 255u) == 0u) { if (xb_ld(&(bar)[XB_TMO])) break; if (_sp > XB_SPIN_CAP) { atomicAdd(&(bar)[XB_TMO], 1u); break; } } } } while (0)

struct XcdBarrier {
    unsigned* bar; unsigned x;
    volatile LAS unsigned* st;
};

__device__ __forceinline__ XcdBarrier xcd_barrier_post(unsigned* bar, volatile LAS unsigned* st, const int wave) {
    XcdBarrier b; b.bar = bar; b.x = xb_xcc_id(); b.st = st;
    if (wave == 0 && pg8::lane_id_v() == 0) (void)xb_add(&bar[XB_XCNT(b.x)], 1u);
    return b;
}
__device__ __forceinline__ void xcd_barrier_complete(unsigned* bar, unsigned x, unsigned& nloc, unsigned& nx) {
    const unsigned G = gridDim.x * gridDim.y * gridDim.z;
    unsigned sum, cnt, mine, sp = 0u;
    for (;;) {
        sum = 0u; cnt = 0u; mine = 0u;
#pragma unroll
        for (unsigned j = 0; j < 16; ++j) { const unsigned c = xb_ld(&bar[XB_XCNT(j)]); sum += c; cnt += (c > 0u) ? 1u : 0u; mine = (j == x) ? c : mine; }
        if (sum == G) break;
        __builtin_amdgcn_s_sleep(1);
        if ((++sp & 255u) == 0u) { if (xb_ld(&bar[XB_TMO])) break; if (sp > XB_SPIN_CAP) { atomicAdd(&bar[XB_TMO], 1u); break; } }
    }
    nloc = mine > 0u ? mine : 1u; nx = cnt > 0u ? cnt : 1u;
}

__device__ __forceinline__ void xcd_barrier(const XcdBarrier& b, const int wave) {
    asm volatile("s_waitcnt vmcnt(0)" ::: "memory");
    __syncthreads();
    if (wave == 0 && pg8::lane_id_v() == 0) {
        unsigned* bar = b.bar;
        __builtin_amdgcn_s_waitcnt(0);
        unsigned nloc = b.st[0], nx = b.st[1];
        if (nloc == 0u) { xcd_barrier_complete(bar, b.x, nloc, nx); b.st[0] = nloc; b.st[1] = nx; }
        const unsigned old = xb_add(&bar[XB_XSUB(b.x)], 1u);
        const unsigned gen = old / nloc;
        if (old + 1u == (gen + 1u) * nloc) {
            __builtin_amdgcn_fence(__ATOMIC_RELEASE, "agent");
            asm volatile("s_waitcnt vmcnt(0)" ::: "memory");
            const unsigned og = xb_add(&bar[XB_TOP], 1u);
            const unsigned tg = og / nx;
            if (og + 1u == (tg + 1u) * nx) xb_add(&bar[XB_TOPGEN], 1u);
            else XB_SPIN(xb_ld(&bar[XB_TOPGEN]) == tg, bar);
            __builtin_amdgcn_fence(__ATOMIC_ACQUIRE, "agent");
            xb_add(&bar[XB_XGEN(b.x)], 1u);
            asm volatile("s_waitcnt vmcnt(0)" ::: "memory");
        } else {
            XB_SPIN(xb_ld(&bar[XB_XGEN(b.x)]) == gen, bar);
            __builtin_amdgcn_fence(__ATOMIC_ACQUIRE, "agent");
            asm volatile("s_waitcnt vmcnt(0)" ::: "memory");
        }
    }
    __syncthreads();
}


constexpr int NWAVES = 8;
constexpr int BATCH = 4, SEQ = 4096, D = 1024, M = BATCH * SEQ, NPROJ = 8192, FF = 4096, NMOD = 6 * D;
constexpr int RH = 4, DK = 128, DV = 256, SCH = 256  , NJ = SEQ / SCH  ;
constexpr float EPS = 1e-6f;
constexpr int KS_MOD = 8;
constexpr size_t MiB = 1u << 20;
constexpr size_t WS_CTL = 0, CTL_ZERO_BYTES = 1 * MiB;
constexpr size_t WS_MODP = 1 * MiB;
constexpr size_t WS_MODF = 2 * MiB + 512 * 1024;
constexpr size_t WS_BIAS2 = WS_MODF + 128 * 1024;
constexpr size_t WS_SSQ2 = 3 * MiB, WS_SSQ3 = 4 * MiB;
constexpr size_t WS_WIN = 5 * MiB, WS_WRC = 21 * MiB, WS_WO = 25 * MiB, WS_W1 = 27 * MiB, WS_W2 = 35 * MiB;
constexpr size_t WS_ST = WS_WIN;
constexpr size_t WS_QK = 44 * MiB, WS_V = 76 * MiB, WS_OGCB = 108 * MiB, WS_GATES = 172 * MiB, WS_END = 236 * MiB;
constexpr size_t WS_MERGED = WS_QK, WS_HHAT = WS_GATES, WS_HID = WS_QK;
constexpr size_t OUT_U = 0, OUT_Z = 32 * MiB, OUT_KV = 0;
static_assert(WS_W2 + (size_t)D * FF * 2 <= WS_QK && WS_HID + (size_t)M * FF * 2 <= WS_GATES, "d_ws map");
constexpr int CW_TMO = 0, CW_BAR = 4096;
constexpr int RING_OFF = 0, PHASE_BYTES = 139264, LDSCTL_OFF = PHASE_BYTES, MISC_OFF = LDSCTL_OFF + 320, TAB_OFF = LDSCTL_OFF + 1024, LDS_BYTES = PHASE_BYTES + 4096;

struct Frame {
    LAS unsigned char* lds; volatile LAS unsigned* MISC; gu32* ctl;
    int wave, vcu, G;
    const float *x, *c, *w_ada, *b_ada, *norm1_w, *w_in, *ret_gn_w, *conv_w, *w_ret_out, *w_conv_out, *w_o, *norm2_w, *w_ff1, *w_ff2, *final_norm_w; const int* positions;
    float* out; unsigned char* ws;
};
__device__ __forceinline__ float wave_sum(float v) {
#pragma unroll
    for (int o = 1; o < 64; o <<= 1) v += __shfl_xor(v, o);
    return v;
}
__device__ __forceinline__ unsigned cvtpk2(float lo, float hi) { return pg8::cvtpk(lo, hi); }

__device__ __forceinline__ int vmap_in(int n) {
    if (n < 1024) { const int hb = n & ~127, d = n & 127; const int dd = d & 63; return hb + 8 * (dd >> 2) + (d >= 64 ? 4 : 0) + (dd & 3); }
    if (n >= 4096 && n < 6144) { const int j = (n - 4096) & 1023; return 4096 + 8 * (j >> 2) + (n >= 5120 ? 4 : 0) + (j & 3); }
    return n;
}
template <bool VMAP>
__device__ __forceinline__ void p0_transpose_item(const float* W, int K, int N, bf16* WT, int ldt, int kofs, LAS float* scr, int item, int lane) {
    const int nblk = N / 32, kb = item / nblk, nb = item % nblk, k0 = 64 * kb, n0 = 32 * nb;
#pragma unroll 8
    for (int i = 0; i < 32; ++i) { const int kk = 2 * i + (lane >> 5); scr[kk * 33 + (lane & 31)] = W[(size_t)(k0 + kk) * N + n0 + (lane & 31)]; }
    LDS_WAIT(); asm volatile("" ::: "memory");
    const int c = lane & 7;
#pragma unroll
    for (int j = 0; j < 4; ++j) { const int n = (lane >> 3) + 8 * j; const LAS float* s = scr + (8 * c) * 33 + n;
        v4u o; o.x = cvtpk2(s[0 * 33], s[1 * 33]); o.y = cvtpk2(s[2 * 33], s[3 * 33]); o.z = cvtpk2(s[4 * 33], s[5 * 33]); o.w = cvtpk2(s[6 * 33], s[7 * 33]);
        const int vr = VMAP ? vmap_in(n0 + n) : (n0 + n);
        *(GAS v4u*)(WT + (size_t)vr * ldt + kofs + k0 + 8 * c) = o; }
    LDS_WAIT(); asm volatile("" ::: "memory");
}
__device__ __forceinline__ float siluf_(float x) { return x / (1.0f + __expf(-x)); }
__device__ __forceinline__ void p0_prologue(Frame& F) {
    const int lane_ = pg8::lane_id_v(), tid_ = F.wave * 64 + lane_; (void)tid_;
    LAS float* scr = (LAS float*)(F.lds + RING_OFF + F.wave * 16384);
    const int gw = F.vcu * NWAVES + F.wave, NGW = F.G * NWAVES;
    constexpr int NMODI = 24 * KS_MOD;
    { const int it = NGW - 1 - gw;
      if (it < NMODI) { const int cb = it % 24, ks = it / 24; const int col = 256 * cb + 4 * lane_;
        f32x4 a0 = {0.f, 0.f, 0.f, 0.f}, a1 = a0, a2 = a0, a3 = a0;
        const float* wp = F.w_ada + (size_t)(ks * (D / KS_MOD)) * NMOD + col;
#pragma unroll 4
        for (int kk = 0; kk < D / KS_MOD; ++kk) { const int k = ks * (D / KS_MOD) + kk; const f32x4 w = *(const GAS f32x4*)(wp + (size_t)kk * NMOD);
            const float s0 = siluf_(F.c[k]), s1 = siluf_(F.c[D + k]), s2 = siluf_(F.c[2 * D + k]), s3 = siluf_(F.c[3 * D + k]);
            a0 += w * s0; a1 += w * s1; a2 += w * s2; a3 += w * s3; }
        float* mp = (float*)(F.ws + WS_MODP) + (size_t)ks * 4 * NMOD + col;
        *(f32x4*)(mp) = a0; *(f32x4*)(mp + NMOD) = a1; *(f32x4*)(mp + 2 * NMOD) = a2; *(f32x4*)(mp + 3 * NMOD) = a3; } }
    constexpr int I_IN = (D / 64) * (NPROJ / 32), I_SQ = (D / 64) * (D / 32), I_1 = (D / 64) * (FF / 32), I_2 = (FF / 64) * (D / 32);
    constexpr int NITEMS = I_IN + 3 * I_SQ + I_1 + I_2;
    bf16* Win_t = (bf16*)(F.ws + WS_WIN); bf16* Wrc_t = (bf16*)(F.ws + WS_WRC); bf16* Wo_t = (bf16*)(F.ws + WS_WO); bf16* W1_t = (bf16*)(F.ws + WS_W1); bf16* W2_t = (bf16*)(F.ws + WS_W2);
    for (int it = gw; it < NITEMS; it += NGW) {
        int r = it;
        if (r < I_IN) { p0_transpose_item<true>(F.w_in, D, NPROJ, Win_t, D, 0, scr, r, lane_); continue; } r -= I_IN;
        if (r < I_SQ) { p0_transpose_item<false>(F.w_ret_out, D, D, Wrc_t, 2 * D, 0, scr, r, lane_); continue; } r -= I_SQ;
        if (r < I_SQ) { p0_transpose_item<false>(F.w_conv_out, D, D, Wrc_t, 2 * D, D, scr, r, lane_); continue; } r -= I_SQ;
        if (r < I_SQ) { p0_transpose_item<false>(F.w_o, D, D, Wo_t, D, 0, scr, r, lane_); continue; } r -= I_SQ;
        if (r < I_1) { p0_transpose_item<false>(F.w_ff1, D, FF, W1_t, D, 0, scr, r, lane_); continue; } r -= I_1;
        p0_transpose_item<false>(F.w_ff2, FF, D, W2_t, FF, 0, scr, r, lane_);
    }
}

__device__ __forceinline__ float modp_sum(const float* modp, int idx) { float s = 0.f;
#pragma unroll
    for (int ks = 0; ks < KS_MOD; ++ks) s += modp[(size_t)ks * 4 * NMOD + idx];
    return s; }
__device__ __forceinline__ void p1_unorm(Frame& F) {
    const int lane_ = pg8::lane_id_v(), tid_ = F.wave * 64 + lane_; (void)tid_;
    const float* modp = (const float*)(F.ws + WS_MODP); float* modf = (float*)(F.ws + WS_MODF);
    const int blk = F.vcu;
    const int b = blk >> 6;
    LAS float* cs1 = (LAS float*)(F.lds + RING_OFF); LAS float* sh1 = cs1 + D;
    for (int k = tid_; k < D; k += NWAVES * 64) {
        const float sh = modp_sum(modp, b * NMOD + k) + F.b_ada[k], sc = modp_sum(modp, b * NMOD + D + k) + F.b_ada[D + k];
        cs1[k] = F.norm1_w[k] * (1.0f + sc); sh1[k] = sh; }
    if (tid_ < 96) { const int idx = blk * 96 + tid_; if (idx < 4 * NMOD) modf[idx] = modp_sum(modp, idx) + F.b_ada[idx % NMOD]; }
    __syncthreads();
    bf16* U = (bf16*)((unsigned char*)F.out + OUT_U);
    for (int rr = F.wave; rr < 64; rr += NWAVES) { const int m = blk * 64 + rr;
        const GAS f32x4* xr = (const GAS f32x4*)(F.x + (size_t)m * D) + lane_;
        f32x4 v[4]; float s = 0.f;
#pragma unroll
        for (int j = 0; j < 4; ++j) { v[j] = xr[64 * j]; s += (v[j].x * v[j].x + v[j].y * v[j].y) + (v[j].z * v[j].z + v[j].w * v[j].w); }
        const float rstd = 1.0f / sqrtf(wave_sum(s) * (1.0f / D) + EPS);
        GAS unsigned long long* o8 = (GAS unsigned long long*)(U + (size_t)m * D) + lane_;
#pragma unroll
        for (int j = 0; j < 4; ++j) { const int k = 4 * lane_ + 256 * j; const f32x4 a = *(const LAS f32x4*)(cs1 + k), sh = *(const LAS f32x4*)(sh1 + k);
            const f32x4 u = v[j] * rstd * a + sh;
            o8[64 * j] = (unsigned long long)cvtpk2(u.x, u.y) | ((unsigned long long)cvtpk2(u.z, u.w) << 32); }
    }
}

typedef short s16x4 __attribute__((ext_vector_type(4)));
typedef float f32x16 __attribute__((ext_vector_type(16)));
#define MFMA32(a, b, c) __builtin_amdgcn_mfma_f32_32x32x16_bf16((a), (b), (c), 0, 0, 0)
__device__ __forceinline__ int crow(int reg, int hh) { return (reg & 3) + 8 * (reg >> 2) + 4 * hh; }
__device__ __forceinline__ bf16x8 tr_frag(LAS unsigned char* p) {
    const s16x4 lo = __builtin_amdgcn_ds_read_tr16_b64_v4i16((LAS s16x4*)p), hi = __builtin_amdgcn_ds_read_tr16_b64_v4i16((LAS s16x4*)(p + 512));
    return __builtin_shufflevector(lo, hi, 0, 1, 2, 3, 4, 5, 6, 7);
}
__device__ __forceinline__ float log2_gamma(int hd) { return log2f(1.0f - exp2f(-5.0f - (float)hd)); }
constexpr int RT_K = 0, RT_V = 8192, RT_BLK = 24576;
__device__ __forceinline__ void p3a_kvsum(Frame& F, int unit) {
    const int lane_ = pg8::lane_id_v(), tid_ = F.wave * 64 + lane_; (void)tid_;
    const int bh = unit >> 4, J = unit & 15, b = bh >> 2, hd = bh & 3;
    const bf16* QK = (const bf16*)(F.ws + WS_QK); const bf16* V = (const bf16*)(F.ws + WS_V);
    float* KV = (float*)((unsigned char*)F.out + OUT_KV) + (size_t)unit * (DV * DK);
    const int tid = tid_, lane = lane_, w = F.wave, r = lane & 31, hh = lane >> 5;
    const float l2g = log2_gamma(hd);
    const size_t mbase = (size_t)b * SEQ + (size_t)J * SCH;
    const int krow_ = tid >> 4, kch = tid & 15;
    const bf16* kp = QK + (mbase + krow_) * 1024 + 512 + hd * DK + kch * 8;
    const bf16* vp0 = V + (mbase + (tid >> 5)) * 1024 + hd * DV + (tid & 31) * 8;
    const int kdst = RT_K + (kch >> 2) * 2048 + krow_ * 64 + (kch & 3) * 16;
    const int vdst0 = RT_V + ((tid & 31) >> 2) * 2048 + (tid >> 5) * 64 + (tid & 3) * 16;
    const int lane_off = (4 * hh + ((lane & 15) >> 2)) * 64 + ((lane >> 4) & 1) * 32 + (lane & 3) * 8;
    f32x16 acc[4];
#pragma unroll
    for (int d = 0; d < 4; ++d)
#pragma unroll
        for (int i = 0; i < 16; ++i) acc[d][i] = 0.f;
    v4u kreg = *(const GAS v4u*)kp, vreg0 = *(const GAS v4u*)vp0, vreg1 = *(const GAS v4u*)(vp0 + 16 * 1024);
    for (int sb = 0; sb < 8; ++sb) {
        __syncthreads();
        { const float dec = __builtin_amdgcn_exp2f((float)(255 - (32 * sb + krow_)) * l2g); v4u o;
#pragma unroll
          for (int j = 0; j < 4; ++j) o[j] = cvtpk2(pg8::bflo(kreg[j]) * dec, pg8::bfhi(kreg[j]) * dec);
          *(LAS v4u*)(F.lds + kdst) = o; *(LAS v4u*)(F.lds + vdst0) = vreg0; *(LAS v4u*)(F.lds + vdst0 + 16 * 64) = vreg1; }
        __syncthreads();
        if (sb < 7) { const size_t o = (size_t)(sb + 1) * 32 * 1024; kreg = *(const GAS v4u*)(kp + o); vreg0 = *(const GAS v4u*)(vp0 + o); vreg1 = *(const GAS v4u*)(vp0 + o + 16 * 1024); }
#pragma unroll
        for (int ks2 = 0; ks2 < 2; ++ks2) {
            const bf16x8 bv = tr_frag(F.lds + RT_V + w * 2048 + ks2 * 1024 + lane_off);
#pragma unroll
            for (int d = 0; d < 4; ++d) { const bf16x8 ak = tr_frag(F.lds + RT_K + d * 2048 + ks2 * 1024 + lane_off); acc[d] = MFMA32(ak, bv, acc[d]); }
        }
    }
#pragma unroll
    for (int d = 0; d < 4; ++d)
#pragma unroll
        for (int g = 0; g < 4; ++g) { f32x4 o = {acc[d][4 * g], acc[d][4 * g + 1], acc[d][4 * g + 2], acc[d][4 * g + 3]};
            *(GAS f32x4*)(KV + (size_t)(32 * w + r) * DK + 32 * d + 8 * g + 4 * hh) = o; }
    __syncthreads();
}
__device__ __forceinline__ void p3a_conv(Frame& F, int blk) {
    const int lane_ = pg8::lane_id_v(), tid_ = F.wave * 64 + lane_; (void)tid_;
    bf16* OGCB = (bf16*)(F.ws + WS_OGCB); const bf16* Z = (const bf16*)((unsigned char*)F.out + OUT_Z);
    const int cc = tid_ & 127, rg = tid_ >> 7, m0 = blk * 64 + rg * 16, c0 = cc * 8;
    float w0[8], w1[8], w2[8];
#pragma unroll
    for (int e = 0; e < 8; ++e) { w0[e] = F.conv_w[c0 + e]; w1[e] = F.conv_w[D + c0 + e]; w2[e] = F.conv_w[2 * D + c0 + e]; }
    v4u zm2 = {0u, 0u, 0u, 0u}, zm1 = {0u, 0u, 0u, 0u};
    if ((m0 & (SEQ - 1)) != 0) { zm2 = *(const GAS v4u*)(Z + (size_t)(m0 - 2) * 1024 + c0); zm1 = *(const GAS v4u*)(Z + (size_t)(m0 - 1) * 1024 + c0); }
#pragma unroll 4
    for (int i = 0; i < 16; ++i) { const int m = m0 + i;
        const v4u z0 = *(const GAS v4u*)(Z + (size_t)m * 1024 + c0); bf16* cp = OGCB + (size_t)m * 2048 + 1024 + c0; const v4u cb = *(const GAS v4u*)cp; v4u o;
#pragma unroll
        for (int j = 0; j < 4; ++j) {
            const float lo = pg8::bflo(cb[j]) * (w0[2 * j] * pg8::bflo(zm2[j]) + w1[2 * j] * pg8::bflo(zm1[j]) + w2[2 * j] * pg8::bflo(z0[j]));
            const float hi = pg8::bfhi(cb[j]) * (w0[2 * j + 1] * pg8::bfhi(zm2[j]) + w1[2 * j + 1] * pg8::bfhi(zm1[j]) + w2[2 * j + 1] * pg8::bfhi(z0[j]));
            o[j] = cvtpk2(lo, hi); }
        *(GAS v4u*)cp = o; zm2 = zm1; zm1 = z0; }
}
__device__ __forceinline__ void p3a_bias2(Frame& F) {
    const int lane_ = pg8::lane_id_v(), tid_ = F.wave * 64 + lane_; (void)tid_;
    const float* modf = (const float*)(F.ws + WS_MODF); const bf16* W1_t = (const bf16*)(F.ws + WS_W1); float* bias2 = (float*)(F.ws + WS_BIAS2);
    const int gw = F.vcu * NWAVES + F.wave, NGW = F.G * NWAVES;
    for (int f = gw; f < FF; f += NGW) { float a[4] = {0.f, 0.f, 0.f, 0.f};
#pragma unroll
        for (int i = 0; i < 2; ++i) { const int k0 = (lane_ + 64 * i) * 8; const v4u wv = *(const GAS v4u*)(W1_t + (size_t)f * D + k0);
#pragma unroll
            for (int bb = 0; bb < 4; ++bb) { const float* sh = modf + bb * NMOD + 3 * D + k0; const f32x4 s0 = *(const f32x4*)sh, s1 = *(const f32x4*)(sh + 4);
                a[bb] += pg8::bflo(wv[0]) * s0[0] + pg8::bfhi(wv[0]) * s0[1] + pg8::bflo(wv[1]) * s0[2] + pg8::bfhi(wv[1]) * s0[3]
                       + pg8::bflo(wv[2]) * s1[0] + pg8::bfhi(wv[2]) * s1[1] + pg8::bflo(wv[3]) * s1[2] + pg8::bfhi(wv[3]) * s1[3]; } }
#pragma unroll
        for (int bb = 0; bb < 4; ++bb) { const float s = wave_sum(a[bb]); if (lane_ == 0) bias2[bb * FF + f] = s; } }
}
__device__ __forceinline__ void p3b_scan(Frame& F) {
    const int lane_ = pg8::lane_id_v(), tid_ = F.wave * 64 + lane_; (void)tid_;
    const float* KV = (const float*)((unsigned char*)F.out + OUT_KV); bf16* ST = (bf16*)(F.ws + WS_ST);
    const int NT = F.G * NWAVES * 64;
    for (int t = F.vcu * (NWAVES * 64) + tid_; t < 16 * (DV * DK / 4); t += NT) {
        const int bh = t / (DV * DK / 4), e = (t % (DV * DK / 4)) * 4; const float g = exp2f(256.0f * log2_gamma(bh & 3));
        f32x4 kv[NJ];
#pragma unroll
        for (int J = 0; J < NJ; ++J) kv[J] = *(const GAS f32x4*)(KV + ((size_t)(bh * NJ + J)) * (DV * DK) + e);
        f32x4 S = {0.f, 0.f, 0.f, 0.f};
#pragma unroll
        for (int J = 0; J < NJ; ++J) { *(GAS unsigned long long*)(ST + ((size_t)(bh * NJ + J)) * (DV * DK) + e) = (unsigned long long)cvtpk2(S[0], S[1]) | ((unsigned long long)cvtpk2(S[2], S[3]) << 32);
            S = S * g + kv[J]; }
    }
}
constexpr int RC_ST = 0, RC_STP = 272, RC_BLK0 = 69632, RC_STG = 528;
__device__ __forceinline__ void p3c_retout(Frame& F, int unit) {
    const int lane_ = pg8::lane_id_v(), tid_ = F.wave * 64 + lane_; (void)tid_;
    const int bh = unit >> 4, J = unit & 15, b = bh >> 2, hd = bh & 3;
    const bf16* QK = (const bf16*)(F.ws + WS_QK); const bf16* V = (const bf16*)(F.ws + WS_V); const bf16* ST = (const bf16*)(F.ws + WS_ST) + (size_t)unit * (DV * DK);
    bf16* OGCB = (bf16*)(F.ws + WS_OGCB);
    const int tid = tid_, lane = lane_, w = F.wave, r = lane & 31, hh = lane >> 5;
    const float l2g = log2_gamma(hd);
    const size_t mbase = (size_t)b * SEQ + (size_t)J * SCH;
    const int krow_ = tid >> 4, kch = tid & 15;
    const bf16* kp = QK + (mbase + krow_) * 1024 + 512 + hd * DK + kch * 8;
    const bf16* vp0 = V + (mbase + (tid >> 5)) * 1024 + hd * DV + (tid & 31) * 8;
    const int kdst = RT_K + (kch >> 2) * 2048 + krow_ * 64 + (kch & 3) * 16;
    const int vdst0 = RT_V + ((tid & 31) >> 2) * 2048 + (tid >> 5) * 64 + (tid & 3) * 16;
    const int lane_off = (4 * hh + ((lane & 15) >> 2)) * 64 + ((lane >> 4) & 1) * 32 + (lane & 3) * 8;
    v4u kreg = *(const GAS v4u*)kp, vreg0 = *(const GAS v4u*)vp0, vreg1 = *(const GAS v4u*)(vp0 + 16 * 1024);
#pragma unroll
    for (int i = 0; i < 8; ++i) { const int idx = tid + 512 * i, row = idx >> 4, ch = idx & 15; *(LAS v4u*)(F.lds + RC_ST + row * RC_STP + ch * 16) = *(const GAS v4u*)(ST + (size_t)row * DK + ch * 8); }
    bf16x8 qf[8];
    { const bf16* qp = QK + (mbase + 32 * w + r) * 1024 + hd * DK + 8 * hh;
#pragma unroll
      for (int ks = 0; ks < 8; ++ks) qf[ks] = *(const GAS bf16x8*)(qp + 16 * ks); }
    f32x16 acc[8];
#pragma unroll
    for (int c8 = 0; c8 < 8; ++c8)
#pragma unroll
        for (int i = 0; i < 16; ++i) acc[c8][i] = 0.f;
    __syncthreads();
#pragma unroll
    for (int c8 = 0; c8 < 8; ++c8)
        {
#pragma unroll
          for (int ks = 0; ks < 8; ++ks) { const bf16x8 sf = *(const LAS bf16x8*)(F.lds + RC_ST + (32 * c8 + r) * RC_STP + (16 * ks + 8 * hh) * 2); acc[c8] = MFMA32(qf[ks], sf, acc[c8]); } __builtin_amdgcn_sched_barrier(0); }
    int t1v = 32 * w + 4 * hh + 1; asm volatile("" : "+v"(t1v));
#pragma unroll
    for (int i = 0; i < 16; ++i) { const float sc = __builtin_amdgcn_exp2f((float)(t1v + (i & 3) + 8 * (i >> 2)) * l2g);
#pragma unroll
        for (int c8 = 0; c8 < 8; ++c8) acc[c8][i] *= sc; }
    const int sbmax = w | 1;
    __syncthreads();
    LAS unsigned char* qsl = F.lds + RC_ST + w * 8192 + lane * 16;
#pragma unroll
    for (int ks = 0; ks < 8; ++ks) *(LAS bf16x8*)(qsl + ks * 1024) = qf[ks];
    for (int sb = 0; sb < 8; ++sb) {
        LAS unsigned char* buf = F.lds + RC_BLK0 + (sb & 1) * RT_BLK;
        *(LAS v4u*)(buf + kdst) = kreg; *(LAS v4u*)(buf + vdst0) = vreg0; *(LAS v4u*)(buf + vdst0 + 16 * 64) = vreg1;
        __syncthreads();
        if (sb < 7) { const size_t o = (size_t)(sb + 1) * 32 * 1024; kreg = *(const GAS v4u*)(kp + o); vreg0 = *(const GAS v4u*)(vp0 + o); vreg1 = *(const GAS v4u*)(vp0 + o + 16 * 1024); }
        if (sb <= sbmax) {
            f32x16 X;
#pragma unroll
            for (int i = 0; i < 16; ++i) X[i] = 0.f;
#pragma unroll
            for (int ks = 0; ks < 8; ++ks) { const bf16x8 kf = *(const LAS bf16x8*)(buf + RT_K + (ks >> 1) * 2048 + r * 64 + (ks & 1) * 32 + hh * 16); const bf16x8 qv = *(const LAS bf16x8*)(qsl + ks * 1024); X = MFMA32(kf, qv, X); }
            int tcv = 32 * w + r - 32 * sb - 4 * hh; asm volatile("" : "+v"(tcv));
#pragma unroll
            for (int i = 0; i < 16; ++i) { const int dt = tcv - ((i & 3) + 8 * (i >> 2)); X[i] *= __builtin_amdgcn_exp2f((float)(dt < 0 ? -dt : dt) * l2g); }
            bf16x8 pa[2];
#pragma unroll
            for (int s2 = 0; s2 < 2; ++s2) { v4u p; p[0] = cvtpk2(X[8 * s2], X[8 * s2 + 1]); p[1] = cvtpk2(X[8 * s2 + 2], X[8 * s2 + 3]); p[2] = cvtpk2(X[8 * s2 + 4], X[8 * s2 + 5]); p[3] = cvtpk2(X[8 * s2 + 6], X[8 * s2 + 7]);
                pa[s2] = __builtin_bit_cast(bf16x8, p); }
#pragma unroll
            for (int c8 = 0; c8 < 8; ++c8)
                {
#pragma unroll
                  for (int s2 = 0; s2 < 2; ++s2) { const bf16x8 bv = tr_frag(buf + RT_V + c8 * 2048 + s2 * 1024 + lane_off); acc[c8] = MFMA32(pa[s2], bv, acc[c8]); } if (c8 & 1) __builtin_amdgcn_sched_barrier(0); }
        }
    }
    __syncthreads();
    LAS unsigned char* stg = F.lds + w * (32 * RC_STG);
    LAS unsigned char* stgl = stg + 4 * hh * RC_STG + 2 * r;
#pragma unroll
    for (int i = 0; i < 16; ++i) {
        float s = 0.f;
#pragma unroll
        for (int c8 = 0; c8 < 8; ++c8) s += acc[c8][i];
        s += __shfl_xor(s, 1); s += __shfl_xor(s, 2); s += __shfl_xor(s, 4); s += __shfl_xor(s, 8); s += __shfl_xor(s, 16);
        const float mu = s * (1.0f / DV); float q = 0.f;
#pragma unroll
        for (int c8 = 0; c8 < 8; ++c8) { const float d = acc[c8][i] - mu; q += d * d; }
        q += __shfl_xor(q, 1); q += __shfl_xor(q, 2); q += __shfl_xor(q, 4); q += __shfl_xor(q, 8); q += __shfl_xor(q, 16);
        const float rs = 1.0f / sqrtf(q * (1.0f / DV) + EPS);
        LAS unsigned short* srow = (LAS unsigned short*)(stgl + ((i & 3) + 8 * (i >> 2)) * RC_STG);
#pragma unroll
        for (int c8 = 0; c8 < 8; ++c8) srow[32 * c8] = (unsigned short)(cvtpk2((acc[c8][i] - mu) * rs, 0.f) & 0xffffu);
    }
    LDS_WAIT(); asm volatile("" ::: "memory");
#pragma unroll 4
    for (int i = 0; i < 16; ++i) { const int idx = lane + 64 * i, row = idx >> 5, ch = idx & 31;
        const v4u y = *(const LAS v4u*)(stg + row * RC_STG + ch * 16);
        bf16* op = OGCB + (mbase + 32 * w + row) * 2048 + hd * DV + ch * 8; const v4u og = *(const GAS v4u*)op;
        const float* gw = F.ret_gn_w + hd * DV + ch * 8; const f32x4 g0 = *(const f32x4*)gw, g1 = *(const f32x4*)(gw + 4); v4u o;
        o[0] = cvtpk2(pg8::bflo(y[0]) * g0[0] * pg8::bflo(og[0]), pg8::bfhi(y[0]) * g0[1] * pg8::bfhi(og[0]));
        o[1] = cvtpk2(pg8::bflo(y[1]) * g0[2] * pg8::bflo(og[1]), pg8::bfhi(y[1]) * g0[3] * pg8::bfhi(og[1]));
        o[2] = cvtpk2(pg8::bflo(y[2]) * g1[0] * pg8::bflo(og[2]), pg8::bfhi(y[2]) * g1[1] * pg8::bfhi(og[2]));
        o[3] = cvtpk2(pg8::bflo(y[3]) * g1[2] * pg8::bflo(og[3]), pg8::bfhi(y[3]) * g1[3] * pg8::bfhi(og[3]));
        *(GAS v4u*)op = o; }
    __syncthreads();
}
__device__ __forceinline__ void p8_final(Frame& F) {
    const int lane_ = pg8::lane_id_v(), tid_ = F.wave * 64 + lane_; (void)tid_;
    const float* ssq = (const float*)(F.ws + WS_SSQ3);
    const int gw = F.vcu * NWAVES + F.wave, NGW = F.G * NWAVES;
    f32x4 wv[4];
#pragma unroll
    for (int j = 0; j < 4; ++j) wv[j] = *(const f32x4*)(F.final_norm_w + 4 * lane_ + 256 * j);
    for (int m = gw; m < M; m += NGW) {
        float s = (lane_ < 16) ? ssq[(size_t)m * 16 + lane_] : 0.f; s = wave_sum(s);
        const float rstd = 1.0f / sqrtf(s * (1.0f / D) + EPS);
        GAS f32x4* xr = (GAS f32x4*)(F.out + (size_t)m * D) + lane_;
#pragma unroll
        for (int j = 0; j < 4; ++j) { const f32x4 v = xr[64 * j]; xr[64 * j] = v * rstd * wv[j]; }
    }
}

constexpr int N_PHASES = 11;
struct Args { const void* in[16]; float* out; unsigned char* ws; int ph_lo, ph_hi, use_bar, pad; };
__global__ void __launch_bounds__(NWAVES * 64, 2) hyb_fwd(Args args) {
    extern __shared__ __attribute__((aligned(16))) unsigned char lds[];
    Frame F;
    F.lds = (LAS unsigned char*)lds; F.MISC = (volatile LAS unsigned*)(F.lds + MISC_OFF);
    F.wave = __builtin_amdgcn_readfirstlane((int)threadIdx.x >> 6);
    F.G = gridDim.x; { const int bx = blockIdx.x; F.vcu = (F.G % 8 == 0) ? (bx % 8) * (F.G / 8) + bx / 8 : bx; }
    F.ws = args.ws; F.out = args.out; F.ctl = (gu32*)(args.ws + WS_CTL);
    F.x = (const float*)args.in[0]; F.c = (const float*)args.in[1]; F.positions = (const int*)args.in[2]; F.w_ada = (const float*)args.in[3]; F.b_ada = (const float*)args.in[4];
    F.norm1_w = (const float*)args.in[5]; F.w_in = (const float*)args.in[6]; F.ret_gn_w = (const float*)args.in[7]; F.conv_w = (const float*)args.in[8]; F.w_ret_out = (const float*)args.in[9];
    F.w_conv_out = (const float*)args.in[10]; F.w_o = (const float*)args.in[11]; F.norm2_w = (const float*)args.in[12]; F.w_ff1 = (const float*)args.in[13]; F.w_ff2 = (const float*)args.in[14];
    F.final_norm_w = (const float*)args.in[15];
    for (int u = F.wave * 64 + pg8::lane_id_v(); u < (LDS_BYTES - LDSCTL_OFF) / 4; u += NWAVES * 64) ((LAS unsigned*)(F.lds + LDSCTL_OFF))[u] = 0u;
    __syncthreads();
    XcdBarrier bar; bar.bar = (unsigned*)(F.ctl + CW_BAR); bar.x = 0; bar.st = nullptr;
    if (args.use_bar) bar = xcd_barrier_post((unsigned*)(F.ctl + CW_BAR), F.MISC + 8, F.wave);
    const int lo = args.ph_lo, hi = args.ph_hi;
#ifndef PH_MASK
#define PH_MASK 0x7ff
#endif
#define IN(k) (((PH_MASK >> (k)) & 1) && lo <= (k) && (k) < hi)
#define SEAM(k) do { if (IN(k) && IN((k) + 1)) xcd_barrier(bar, F.wave); } while (0)
    unsigned char* ws = args.ws;
    bf16* U = (bf16*)((unsigned char*)args.out + OUT_U);

    if (IN(0)) { p0_prologue(F); } SEAM(0);
    if (IN(1)) { p1_unorm(F); } SEAM(1);
    if (IN(2)) {
        pg8::Gemm g{U, (const bf16*)(ws + WS_WIN), M, NPROJ, D}; pg8::StaticOrder S; S.init(M, NPROJ, F.G, (int)blockIdx.x);
        pg8::EpiProj E{(bf16*)(ws + WS_QK), (bf16*)(ws + WS_V), (bf16*)(ws + WS_OGCB), (bf16*)((unsigned char*)args.out + OUT_Z), (bf16*)(ws + WS_GATES), F.positions};
        pg8::gemm_phase<pg8::EpiProj, pg8::StaticOrder, true, true>(F.lds + RING_OFF, g, S, E, F.wave);
    } SEAM(2);
    if (IN(3)) { for (int u = F.vcu; u < 256; u += F.G) p3a_kvsum(F, u); for (int bk = F.vcu; bk < 256; bk += F.G) p3a_conv(F, bk); p3a_bias2(F); } SEAM(3);
    if (IN(4)) { p3b_scan(F); } SEAM(4);
    if (IN(5)) { for (int u = F.vcu; u < 256; u += F.G) p3c_retout(F, u); } SEAM(5);
    if (IN(6)) {
        pg8::Gemm g{(const bf16*)(ws + WS_OGCB), (const bf16*)(ws + WS_WRC), M, D, 2 * D}; pg8::StaticOrder S; S.init(M, D, F.G, (int)blockIdx.x);
        pg8::EpiMerge E{(const bf16*)(ws + WS_GATES), (bf16*)(ws + WS_MERGED)};
        pg8::gemm_phase<pg8::EpiMerge, pg8::StaticOrder, false, true>(F.lds + RING_OFF, g, S, E, F.wave);
    } SEAM(6);
    if (IN(7)) {
        pg8::Gemm g{(const bf16*)(ws + WS_MERGED), (const bf16*)(ws + WS_WO), M, D, D}; pg8::StaticOrder S; S.init(M, D, F.G, (int)blockIdx.x);
        pg8::EpiRes1 E{F.x, args.out, (bf16*)(ws + WS_HHAT), (const float*)(ws + WS_MODF), F.norm2_w, (float*)(ws + WS_SSQ2)};
        pg8::gemm_phase<pg8::EpiRes1, pg8::StaticOrder, false, true>(F.lds + RING_OFF, g, S, E, F.wave);
    } SEAM(7);
    if (IN(8)) {
        pg8::Gemm g{(const bf16*)(ws + WS_HHAT), (const bf16*)(ws + WS_W1), M, FF, D}; pg8::StaticOrder S; S.init(M, FF, F.G, (int)blockIdx.x);
        pg8::Unit u0; LAS float* tab = (LAS float*)(F.lds + TAB_OFF); const int tid_ = F.wave * 64 + pg8::lane_id_v();
        if (S.next(0, u0)) { if (tid_ < 256) { const float* sq = (const float*)(ws + WS_SSQ2) + (size_t)(u0.pm * 256 + tid_) * 16; const f32x4 a = *(const f32x4*)sq, b = *(const f32x4*)(sq + 4), c = *(const f32x4*)(sq + 8), d = *(const f32x4*)(sq + 12);
            const float s = ((a[0] + a[1]) + (a[2] + a[3])) + ((b[0] + b[1]) + (b[2] + b[3])) + ((c[0] + c[1]) + (c[2] + c[3])) + ((d[0] + d[1]) + (d[2] + d[3]));
            tab[tid_] = 1.0f / sqrtf(s * (1.0f / D) + EPS); } }
        __syncthreads();
        pg8::EpiFF1 E{(const float*)(ws + WS_BIAS2), (const LAS float*)tab, (bf16*)(ws + WS_HID)};
        pg8::gemm_phase<pg8::EpiFF1, pg8::StaticOrder, true, true>(F.lds + RING_OFF, g, S, E, F.wave);
    } SEAM(8);
    if (IN(9)) {
        pg8::Gemm g{(const bf16*)(ws + WS_HID), (const bf16*)(ws + WS_W2), M, D, FF}; pg8::StaticOrder S; S.init(M, D, F.G, (int)blockIdx.x);
        pg8::EpiRes2 E{args.out, (const float*)(ws + WS_MODF), (float*)(ws + WS_SSQ3)};
        pg8::gemm_phase<pg8::EpiRes2, pg8::StaticOrder, false, true>(F.lds + RING_OFF, g, S, E, F.wave);
    } SEAM(9);
    if (IN(10)) { p8_final(F); }
#undef IN
#undef SEAM
}

#ifndef HYB_N_LAUNCHES
#define HYB_N_LAUNCHES 1
#endif
extern "C" void kernel_launch(void* const* d_in, const int* in_sizes, int n_in, void* d_out, int out_size, void* d_ws, size_t ws_size, hipStream_t stream) {
    static int grid = 0;
    if (grid == 0) {
        if (n_in != 16 || in_sizes[0] != M * D || out_size != M * D || ws_size < WS_END) { fprintf(stderr, "kernel_launch: unexpected shapes (n_in %d, in0 %d, out %d, ws %zu); nothing launched\n", n_in, n_in > 0 ? in_sizes[0] : -1, out_size, ws_size); grid = -1; return; }
        int dev = 0, cus = 0, per_cu = 0;
        if (hipGetDevice(&dev) != hipSuccess || hipDeviceGetAttribute(&cus, hipDeviceAttributeMultiprocessorCount, dev) != hipSuccess) { grid = -1; return; }
        if (hipFuncSetAttribute((const void*)hyb_fwd, hipFuncAttributeMaxDynamicSharedMemorySize, LDS_BYTES) != hipSuccess) { fprintf(stderr, "kernel_launch: hipFuncSetAttribute failed\n"); grid = -1; return; }
        if (hipOccupancyMaxActiveBlocksPerMultiprocessor(&per_cu, (const void*)hyb_fwd, NWAVES * 64, LDS_BYTES) != hipSuccess || per_cu < 1) { fprintf(stderr, "kernel_launch: occupancy query says %d workgroups per CU; nothing launched\n", per_cu); (void)hipGetLastError(); grid = -1; return; }
        { bool okp = true; pg8::StaticOrder S; for (int c = 0; c < cus && okp; ++c) { S.init(M, FF, cus, c); pg8::Unit u0, u; if (!S.next(0, u0)) continue; for (int i = 1; S.next(i, u); ++i) okp = okp && (u.pm == u0.pm); }
          if (!okp) { fprintf(stderr, "kernel_launch: FF1's unit order does not keep a workgroup inside one row panel on %d CUs; nothing launched\n", cus); grid = -1; return; } }
        grid = cus;
        if (grid != 256) fprintf(stderr, "kernel_launch: %d CUs (built for 256)\n", grid);
    }
    if (grid < 0) return;
    (void)hipMemsetAsync((char*)d_ws + WS_CTL, 0, CTL_ZERO_BYTES, stream);
    Args a{};
    for (int i = 0; i < 16; ++i) a.in[i] = d_in[i];
    a.out = (float*)d_out; a.ws = (unsigned char*)d_ws;
#if HYB_N_LAUNCHES == 1
    a.ph_lo = 0; a.ph_hi = N_PHASES; a.use_bar = 1;
    hipLaunchKernelGGL(hyb_fwd, dim3(grid), dim3(NWAVES * 64), LDS_BYTES, stream, a);
#else
    for (int p = 0; p < N_PHASES; ++p) { a.ph_lo = p; a.ph_hi = p + 1; a.use_bar = 0; hipLaunchKernelGGL(hyb_fwd, dim3(grid), dim3(NWAVES * 64), LDS_BYTES, stream, a); }
#endif
}
```

```cpp
#include <hip/hip_runtime.h>
#include <cstdio>
#include <cstdint>
namespace pg8 {
#define PG8_LAS __attribute__((address_space(3)))
typedef unsigned short bf16_t;
typedef short bf16x8 __attribute__((ext_vector_type(8)));
typedef float f32x4 __attribute__((ext_vector_type(4)));
typedef unsigned u32x4 __attribute__((ext_vector_type(4)));
constexpr int BM = 256, BK = 64, HALF = 128, HTB = HALF * BK * 2  , STAGE_BYTES = 8 * HTB, NXCD = 8, WGM = 8;

__host__ __device__ __forceinline__ int lds_byte(int r, int c) { const int st = (r >> 4) * 2 + (c >> 5), rr = r & 15, cc = c & 31, ob = rr * 64 + cc * 2; return st * 1024 + (ob ^ (((ob >> 9) & 1) << 5)); }
__host__ __device__ __forceinline__ void stage_rc(int b, int& R, int& C) { const int st = b / 1024, sb = b % 1024, swz = sb ^ (((sb >> 9) & 1) << 5); R = (st >> 1) * 16 + swz / 64; C = (st & 1) * 32 + (swz % 64) / 2; }
__host__ __device__ __forceinline__ int perm32(int rho) { const int n = rho >> 4, i = rho & 15; return 8 * (i >> 2) + 4 * n + (i & 3); }

struct Unit { int pm, pn; };
struct Gemm { const bf16_t* A; const bf16_t* Bt; int M, N, K; };

struct StaticOrder {
    int nM, nN, nwg, G, c;
    __host__ __device__ void init(int M, int N, int G_, int c_) { nM = M / BM; nN = N / BM; nwg = nM * nN; G = G_; c = c_; }
    __host__ __device__ bool next(int i, Unit& u) const {
        const long L = (long)i * G + c; if (L >= nwg) return false;
        int wgid = (int)L; { const int q = nwg / NXCD, r = nwg % NXCD, xcd = wgid % NXCD, off = wgid / NXCD; wgid = (xcd < r ? xcd * (q + 1) : r * (q + 1) + (xcd - r) * q) + off; }
        const int nig = WGM * nN, gid = wgid / nig, fm = gid * WGM, gsz = (nM - fm) < WGM ? (nM - fm) : WGM;
        u.pm = fm + ((wgid % nig) % gsz); u.pn = (wgid % nig) / gsz; return true;
    }
    __device__ __forceinline__ void a_ready(const Unit&) const {}
    __device__ __forceinline__ void done(const Unit&) const {}
};

__device__ __forceinline__ unsigned cvt_pk_bf16(float lo, float hi) { unsigned r; asm volatile("v_cvt_pk_bf16_f32 %0, %1, %2" : "=v"(r) : "v"(lo), "v"(hi)); return r; }
typedef float f32x2 __attribute__((ext_vector_type(2)));
__device__ __forceinline__ int lane_id_v() { int l; asm volatile("v_mbcnt_lo_u32_b32 %0, -1, 0\n\tv_mbcnt_hi_u32_b32 %0, -1, %0" : "=v"(l)); return l; }
typedef unsigned u32x2 __attribute__((ext_vector_type(2)));
__device__ __forceinline__ unsigned cvtpk(float lo, float hi) { typedef float f2_t __attribute__((ext_vector_type(2))); typedef __bf16 b2_t __attribute__((ext_vector_type(2))); f2_t v = {lo, hi}; b2_t b = __builtin_convertvector(v, b2_t); return __builtin_bit_cast(unsigned, b); }
__device__ __forceinline__ float bflo(unsigned w) { return __builtin_bit_cast(float, w << 16); }
__device__ __forceinline__ float bfhi(unsigned w) { return __builtin_bit_cast(float, w & 0xffff0000u); }
__device__ __forceinline__ float fast_rcp(float x) { return __builtin_amdgcn_rcpf(x); }
__device__ __forceinline__ float sigmoidf_(float x) { return fast_rcp(1.0f + __expf(-x)); }
__device__ __forceinline__ void sincos_rev(float ang, float& s, float& c) {
    const float I2P = 0.15915493667125702f, I2P_LO = 6.420638326565253e-09f;
    const float r = ang * I2P; float e = __builtin_fmaf(ang, I2P, -r); e = __builtin_fmaf(ang, I2P_LO, e);
    const float k = __builtin_rintf(r); const float f = (r - k) + e;
    s = __builtin_amdgcn_sinf(f); c = __builtin_amdgcn_cosf(f);
}
__device__ __forceinline__ u32x4 pack8(const f32x4 a, const f32x4 b) { u32x4 w; w.x = cvtpk(a[0], a[1]); w.y = cvtpk(a[2], a[3]); w.z = cvtpk(b[0], b[1]); w.w = cvtpk(b[2], b[3]); return w; }

struct EpiProj {
    static constexpr bool PERM = true, AFTER_DRAIN = false, HAS_MID = false;
    bf16_t* QK; bf16_t* V; bf16_t* OGCB; bf16_t* Z; bf16_t* GATES; const int* pos;
    __device__ __forceinline__ void mid(f32x4 (&)[2][2][4][2], const Unit&, int, int, int, int) const {}
    __device__ __forceinline__ void operator()(const f32x4 (&acc)[2][2][4][2], const Unit& u, int wr, int wc, int fr, int fq) const {
        const int row0 = u.pm * BM + wr * 64 + fr, cw = wc * 32 + 8 * fq, pn = u.pn;
        if (pn < 4) {
            const float ksc = pn >= 2 ? 0.08838834764831845f : 1.0f;
            const int g = 4 * wc + fq; float invf[4];
#pragma unroll
            for (int i = 0; i < 4; ++i) invf[i] = exp2f(-(float)(4 * g + i) * (13.287712379549449f / 64.0f));
#pragma unroll
            for (int ai = 0; ai < 2; ++ai)
#pragma unroll
                for (int m = 0; m < 4; ++m) { const int row = row0 + ai * HALF + m * 16; const float p = (float)pos[row];
                    f32x4 cs, sn;
#pragma unroll
                    for (int i = 0; i < 4; ++i) { float s_, c_; sincos_rev(p * invf[i], s_, c_); cs[i] = c_ * ksc; sn[i] = s_ * ksc; }
                    bf16_t* rowp = QK + (size_t)row * 1024 + pn * 256 + cw;
#pragma unroll
                    for (int bj = 0; bj < 2; ++bj) { const f32x4 x1 = acc[ai][bj][m][0], x2 = acc[ai][bj][m][1];
                        const f32x4 o1 = x1 * cs - x2 * sn, o2 = x1 * sn + x2 * cs;
                        *(u32x4*)(rowp + bj * HALF) = pack8(o1, o2); } }
        } else if (pn >= 16 && pn < 24) {
#pragma unroll
            for (int ai = 0; ai < 2; ++ai)
#pragma unroll
                for (int m = 0; m < 4; ++m) { const int row = row0 + ai * HALF + m * 16; bf16_t* rowp = Z + (size_t)row * 1024 + (((pn - 16) * 256 + cw) >> 1);
#pragma unroll
                    for (int bj = 0; bj < 2; ++bj) { const f32x4 z = acc[ai][bj][m][0] * acc[ai][bj][m][1]; u32x2 w; w.x = cvtpk(z[0], z[1]); w.y = cvtpk(z[2], z[3]);
                        *(u32x2*)(rowp + bj * (HALF / 2)) = w; } }
        } else {
            bf16_t* base; int ld, mode;
            if (pn < 8) { base = V + (pn - 4) * 256; ld = 1024; mode = 0; }
            else if (pn < 12) { base = OGCB + (pn - 8) * 256; ld = 2048; mode = 1; }
            else if (pn < 16) { base = OGCB + 1024 + (pn - 12) * 256; ld = 2048; mode = 0; }
            else { base = GATES + (pn - 24) * 256; ld = 2048; mode = 2; }
#pragma unroll
            for (int ai = 0; ai < 2; ++ai)
#pragma unroll
                for (int m = 0; m < 4; ++m) { const int row = row0 + ai * HALF + m * 16; bf16_t* rowp = base + (size_t)row * ld + cw;
#pragma unroll
                    for (int bj = 0; bj < 2; ++bj) { f32x4 v0 = acc[ai][bj][m][0], v1 = acc[ai][bj][m][1];
                        if (mode != 0) {
#pragma unroll
                            for (int i = 0; i < 4; ++i) { const float s0 = sigmoidf_(v0[i]), s1 = sigmoidf_(v1[i]); v0[i] = mode == 1 ? v0[i] * s0 : s0; v1[i] = mode == 1 ? v1[i] * s1 : s1; } }
                        *(u32x4*)(rowp + bj * HALF) = pack8(v0, v1); } }
        }
    }
};

struct EpiMerge {
    static constexpr bool PERM = true, AFTER_DRAIN = false, HAS_MID = true;
    const bf16_t* GATES; bf16_t* MERGED;
    __device__ __forceinline__ void mid(f32x4 (&acc)[2][2][4][2], const Unit& u, int wr, int wc, int fr, int fq) const {
        const int row0 = u.pm * BM + wr * 64 + fr, col0 = u.pn * BM + wc * 32 + 8 * fq;
#pragma unroll
        for (int ai = 0; ai < 2; ++ai)
#pragma unroll
            for (int m = 0; m < 4; ++m) { const bf16_t* rowp = GATES + (size_t)(row0 + ai * HALF + m * 16) * 2048 + col0;
#pragma unroll
                for (int bj = 0; bj < 2; ++bj) { const u32x4 ga = *(const u32x4*)(rowp + bj * HALF), gb = *(const u32x4*)(rowp + 1024 + bj * HALF);
#pragma unroll
                    for (int j = 0; j < 4; ++j) { const float a0 = bflo(ga[j]), a1 = bfhi(ga[j]); const float b0 = fmaxf(bflo(gb[j]), 1e-30f), b1 = fmaxf(bfhi(gb[j]), 1e-30f);
                        acc[ai][bj][m][j >> 1][2 * (j & 1)] *= a0 * fast_rcp(b0); acc[ai][bj][m][j >> 1][2 * (j & 1) + 1] *= a1 * fast_rcp(b1); } } }
    }
    __device__ __forceinline__ void operator()(const f32x4 (&acc)[2][2][4][2], const Unit& u, int wr, int wc, int fr, int fq) const {
        const int row0 = u.pm * BM + wr * 64 + fr, col0 = u.pn * BM + wc * 32 + 8 * fq;
#pragma unroll
        for (int ai = 0; ai < 2; ++ai)
#pragma unroll
            for (int m = 0; m < 4; ++m) { const int row = row0 + ai * HALF + m * 16; const bf16_t* gp = GATES + (size_t)row * 2048 + 1024 + col0; bf16_t* op = MERGED + (size_t)row * 1024 + col0;
#pragma unroll
                for (int bj = 0; bj < 2; ++bj) { const u32x4 gb = *(const u32x4*)(gp + bj * HALF); f32x4 v0 = acc[ai][bj][m][0], v1 = acc[ai][bj][m][1];
                    v0[0] *= fmaxf(bflo(gb[0]), 1e-30f); v0[1] *= fmaxf(bfhi(gb[0]), 1e-30f); v0[2] *= fmaxf(bflo(gb[1]), 1e-30f); v0[3] *= fmaxf(bfhi(gb[1]), 1e-30f);
                    v1[0] *= fmaxf(bflo(gb[2]), 1e-30f); v1[1] *= fmaxf(bfhi(gb[2]), 1e-30f); v1[2] *= fmaxf(bflo(gb[3]), 1e-30f); v1[3] *= fmaxf(bfhi(gb[3]), 1e-30f);
                    *(u32x4*)(op + bj * HALF) = pack8(v0, v1); } }
    }
};

struct EpiRes1 {
    static constexpr bool PERM = true, AFTER_DRAIN = false, HAS_MID = false;
    const float* x; float* h1; bf16_t* hhat; const float* modf; const float* norm2w; float* ssq;
    __device__ __forceinline__ void mid(f32x4 (&)[2][2][4][2], const Unit&, int, int, int, int) const {}
    __device__ __forceinline__ void operator()(const f32x4 (&acc)[2][2][4][2], const Unit& u, int wr, int wc, int fr, int fq) const {
        const int row0 = u.pm * BM + wr * 64 + fr, col0 = u.pn * BM + wc * 32 + 8 * fq, b = u.pm >> 4;
        f32x4 g1[2][2], cs[2][2];
#pragma unroll
        for (int bj = 0; bj < 2; ++bj)
#pragma unroll
            for (int n = 0; n < 2; ++n) { const int c = col0 + bj * HALF + 4 * n; g1[bj][n] = *(const f32x4*)(modf + b * 6144 + 2048 + c);
                const f32x4 sc = *(const f32x4*)(modf + b * 6144 + 4096 + c), w = *(const f32x4*)(norm2w + c); cs[bj][n] = w * (sc + 1.0f); }
#pragma unroll
        for (int ai = 0; ai < 2; ++ai)
#pragma unroll
            for (int m = 0; m < 4; ++m) { const int row = row0 + ai * HALF + m * 16; const size_t off = (size_t)row * 1024 + col0; float q = 0.f;
#pragma unroll
                for (int bj = 0; bj < 2; ++bj) { const f32x4 x0 = *(const f32x4*)(x + off + bj * HALF), x1 = *(const f32x4*)(x + off + bj * HALF + 4);
                    const f32x4 h0 = x0 + g1[bj][0] * acc[ai][bj][m][0], hb = x1 + g1[bj][1] * acc[ai][bj][m][1];
                    *(f32x4*)(h1 + off + bj * HALF) = h0; *(f32x4*)(h1 + off + bj * HALF + 4) = hb;
                    q += (h0[0] * h0[0] + h0[1] * h0[1]) + (h0[2] * h0[2] + h0[3] * h0[3]) + (hb[0] * hb[0] + hb[1] * hb[1]) + (hb[2] * hb[2] + hb[3] * hb[3]);
                    *(u32x4*)(hhat + off + bj * HALF) = pack8(h0 * cs[bj][0], hb * cs[bj][1]); }
                q += __shfl_xor(q, 16); q += __shfl_xor(q, 32);
                if (fq == 0) ssq[(size_t)row * 16 + u.pn * 4 + wc] = q; }
    }
};

struct EpiFF1 {
    static constexpr bool PERM = true, AFTER_DRAIN = false, HAS_MID = false;
    const float* bias2; const PG8_LAS float* rstd; bf16_t* HID;
    __device__ __forceinline__ void mid(f32x4 (&)[2][2][4][2], const Unit&, int, int, int, int) const {}
    __device__ __forceinline__ void operator()(const f32x4 (&acc)[2][2][4][2], const Unit& u, int wr, int wc, int fr, int fq) const {
        const int rl0 = wr * 64 + fr, col0 = u.pn * BM + wc * 32 + 8 * fq, b = u.pm >> 4;
        f32x4 bv[2][2];
#pragma unroll
        for (int bj = 0; bj < 2; ++bj)
#pragma unroll
            for (int n = 0; n < 2; ++n) bv[bj][n] = *(const f32x4*)(bias2 + b * 4096 + col0 + bj * HALF + 4 * n);
#pragma unroll
        for (int ai = 0; ai < 2; ++ai)
#pragma unroll
            for (int m = 0; m < 4; ++m) { const int rl = rl0 + ai * HALF + m * 16; const float rs = rstd[rl]; bf16_t* op = HID + (size_t)(u.pm * BM + rl) * 4096 + col0;
#pragma unroll
                for (int bj = 0; bj < 2; ++bj) { f32x4 v0 = acc[ai][bj][m][0] * rs + bv[bj][0], v1 = acc[ai][bj][m][1] * rs + bv[bj][1];
#pragma unroll
                    for (int i = 0; i < 4; ++i) { const float a = fmaxf(v0[i], 0.f), c = fmaxf(v1[i], 0.f); v0[i] = a * a; v1[i] = c * c; }
                    *(u32x4*)(op + bj * HALF) = pack8(v0, v1); } }
    }
};

struct EpiRes2 {
    static constexpr bool PERM = true, AFTER_DRAIN = false, HAS_MID = false;
    const float* h; float* ho; const float* modf; float* ssq;
    __device__ __forceinline__ void mid(f32x4 (&)[2][2][4][2], const Unit&, int, int, int, int) const {}
    __device__ __forceinline__ void operator()(const f32x4 (&acc)[2][2][4][2], const Unit& u, int wr, int wc, int fr, int fq) const {
        const int row0 = u.pm * BM + wr * 64 + fr, col0 = u.pn * BM + wc * 32 + 8 * fq, b = u.pm >> 4;
        f32x4 g2[2][2];
#pragma unroll
        for (int bj = 0; bj < 2; ++bj)
#pragma unroll
            for (int n = 0; n < 2; ++n) g2[bj][n] = *(const f32x4*)(modf + b * 6144 + 5120 + col0 + bj * HALF + 4 * n);
#pragma unroll
        for (int ai = 0; ai < 2; ++ai)
#pragma unroll
            for (int m = 0; m < 4; ++m) { const int row = row0 + ai * HALF + m * 16; const size_t off = (size_t)row * 1024 + col0; float q = 0.f;
#pragma unroll
                for (int bj = 0; bj < 2; ++bj) { const f32x4 x0 = *(const f32x4*)(h + off + bj * HALF), x1 = *(const f32x4*)(h + off + bj * HALF + 4);
                    const f32x4 h0 = x0 + g2[bj][0] * acc[ai][bj][m][0], hb = x1 + g2[bj][1] * acc[ai][bj][m][1];
                    *(f32x4*)(ho + off + bj * HALF) = h0; *(f32x4*)(ho + off + bj * HALF + 4) = hb;
                    q += (h0[0] * h0[0] + h0[1] * h0[1]) + (h0[2] * h0[2] + h0[3] * h0[3]) + (hb[0] * hb[0] + hb[1] * hb[1]) + (hb[2] * hb[2] + hb[3] * hb[3]); }
                q += __shfl_xor(q, 16); q += __shfl_xor(q, 32);
                if (fq == 0) ssq[(size_t)row * 16 + u.pn * 4 + wc] = q; }
    }
};

template <class Epi, class Sched, bool ALIGN_EPI = false, bool SP2 = false>
__device__ __forceinline__ void gemm_phase(PG8_LAS unsigned char* lds, const Gemm g, const Sched& S, const Epi& E, const int wid) {
    const int lane = lane_id_v(), tid = wid * 64 + lane, wr = wid >> 2, wc = wid & 3, fr = lane & 15, fq = lane >> 4;
    const int K = g.K, nt = K / BK;
    unsigned voffA[2], voffB[2];
#pragma unroll
    for (int i = 0; i < 2; ++i) { int R, C; stage_rc(tid * 16 + i * 8192, R, C); const int Rb = Epi::PERM ? ((R & ~31) + perm32(R & 31)) : R;
        voffA[i] = (unsigned)(R * K + C) * 2u; voffB[i] = (unsigned)(Rb * K + C) * 2u; }
    const size_t kstep = (size_t)(BK * 2);
    const size_t hstep = (size_t)HALF * K * 2;
    const size_t tstep = 2 * hstep;
    const unsigned ldsw = (unsigned)wid * 1024u;
    const int aoff = lds_byte(wr * 64 + fr, fq * 8), boff = lds_byte(wc * 32 + fr, fq * 8);
#define PG8_SA(b, h) (((b) * 2 + (h)) * HTB)
#define PG8_SB(b, h) ((4 + (b) * 2 + (h)) * HTB)
#define PG8_STAGE(bufoff, gbase, voff) do { _Pragma("unroll") for (int _i = 0; _i < 2; ++_i) \
        __builtin_amdgcn_global_load_lds((const unsigned*)((const char*)(gbase) + (voff)[_i]), (PG8_LAS unsigned*)(lds + (bufoff) + ldsw + _i * 8192), 16, 0, 0); } while (0)
#define PG8_LDA(dst, b, h) do { _Pragma("unroll") for (int m = 0; m < 4; ++m) _Pragma("unroll") for (int k = 0; k < 2; ++k) dst[m][k] = *(const PG8_LAS bf16x8*)(lds + PG8_SA(b, h) + aoff + m * 2048 + k * 1024); } while (0)
#define PG8_LDB(dst, b, h) do { _Pragma("unroll") for (int n = 0; n < 2; ++n) _Pragma("unroll") for (int k = 0; k < 2; ++k) dst[n][k] = *(const PG8_LAS bf16x8*)(lds + PG8_SB(b, h) + boff + n * 2048 + k * 1024); } while (0)
#define PG8_MMA(ai, bj, At, Bt) do { __builtin_amdgcn_s_setprio(1); _Pragma("unroll") for (int m = 0; m < 4; ++m) _Pragma("unroll") for (int n = 0; n < 2; ++n) _Pragma("unroll") for (int k = 0; k < 2; ++k) \
        acc[ai][bj][m][n] = __builtin_amdgcn_mfma_f32_16x16x32_bf16(Bt[n][k], At[m][k], acc[ai][bj][m][n], 0, 0, 0); __builtin_amdgcn_s_setprio(0); } while (0)
#define PG8_WAIT_V(n) asm volatile("s_waitcnt vmcnt(" #n ")" ::: "memory")
#define PG8_WAIT_L(n) asm volatile("s_waitcnt lgkmcnt(" #n ")" ::: "memory")
#define PG8_BAR __builtin_amdgcn_s_barrier()
#define PG8_SCHED __builtin_amdgcn_sched_barrier(0)
    Unit cur, nxt; int ui = 0;
    if (!S.next(0, cur)) return;
    f32x4 acc[2][2][4][2];
#pragma unroll
    for (int a = 0; a < 2; ++a)
#pragma unroll
        for (int b = 0; b < 2; ++b)
#pragma unroll
            for (int m = 0; m < 4; ++m)
#pragma unroll
                for (int n = 0; n < 2; ++n) acc[a][b][m][n] = (f32x4){0.f, 0.f, 0.f, 0.f};
    bf16x8 At[4][2], B0[2][2], B1[2][2];
    const char* cA = (const char*)g.A + (size_t)cur.pm * tstep; const char* cB = (const char*)g.Bt + (size_t)cur.pn * tstep;
    S.a_ready(cur);
    if constexpr (SP2) {
        PG8_STAGE(PG8_SB(0, 0), cB, voffB); PG8_STAGE(PG8_SB(0, 1), cB + hstep, voffB); PG8_STAGE(PG8_SA(0, 0), cA, voffA); PG8_STAGE(PG8_SA(0, 1), cA + hstep, voffA);
        if (wr == 1) PG8_BAR;
        PG8_WAIT_V(2); PG8_BAR;
        PG8_STAGE(PG8_SB(1, 0), cB + kstep, voffB); PG8_STAGE(PG8_SA(1, 0), cA + kstep, voffA); PG8_STAGE(PG8_SB(1, 1), cB + hstep + kstep, voffB);
        PG8_WAIT_V(6); PG8_BAR;
    } else {
        PG8_STAGE(PG8_SB(0, 0), cB, voffB); PG8_STAGE(PG8_SA(0, 0), cA, voffA); PG8_STAGE(PG8_SB(0, 1), cB + hstep, voffB); PG8_STAGE(PG8_SA(0, 1), cA + hstep, voffA);
        if (wr == 1) PG8_BAR;
        PG8_WAIT_V(4); PG8_BAR;
        PG8_STAGE(PG8_SB(1, 0), cB + kstep, voffB); PG8_STAGE(PG8_SA(1, 0), cA + kstep, voffA); PG8_STAGE(PG8_SB(1, 1), cB + hstep + kstep, voffB);
        PG8_WAIT_V(6); PG8_BAR;
    }
    for (;;) {
        const bool has_next = S.next(ui + 1, nxt);
        const char* nA = has_next ? (const char*)g.A + (size_t)nxt.pm * tstep : cA; const char* nB = has_next ? (const char*)g.Bt + (size_t)nxt.pn * tstep : cB;
        for (int t = 0; t < nt; t += 2) {
            if constexpr (Epi::HAS_MID) { if (t == (nt >> 1)) { int fr_e = fr, fq_e = fq; asm volatile("" : "+v"(fr_e), "+v"(fq_e)); E.mid(acc, cur, wr, wc, fr_e, fq_e); } }
            const bool last = (t == nt - 2);
            const char* a1 = cA + (size_t)(t + 1) * kstep;
            const char* a2 = last ? nA : cA + (size_t)(t + 2) * kstep; const char* b2 = last ? nB : cB + (size_t)(t + 2) * kstep;
            const char* a3 = a2 + kstep; const char* b3 = b2 + kstep;
            if (last && has_next) S.a_ready(nxt);
            if constexpr (SP2) {
            PG8_LDB(B0, 0, 0); PG8_LDB(B1, 0, 1); PG8_SCHED; PG8_LDA(At, 0, 0); PG8_STAGE(PG8_SA(1, 1), a1 + hstep, voffA);
            PG8_WAIT_V(8); PG8_WAIT_L(0); PG8_BAR; PG8_MMA(0, 0, At, B0); PG8_MMA(0, 1, At, B1); PG8_BAR; PG8_SCHED;
            PG8_LDA(At, 0, 1); PG8_STAGE(PG8_SB(0, 0), b2, voffB); PG8_STAGE(PG8_SB(0, 1), b2 + hstep, voffB); PG8_STAGE(PG8_SA(0, 0), a2, voffA);
            PG8_WAIT_V(8); PG8_WAIT_L(0); PG8_BAR; PG8_MMA(1, 0, At, B0); PG8_MMA(1, 1, At, B1); PG8_BAR; PG8_SCHED;
            PG8_LDB(B0, 1, 0); PG8_LDB(B1, 1, 1); PG8_SCHED; PG8_LDA(At, 1, 0); PG8_STAGE(PG8_SA(0, 1), a2 + hstep, voffA);
            PG8_WAIT_V(8); PG8_WAIT_L(0); PG8_BAR; PG8_MMA(0, 0, At, B0); PG8_MMA(0, 1, At, B1); PG8_BAR; PG8_SCHED;
            PG8_LDA(At, 1, 1); PG8_STAGE(PG8_SB(1, 0), b3, voffB); PG8_STAGE(PG8_SB(1, 1), b3 + hstep, voffB); PG8_STAGE(PG8_SA(1, 0), a3, voffA);
            PG8_WAIT_V(8); PG8_WAIT_L(0); PG8_BAR; PG8_MMA(1, 0, At, B0); PG8_MMA(1, 1, At, B1); PG8_BAR; PG8_SCHED;
            } else {
            PG8_LDB(B0, 0, 0); PG8_SCHED; PG8_LDA(At, 0, 0); PG8_STAGE(PG8_SA(1, 1), a1 + hstep, voffA);
            PG8_WAIT_L(8); PG8_BAR; PG8_WAIT_L(0); PG8_MMA(0, 0, At, B0); PG8_BAR; PG8_SCHED;
            PG8_LDB(B1, 0, 1); PG8_STAGE(PG8_SB(0, 0), b2, voffB);
            PG8_BAR; PG8_WAIT_L(0); PG8_MMA(0, 1, At, B1); PG8_BAR;
            PG8_LDA(At, 0, 1); PG8_STAGE(PG8_SA(0, 0), a2, voffA);
            PG8_BAR; PG8_WAIT_L(0); PG8_MMA(1, 0, At, B0); PG8_BAR; PG8_SCHED;
            PG8_STAGE(PG8_SB(0, 1), b2 + hstep, voffB);
            PG8_WAIT_V(6); PG8_BAR; PG8_MMA(1, 1, At, B1); PG8_BAR;
            PG8_LDB(B0, 1, 0); PG8_SCHED; PG8_LDA(At, 1, 0); PG8_STAGE(PG8_SA(0, 1), a2 + hstep, voffA);
            PG8_WAIT_L(8); PG8_BAR; PG8_WAIT_L(0); PG8_MMA(0, 0, At, B0); PG8_BAR; PG8_SCHED;
            PG8_LDB(B1, 1, 1); PG8_STAGE(PG8_SB(1, 0), b3, voffB);
            PG8_BAR; PG8_WAIT_L(0); PG8_MMA(0, 1, At, B1); PG8_BAR;
            PG8_LDA(At, 1, 1); PG8_STAGE(PG8_SA(1, 0), a3, voffA);
            PG8_BAR; PG8_WAIT_L(0); PG8_MMA(1, 0, At, B0); PG8_BAR; PG8_SCHED;
            PG8_STAGE(PG8_SB(1, 1), b3 + hstep, voffB);
            PG8_WAIT_V(6); PG8_BAR; PG8_MMA(1, 1, At, B1); PG8_BAR;
            }
        }
        if constexpr (ALIGN_EPI) { if (wr == 0) PG8_BAR; }
        if constexpr (!Epi::AFTER_DRAIN) { int fr_e = fr, fq_e = fq; asm volatile("" : "+v"(fr_e), "+v"(fq_e));
            E(acc, cur, wr, wc, fr_e, fq_e); S.done(cur); }
        if (!has_next) break;
#pragma unroll
        for (int a = 0; a < 2; ++a)
#pragma unroll
            for (int b = 0; b < 2; ++b)
#pragma unroll
                for (int m = 0; m < 4; ++m)
#pragma unroll
                    for (int n = 0; n < 2; ++n) acc[a][b][m][n] = (f32x4){0.f, 0.f, 0.f, 0.f};
        cur = nxt; cA = nA; cB = nB; ++ui;
        if constexpr (ALIGN_EPI) { if (wr == 1) PG8_BAR; }
    }
    PG8_WAIT_V(0);
    if constexpr (!ALIGN_EPI) { if (wr == 0) PG8_BAR; }
    PG8_BAR;
    if constexpr (Epi::AFTER_DRAIN) { E.fused(acc, cur, wr, wc, fr, fq, lds, wid, lane); S.done(cur); }
#undef PG8_SA
#undef PG8_SB
#undef PG8_STAGE
#undef PG8_LDA
#undef PG8_LDB
#undef PG8_MMA
#undef PG8_WAIT_V
#undef PG8_WAIT_L
#undef PG8_BAR
#undef PG8_SCHED
}
}

#define GAS __attribute__((address_space(1)))
#define LAS __attribute__((address_space(3)))
typedef unsigned short bf16;
typedef unsigned v4u __attribute__((ext_vector_type(4)));
typedef float f32x4 __attribute__((ext_vector_type(4)));
typedef short bf16x8 __attribute__((ext_vector_type(8)));
typedef GAS unsigned gu32;
typedef GAS unsigned long long gu64;
#define RLX_AGENT __ATOMIC_RELAXED, __HIP_MEMORY_SCOPE_AGENT
#define LDS_WAIT() asm volatile("s_waitcnt lgkmcnt(0)" ::: "memory")
#define VM_WAIT() asm volatile("s_waitcnt vmcnt(0)" ::: "memory")
__device__ __forceinline__ unsigned long long rt() { return __builtin_amdgcn_s_memrealtime(); }
__device__ __forceinline__ unsigned f2bf(float f) { unsigned u = __builtin_bit_cast(unsigned, f); return (u + 0x7fffu + ((u >> 16) & 1u)) >> 16; }
__device__ __forceinline__ unsigned pk2(float lo, float hi) { return f2bf(lo) | (f2bf(hi) << 16); }

#define XB_TMO      128
#define XB_XCNT(j)  (256  + 64 * (j))
#define XB_XSUB(j)  (1280 + 64 * (j))
#define XB_XGEN(j)  (2304 + 64 * (j))
#define XB_TOP      3328
#define XB_TOPGEN   3392
#define XCD_BAR_WORDS 3456
#define XB_SPIN_CAP (1u << 18)

__device__ __forceinline__ unsigned xb_ld(unsigned* p)              { return __hip_atomic_load(p, __ATOMIC_RELAXED, __HIP_MEMORY_SCOPE_AGENT); }
__device__ __forceinline__ unsigned xb_add(unsigned* p, unsigned v) { return __hip_atomic_fetch_add(p, v, __ATOMIC_RELAXED, __HIP_MEMORY_SCOPE_AGENT); }
__device__ __forceinline__ unsigned xb_xcc_id() { return (unsigned)__builtin_amdgcn_s_getreg((3 << 11) | 20) & 0xFu; }
#define XB_SPIN(cond, bar) do { unsigned _sp = 0; while (cond) { __builtin_amdgcn_s_sleep(1); \
    if ((++_sp & 255u) == 0u) { if (xb_ld(&(bar)[XB_TMO])) break; if (_sp > XB_SPIN_CAP) { atomicAdd(&(bar)[XB_TMO], 1u); break; } } } } while (0)

struct XcdBarrier {
    unsigned* bar; unsigned x;
    volatile LAS unsigned* st;
};

__device__ __forceinline__ XcdBarrier xcd_barrier_post(unsigned* bar, volatile LAS unsigned* st, const int wave) {
    XcdBarrier b; b.bar = bar; b.x = xb_xcc_id(); b.st = st;
    if (wave == 0 && pg8::lane_id_v() == 0) (void)xb_add(&bar[XB_XCNT(b.x)], 1u);
    return b;
}
__device__ __forceinline__ void xcd_barrier_complete(unsigned* bar, unsigned x, unsigned& nloc, unsigned& nx) {
    const unsigned G = gridDim.x * gridDim.y * gridDim.z;
    unsigned sum, cnt, mine, sp = 0u;
    for (;;) {
        sum = 0u; cnt = 0u; mine = 0u;
#pragma unroll
        for (unsigned j = 0; j < 16; ++j) { const unsigned c = xb_ld(&bar[XB_XCNT(j)]); sum += c; cnt += (c > 0u) ? 1u : 0u; mine = (j == x) ? c : mine; }
        if (sum == G) break;
        __builtin_amdgcn_s_sleep(1);
        if ((++sp & 255u) == 0u) { if (xb_ld(&bar[XB_TMO])) break; if (sp > XB_SPIN_CAP) { atomicAdd(&bar[XB_TMO], 1u); break; } }
    }
    nloc = mine > 0u ? mine : 1u; nx = cnt > 0u ? cnt : 1u;
}

__device__ __forceinline__ void xcd_barrier(const XcdBarrier& b, const int wave) {
    asm volatile("s_waitcnt vmcnt(0)" ::: "memory");
    __syncthreads();
    if (wave == 0 && pg8::lane_id_v() == 0) {
        unsigned* bar = b.bar;
        __builtin_amdgcn_s_waitcnt(0);
        unsigned nloc = b.st[0], nx = b.st[1];
        if (nloc == 0u) { xcd_barrier_complete(bar, b.x, nloc, nx); b.st[0] = nloc; b.st[1] = nx; }
        const unsigned old = xb_add(&bar[XB_XSUB(b.x)], 1u);
        const unsigned gen = old / nloc;
        if (old + 1u == (gen + 1u) * nloc) {
            __builtin_amdgcn_fence(__ATOMIC_RELEASE, "agent");
            asm volatile("s_waitcnt vmcnt(0)" ::: "memory");
            const unsigned og = xb_add(&bar[XB_TOP], 1u);
            const unsigned tg = og / nx;
            if (og + 1u == (tg + 1u) * nx) xb_add(&bar[XB_TOPGEN], 1u);
            else XB_SPIN(xb_ld(&bar[XB_TOPGEN]) == tg, bar);
            __builtin_amdgcn_fence(__ATOMIC_ACQUIRE, "agent");
            xb_add(&bar[XB_XGEN(b.x)], 1u);
            asm volatile("s_waitcnt vmcnt(0)" ::: "memory");
        } else {
            XB_SPIN(xb_ld(&bar[XB_XGEN(b.x)]) == gen, bar);
            __builtin_amdgcn_fence(__ATOMIC_ACQUIRE, "agent");
            asm volatile("s_waitcnt vmcnt(0)" ::: "memory");
        }
    }
    __syncthreads();
}


constexpr int NWAVES = 8;
constexpr int BATCH = 4, SEQ = 4096, D = 1024, M = BATCH * SEQ, NPROJ = 8192, FF = 4096, NMOD = 6 * D;
constexpr int RH = 4, DK = 128, DV = 256, SCH = 256  , NJ = SEQ / SCH  ;
constexpr float EPS = 1e-6f;
constexpr int KS_MOD = 8;
constexpr size_t MiB = 1u << 20;
constexpr size_t WS_CTL = 0, CTL_ZERO_BYTES = 1 * MiB;
constexpr size_t WS_MODP = 1 * MiB;
constexpr size_t WS_MODF = 2 * MiB + 512 * 1024;
constexpr size_t WS_BIAS2 = WS_MODF + 128 * 1024;
constexpr size_t WS_SSQ2 = 3 * MiB, WS_SSQ3 = 4 * MiB;
constexpr size_t WS_WIN = 5 * MiB, WS_WRC = 21 * MiB, WS_WO = 25 * MiB, WS_W1 = 27 * MiB, WS_W2 = 35 * MiB;
constexpr size_t WS_ST = WS_WIN;
constexpr size_t WS_QK = 44 * MiB, WS_V = 76 * MiB, WS_OGCB = 108 * MiB, WS_GATES = 172 * MiB, WS_END = 236 * MiB;
constexpr size_t WS_MERGED = WS_QK, WS_HHAT = WS_GATES, WS_HID = WS_QK;
constexpr size_t OUT_U = 0, OUT_Z = 32 * MiB, OUT_KV = 0;
static_assert(WS_W2 + (size_t)D * FF * 2 <= WS_QK && WS_HID + (size_t)M * FF * 2 <= WS_GATES, "d_ws map");
constexpr int CW_TMO = 0, CW_BAR = 4096;
constexpr int RING_OFF = 0, PHASE_BYTES = 139264, LDSCTL_OFF = PHASE_BYTES, MISC_OFF = LDSCTL_OFF + 320, TAB_OFF = LDSCTL_OFF + 1024, LDS_BYTES = PHASE_BYTES + 4096;

struct Frame {
    LAS unsigned char* lds; volatile LAS unsigned* MISC; gu32* ctl;
    int wave, vcu, G;
    const float *x, *c, *w_ada, *b_ada, *norm1_w, *w_in, *ret_gn_w, *conv_w, *w_ret_out, *w_conv_out, *w_o, *norm2_w, *w_ff1, *w_ff2, *final_norm_w; const int* positions;
    float* out; unsigned char* ws;
};
__device__ __forceinline__ float wave_sum(float v) {
#pragma unroll
    for (int o = 1; o < 64; o <<= 1) v += __shfl_xor(v, o);
    return v;
}
__device__ __forceinline__ unsigned cvtpk2(float lo, float hi) { return pg8::cvtpk(lo, hi); }

__device__ __forceinline__ int vmap_in(int n) {
    if (n < 1024) { const int hb = n & ~127, d = n & 127; const int dd = d & 63; return hb + 8 * (dd >> 2) + (d >= 64 ? 4 : 0) + (dd & 3); }
    if (n >= 4096 && n < 6144) { const int j = (n - 4096) & 1023; return 4096 + 8 * (j >> 2) + (n >= 5120 ? 4 : 0) + (j & 3); }
    return n;
}
struct P0Tile { const float* W; bf16* WT; int N, ldt, kofs, k0, n0, vm; };
__device__ __forceinline__ P0Tile p0_tile(const Frame& F, int t) {
    P0Tile T; int r = t;
    if (r < 512) { T.W = F.w_in; T.WT = (bf16*)(F.ws + WS_WIN); T.N = NPROJ; T.ldt = D; T.kofs = 0; T.vm = 1; T.n0 = 512 * (r >> 5); T.k0 = 32 * (r & 31); return T; } r -= 512;
    if (r < 64) { T.W = F.w_ret_out; T.WT = (bf16*)(F.ws + WS_WRC); T.N = D; T.ldt = 2 * D; T.kofs = 0; T.vm = 0; T.n0 = 512 * (r >> 5); T.k0 = 32 * (r & 31); return T; } r -= 64;
    if (r < 64) { T.W = F.w_conv_out; T.WT = (bf16*)(F.ws + WS_WRC); T.N = D; T.ldt = 2 * D; T.kofs = D; T.vm = 0; T.n0 = 512 * (r >> 5); T.k0 = 32 * (r & 31); return T; } r -= 64;
    if (r < 64) { T.W = F.w_o; T.WT = (bf16*)(F.ws + WS_WO); T.N = D; T.ldt = D; T.kofs = 0; T.vm = 0; T.n0 = 512 * (r >> 5); T.k0 = 32 * (r & 31); return T; } r -= 64;
    if (r < 256) { T.W = F.w_ff1; T.WT = (bf16*)(F.ws + WS_W1); T.N = FF; T.ldt = D; T.kofs = 0; T.vm = 0; T.n0 = 512 * (r >> 5); T.k0 = 32 * (r & 31); return T; } r -= 256;
    T.W = F.w_ff2; T.WT = (bf16*)(F.ws + WS_W2); T.N = D; T.ldt = FF; T.kofs = 0; T.vm = 0; T.n0 = 512 * (r >> 7); T.k0 = 32 * (r & 127); return T;
}
constexpr int P0_NTILES = 512 + 3 * 64 + 256 + 256;
__device__ __forceinline__ void p0_dma(const P0Tile& T, LAS unsigned char* buf, int wave, int lane) {
#pragma unroll
    for (int i = 0; i < 8; ++i) { const int row = 4 * wave + (i >> 1), half = i & 1;
        __builtin_amdgcn_global_load_lds((const unsigned*)(T.W + (size_t)(T.k0 + row) * T.N + T.n0 + half * 256 + lane * 4), (LAS unsigned*)(buf + row * 2048 + half * 1024), 16, 0, 2  ); }
}
__device__ __forceinline__ float siluf_(float x) { return x / (1.0f + __expf(-x)); }
__device__ __forceinline__ void p0_prologue(Frame& F) {
    const int lane_ = pg8::lane_id_v(), tid_ = F.wave * 64 + lane_; (void)tid_;
    const int gw = F.vcu * NWAVES + F.wave, NGW = F.G * NWAVES;
    for (int vb = F.vcu; vb < 32 * KS_MOD; vb += F.G) {
        const int cb = vb & 31, ks = vb >> 5, k0 = ks * (D / KS_MOD) + 16 * F.wave; const int col = 192 * cb + 4 * (lane_ < 48 ? lane_ : 0);
        f32x4 a0 = {0.f, 0.f, 0.f, 0.f}, a1 = a0, a2 = a0, a3 = a0;
        const float* wp = F.w_ada + (size_t)k0 * NMOD + col;
        f32x4 wv[16];
#pragma unroll
        for (int kk = 0; kk < 16; ++kk) wv[kk] = __builtin_nontemporal_load((const GAS f32x4*)(wp + (size_t)kk * NMOD));
#pragma unroll
        for (int kk = 0; kk < 16; ++kk) { const int k = k0 + kk; const float s0 = siluf_(F.c[k]), s1 = siluf_(F.c[D + k]), s2 = siluf_(F.c[2 * D + k]), s3 = siluf_(F.c[3 * D + k]);
            a0 += wv[kk] * s0; a1 += wv[kk] * s1; a2 += wv[kk] * s2; a3 += wv[kk] * s3; }
        LAS f32x4* red = (LAS f32x4*)(F.lds + RING_OFF);
        if (lane_ < 48) { LAS f32x4* rp = red + (F.wave * 4) * 48 + lane_; rp[0] = a0; rp[48] = a1; rp[96] = a2; rp[144] = a3; }
        __syncthreads();
        if (tid_ < 192) { f32x4 sacc = {0.f, 0.f, 0.f, 0.f};
#pragma unroll
            for (int w = 0; w < NWAVES; ++w) sacc += red[w * 192 + tid_];
            *(f32x4*)((float*)(F.ws + WS_MODP) + (size_t)ks * 4 * NMOD + (size_t)(tid_ / 48) * NMOD + 192 * cb + 4 * (tid_ % 48)) = sacc; }
        __syncthreads();
    }
    const int t0 = (int)(((long)F.vcu * P0_NTILES) / F.G), t1 = (int)(((long)(F.vcu + 1) * P0_NTILES) / F.G);
    if (t0 < t1) { const P0Tile T0 = p0_tile(F, t0); p0_dma(T0, F.lds + RING_OFF, F.wave, lane_); }
    for (int t = t0; t < t1; ++t) {
        LAS unsigned char* buf = F.lds + RING_OFF + ((t - t0) & 1) * 65536;
        const P0Tile T = p0_tile(F, t);
        __syncthreads();
        if (t + 1 < t1) { const P0Tile Tn = p0_tile(F, t + 1); p0_dma(Tn, F.lds + RING_OFF + ((t + 1 - t0) & 1) * 65536, F.wave, lane_); }
        float v[32];
#pragma unroll
        for (int k = 0; k < 32; ++k) v[k] = *(const LAS float*)(buf + k * 2048 + tid_ * 4);
        const int n = T.n0 + tid_, vr = T.vm ? vmap_in(n) : n;
        GAS v4u* dst = (GAS v4u*)(T.WT + (size_t)vr * T.ldt + T.kofs + T.k0);
#pragma unroll
        for (int c = 0; c < 4; ++c) { v4u o; o.x = cvtpk2(v[8 * c], v[8 * c + 1]); o.y = cvtpk2(v[8 * c + 2], v[8 * c + 3]); o.z = cvtpk2(v[8 * c + 4], v[8 * c + 5]); o.w = cvtpk2(v[8 * c + 6], v[8 * c + 7]); dst[c] = o; }
    }
    __syncthreads();
}

__device__ __forceinline__ float modp_sum(const float* modp, int idx) { float s = 0.f;
#pragma unroll
    for (int ks = 0; ks < KS_MOD; ++ks) s += modp[(size_t)ks * 4 * NMOD + idx];
    return s; }
__device__ __forceinline__ void p1_unorm(Frame& F) {
    const int lane_ = pg8::lane_id_v(), tid_ = F.wave * 64 + lane_; (void)tid_;
    const float* modp = (const float*)(F.ws + WS_MODP); float* modf = (float*)(F.ws + WS_MODF);
    const int blk = F.vcu;
    const int b = blk >> 6;
    LAS float* cs1 = (LAS float*)(F.lds + RING_OFF); LAS float* sh1 = cs1 + D;
    for (int k = tid_; k < D; k += NWAVES * 64) {
        const float sh = modp_sum(modp, b * NMOD + k) + F.b_ada[k], sc = modp_sum(modp, b * NMOD + D + k) + F.b_ada[D + k];
        cs1[k] = F.norm1_w[k] * (1.0f + sc); sh1[k] = sh; }
    if (tid_ < 96) { const int idx = blk * 96 + tid_; if (idx < 4 * NMOD) modf[idx] = modp_sum(modp, idx) + F.b_ada[idx % NMOD]; }
    __syncthreads();
    bf16* U = (bf16*)((unsigned char*)F.out + OUT_U);
    for (int r0 = 0; r0 < 8; r0 += 4) {
        f32x4 v[4][4]; float ss[4];
#pragma unroll
        for (int q = 0; q < 4; ++q) { const int m = blk * 64 + F.wave * 8 + r0 + q; const GAS f32x4* xr = (const GAS f32x4*)(F.x + (size_t)m * D) + lane_;
#pragma unroll
            for (int j = 0; j < 4; ++j) v[q][j] = __builtin_nontemporal_load(xr + 64 * j); }
#pragma unroll
        for (int q = 0; q < 4; ++q) { float s = 0.f;
#pragma unroll
            for (int j = 0; j < 4; ++j) s += (v[q][j].x * v[q][j].x + v[q][j].y * v[q][j].y) + (v[q][j].z * v[q][j].z + v[q][j].w * v[q][j].w);
            ss[q] = 1.0f / sqrtf(wave_sum(s) * (1.0f / D) + EPS); }
#pragma unroll
        for (int q = 0; q < 4; ++q) { const int m = blk * 64 + F.wave * 8 + r0 + q; GAS unsigned long long* o8 = (GAS unsigned long long*)(U + (size_t)m * D) + lane_;
#pragma unroll
            for (int j = 0; j < 4; ++j) { const int k = 4 * lane_ + 256 * j; const f32x4 a = *(const LAS f32x4*)(cs1 + k), sh = *(const LAS f32x4*)(sh1 + k);
                const f32x4 u = v[q][j] * ss[q] * a + sh;
                o8[64 * j] = (unsigned long long)cvtpk2(u.x, u.y) | ((unsigned long long)cvtpk2(u.z, u.w) << 32); } }
    }
}

typedef short s16x4 __attribute__((ext_vector_type(4)));
typedef float f32x16 __attribute__((ext_vector_type(16)));
#define MFMA32(a, b, c) __builtin_amdgcn_mfma_f32_32x32x16_bf16((a), (b), (c), 0, 0, 0)
__device__ __forceinline__ int crow(int reg, int hh) { return (reg & 3) + 8 * (reg >> 2) + 4 * hh; }
__device__ __forceinline__ bf16x8 tr_frag(LAS unsigned char* p) {
    const s16x4 lo = __builtin_amdgcn_ds_read_tr16_b64_v4i16((LAS s16x4*)p), hi = __builtin_amdgcn_ds_read_tr16_b64_v4i16((LAS s16x4*)(p + 512));
    return __builtin_shufflevector(lo, hi, 0, 1, 2, 3, 4, 5, 6, 7);
}
__device__ __forceinline__ float log2_gamma(int hd) { return log2f(1.0f - exp2f(-5.0f - (float)hd)); }
constexpr int RT_K = 0, RT_V = 8192, RT_BLK = 24576;
__device__ __forceinline__ void p3a_kvsum(Frame& F, int unit) {
    const int lane_ = pg8::lane_id_v(), tid_ = F.wave * 64 + lane_; (void)tid_;
    const int bh = unit >> 4, J = unit & 15, b = bh >> 2, hd = bh & 3;
    const bf16* QK = (const bf16*)(F.ws + WS_QK); const bf16* V = (const bf16*)(F.ws + WS_V);
    float* KV = (float*)((unsigned char*)F.out + OUT_KV) + (size_t)unit * (DV * DK);
    const int tid = tid_, lane = lane_, w = F.wave, r = lane & 31, hh = lane >> 5;
    const float l2g = log2_gamma(hd);
    const size_t mbase = (size_t)b * SEQ + (size_t)J * SCH;
    const int krow_ = tid >> 4, kch = tid & 15;
    const bf16* kp = QK + (mbase + krow_) * 1024 + 512 + hd * DK + kch * 8;
    const bf16* vp0 = V + (mbase + (tid >> 5)) * 1024 + hd * DV + (tid & 31) * 8;
    const int kdst = RT_K + (kch >> 2) * 2048 + krow_ * 64 + (kch & 3) * 16;
    const int vdst0 = RT_V + ((tid & 31) >> 2) * 2048 + (tid >> 5) * 64 + (tid & 3) * 16;
    const int lane_off = (4 * hh + ((lane & 15) >> 2)) * 64 + ((lane >> 4) & 1) * 32 + (lane & 3) * 8;
    f32x16 acc[4];
#pragma unroll
    for (int d = 0; d < 4; ++d)
#pragma unroll
        for (int i = 0; i < 16; ++i) acc[d][i] = 0.f;
    v4u kreg = *(const GAS v4u*)kp, vreg0 = *(const GAS v4u*)vp0, vreg1 = *(const GAS v4u*)(vp0 + 16 * 1024);
    for (int sb = 0; sb < 8; ++sb) {
        __syncthreads();
        { const float dec = __builtin_amdgcn_exp2f((float)(255 - (32 * sb + krow_)) * l2g); v4u o;
#pragma unroll
          for (int j = 0; j < 4; ++j) o[j] = cvtpk2(pg8::bflo(kreg[j]) * dec, pg8::bfhi(kreg[j]) * dec);
          *(LAS v4u*)(F.lds + kdst) = o; *(LAS v4u*)(F.lds + vdst0) = vreg0; *(LAS v4u*)(F.lds + vdst0 + 16 * 64) = vreg1; }
        __syncthreads();
        if (sb < 7) { const size_t o = (size_t)(sb + 1) * 32 * 1024; kreg = *(const GAS v4u*)(kp + o); vreg0 = *(const GAS v4u*)(vp0 + o); vreg1 = *(const GAS v4u*)(vp0 + o + 16 * 1024); }
#pragma unroll
        for (int ks2 = 0; ks2 < 2; ++ks2) {
            const bf16x8 bv = tr_frag(F.lds + RT_V + w * 2048 + ks2 * 1024 + lane_off);
#pragma unroll
            for (int d = 0; d < 4; ++d) { const bf16x8 ak = tr_frag(F.lds + RT_K + d * 2048 + ks2 * 1024 + lane_off); acc[d] = MFMA32(ak, bv, acc[d]); }
        }
    }
#pragma unroll
    for (int d = 0; d < 4; ++d)
#pragma unroll
        for (int g = 0; g < 4; ++g) { f32x4 o = {acc[d][4 * g], acc[d][4 * g + 1], acc[d][4 * g + 2], acc[d][4 * g + 3]};
            *(GAS f32x4*)(KV + (size_t)(32 * w + r) * DK + 32 * d + 8 * g + 4 * hh) = o; }
    __syncthreads();
}
__device__ __forceinline__ void p3a_conv(Frame& F, int blk) {
    const int lane_ = pg8::lane_id_v(), tid_ = F.wave * 64 + lane_; (void)tid_;
    bf16* OGCB = (bf16*)(F.ws + WS_OGCB); const bf16* Z = (const bf16*)((unsigned char*)F.out + OUT_Z);
    const int cc = tid_ & 127, rg = tid_ >> 7, m0 = blk * 64 + rg * 16, c0 = cc * 8;
    float w0[8], w1[8], w2[8];
#pragma unroll
    for (int e = 0; e < 8; ++e) { w0[e] = F.conv_w[c0 + e]; w1[e] = F.conv_w[D + c0 + e]; w2[e] = F.conv_w[2 * D + c0 + e]; }
    v4u zm2 = {0u, 0u, 0u, 0u}, zm1 = {0u, 0u, 0u, 0u};
    if ((m0 & (SEQ - 1)) != 0) { zm2 = *(const GAS v4u*)(Z + (size_t)(m0 - 2) * 1024 + c0); zm1 = *(const GAS v4u*)(Z + (size_t)(m0 - 1) * 1024 + c0); }
#pragma unroll 4
    for (int i = 0; i < 16; ++i) { const int m = m0 + i;
        const v4u z0 = *(const GAS v4u*)(Z + (size_t)m * 1024 + c0); bf16* cp = OGCB + (size_t)m * 2048 + 1024 + c0; const v4u cb = *(const GAS v4u*)cp; v4u o;
#pragma unroll
        for (int j = 0; j < 4; ++j) {
            const float lo = pg8::bflo(cb[j]) * (w0[2 * j] * pg8::bflo(zm2[j]) + w1[2 * j] * pg8::bflo(zm1[j]) + w2[2 * j] * pg8::bflo(z0[j]));
            const float hi = pg8::bfhi(cb[j]) * (w0[2 * j + 1] * pg8::bfhi(zm2[j]) + w1[2 * j + 1] * pg8::bfhi(zm1[j]) + w2[2 * j + 1] * pg8::bfhi(z0[j]));
            o[j] = cvtpk2(lo, hi); }
        *(GAS v4u*)cp = o; zm2 = zm1; zm1 = z0; }
}
__device__ __forceinline__ void p3a_bias2(Frame& F) {
    const int lane_ = pg8::lane_id_v(), tid_ = F.wave * 64 + lane_; (void)tid_;
    const float* modf = (const float*)(F.ws + WS_MODF); const bf16* W1_t = (const bf16*)(F.ws + WS_W1); float* bias2 = (float*)(F.ws + WS_BIAS2);
    const int gw = F.vcu * NWAVES + F.wave, NGW = F.G * NWAVES;
    for (int f = gw; f < FF; f += NGW) { float a[4] = {0.f, 0.f, 0.f, 0.f};
#pragma unroll
        for (int i = 0; i < 2; ++i) { const int k0 = (lane_ + 64 * i) * 8; const v4u wv = *(const GAS v4u*)(W1_t + (size_t)f * D + k0);
#pragma unroll
            for (int bb = 0; bb < 4; ++bb) { const float* sh = modf + bb * NMOD + 3 * D + k0; const f32x4 s0 = *(const f32x4*)sh, s1 = *(const f32x4*)(sh + 4);
                a[bb] += pg8::bflo(wv[0]) * s0[0] + pg8::bfhi(wv[0]) * s0[1] + pg8::bflo(wv[1]) * s0[2] + pg8::bfhi(wv[1]) * s0[3]
                       + pg8::bflo(wv[2]) * s1[0] + pg8::bfhi(wv[2]) * s1[1] + pg8::bflo(wv[3]) * s1[2] + pg8::bfhi(wv[3]) * s1[3]; } }
#pragma unroll
        for (int bb = 0; bb < 4; ++bb) { const float s = wave_sum(a[bb]); if (lane_ == 0) bias2[bb * FF + f] = s; } }
}
__device__ __forceinline__ void p3b_scan(Frame& F) {
    const int lane_ = pg8::lane_id_v(), tid_ = F.wave * 64 + lane_; (void)tid_;
    const float* KV = (const float*)((unsigned char*)F.out + OUT_KV); bf16* ST = (bf16*)(F.ws + WS_ST);
    const int NT = F.G * NWAVES * 64;
    for (int t = F.vcu * (NWAVES * 64) + tid_; t < 16 * (DV * DK / 4); t += NT) {
        const int bh = t / (DV * DK / 4), e = (t % (DV * DK / 4)) * 4; const float g = exp2f(256.0f * log2_gamma(bh & 3));
        f32x4 kv[NJ];
#pragma unroll
        for (int J = 0; J < NJ; ++J) kv[J] = *(const GAS f32x4*)(KV + ((size_t)(bh * NJ + J)) * (DV * DK) + e);
        f32x4 S = {0.f, 0.f, 0.f, 0.f};
#pragma unroll
        for (int J = 0; J < NJ; ++J) { *(GAS unsigned long long*)(ST + ((size_t)(bh * NJ + J)) * (DV * DK) + e) = (unsigned long long)cvtpk2(S[0], S[1]) | ((unsigned long long)cvtpk2(S[2], S[3]) << 32);
            S = S * g + kv[J]; }
    }
}
constexpr int RC_ST = 0, RC_STP = 272, RC_BLK0 = 69632, RC_STG = 528;
__device__ __forceinline__ void p3c_retout(Frame& F, int unit, bf16* OUTP, int oldp) {
    const int lane_ = pg8::lane_id_v(), tid_ = F.wave * 64 + lane_; (void)tid_;
    const int bh = unit >> 4, J = unit & 15, b = bh >> 2, hd = bh & 3;
    const bf16* QK = (const bf16*)(F.ws + WS_QK); const bf16* V = (const bf16*)(F.ws + WS_V); const bf16* ST = (const bf16*)(F.ws + WS_ST) + (size_t)unit * (DV * DK);
    bf16* OGCB = (bf16*)(F.ws + WS_OGCB);
    const int tid = tid_, lane = lane_, w = F.wave, r = lane & 31, hh = lane >> 5;
    const float l2g = log2_gamma(hd);
    const size_t mbase = (size_t)b * SEQ + (size_t)J * SCH;
    const int krow_ = tid >> 4, kch = tid & 15;
    const bf16* kp = QK + (mbase + krow_) * 1024 + 512 + hd * DK + kch * 8;
    const bf16* vp0 = V + (mbase + (tid >> 5)) * 1024 + hd * DV + (tid & 31) * 8;
    const int kdst = RT_K + (kch >> 2) * 2048 + krow_ * 64 + (kch & 3) * 16;
    const int vdst0 = RT_V + ((tid & 31) >> 2) * 2048 + (tid >> 5) * 64 + (tid & 3) * 16;
    const int lane_off = (4 * hh + ((lane & 15) >> 2)) * 64 + ((lane >> 4) & 1) * 32 + (lane & 3) * 8;
    v4u kreg = *(const GAS v4u*)kp, vreg0 = *(const GAS v4u*)vp0, vreg1 = *(const GAS v4u*)(vp0 + 16 * 1024);
#pragma unroll
    for (int i = 0; i < 8; ++i) { const int idx = tid + 512 * i, row = idx >> 4, ch = idx & 15; *(LAS v4u*)(F.lds + RC_ST + row * RC_STP + ch * 16) = *(const GAS v4u*)(ST + (size_t)row * DK + ch * 8); }
    bf16x8 qf[8];
    { const bf16* qp = QK + (mbase + 32 * w + r) * 1024 + hd * DK + 8 * hh;
#pragma unroll
      for (int ks = 0; ks < 8; ++ks) qf[ks] = *(const GAS bf16x8*)(qp + 16 * ks); }
    f32x16 acc[8];
#pragma unroll
    for (int c8 = 0; c8 < 8; ++c8)
#pragma unroll
        for (int i = 0; i < 16; ++i) acc[c8][i] = 0.f;
    __syncthreads();
#pragma unroll
    for (int c8 = 0; c8 < 8; ++c8)
        {
#pragma unroll
          for (int ks = 0; ks < 8; ++ks) { const bf16x8 sf = *(const LAS bf16x8*)(F.lds + RC_ST + (32 * c8 + r) * RC_STP + (16 * ks + 8 * hh) * 2); acc[c8] = MFMA32(qf[ks], sf, acc[c8]); } __builtin_amdgcn_sched_barrier(0); }
    int t1v = 32 * w + 4 * hh + 1; asm volatile("" : "+v"(t1v));
#pragma unroll
    for (int i = 0; i < 16; ++i) { const float sc = __builtin_amdgcn_exp2f((float)(t1v + (i & 3) + 8 * (i >> 2)) * l2g);
#pragma unroll
        for (int c8 = 0; c8 < 8; ++c8) acc[c8][i] *= sc; }
    const int sbmax = w | 1;
    __syncthreads();
    LAS unsigned char* qsl = F.lds + RC_ST + w * 8192 + lane * 16;
#pragma unroll
    for (int ks = 0; ks < 8; ++ks) *(LAS bf16x8*)(qsl + ks * 1024) = qf[ks];
    for (int sb = 0; sb < 8; ++sb) {
        LAS unsigned char* buf = F.lds + RC_BLK0 + (sb & 1) * RT_BLK;
        *(LAS v4u*)(buf + kdst) = kreg; *(LAS v4u*)(buf + vdst0) = vreg0; *(LAS v4u*)(buf + vdst0 + 16 * 64) = vreg1;
        __syncthreads();
        if (sb < 7) { const size_t o = (size_t)(sb + 1) * 32 * 1024; kreg = *(const GAS v4u*)(kp + o); vreg0 = *(const GAS v4u*)(vp0 + o); vreg1 = *(const GAS v4u*)(vp0 + o + 16 * 1024); }
        if (sb <= sbmax) {
            f32x16 X;
#pragma unroll
            for (int i = 0; i < 16; ++i) X[i] = 0.f;
#pragma unroll
            for (int ks = 0; ks < 8; ++ks) { const bf16x8 kf = *(const LAS bf16x8*)(buf + RT_K + (ks >> 1) * 2048 + r * 64 + (ks & 1) * 32 + hh * 16); const bf16x8 qv = *(const LAS bf16x8*)(qsl + ks * 1024); X = MFMA32(kf, qv, X); }
            int tcv = 32 * w + r - 32 * sb - 4 * hh; asm volatile("" : "+v"(tcv));
#pragma unroll
            for (int i = 0; i < 16; ++i) { const int dt = tcv - ((i & 3) + 8 * (i >> 2)); X[i] *= __builtin_amdgcn_exp2f((float)(dt < 0 ? -dt : dt) * l2g); }
            bf16x8 pa[2];
#pragma unroll
            for (int s2 = 0; s2 < 2; ++s2) { v4u p; p[0] = cvtpk2(X[8 * s2], X[8 * s2 + 1]); p[1] = cvtpk2(X[8 * s2 + 2], X[8 * s2 + 3]); p[2] = cvtpk2(X[8 * s2 + 4], X[8 * s2 + 5]); p[3] = cvtpk2(X[8 * s2 + 6], X[8 * s2 + 7]);
                pa[s2] = __builtin_bit_cast(bf16x8, p); }
#pragma unroll
            for (int c8 = 0; c8 < 8; ++c8)
                {
#pragma unroll
                  for (int s2 = 0; s2 < 2; ++s2) { const bf16x8 bv = tr_frag(buf + RT_V + c8 * 2048 + s2 * 1024 + lane_off); acc[c8] = MFMA32(pa[s2], bv, acc[c8]); } if (c8 & 1) __builtin_amdgcn_sched_barrier(0); }
        }
    }
    __syncthreads();
    LAS unsigned char* stg = F.lds + w * (32 * RC_STG);
    LAS unsigned char* stgl = stg + 4 * hh * RC_STG + 2 * r;
#pragma unroll
    for (int i = 0; i < 16; ++i) {
        float s = 0.f;
#pragma unroll
        for (int c8 = 0; c8 < 8; ++c8) s += acc[c8][i];
        s += __shfl_xor(s, 1); s += __shfl_xor(s, 2); s += __shfl_xor(s, 4); s += __shfl_xor(s, 8); s += __shfl_xor(s, 16);
        const float mu = s * (1.0f / DV); float q = 0.f;
#pragma unroll
        for (int c8 = 0; c8 < 8; ++c8) { const float d = acc[c8][i] - mu; q += d * d; }
        q += __shfl_xor(q, 1); q += __shfl_xor(q, 2); q += __shfl_xor(q, 4); q += __shfl_xor(q, 8); q += __shfl_xor(q, 16);
        const float rs = 1.0f / sqrtf(q * (1.0f / DV) + EPS);
        LAS unsigned short* srow = (LAS unsigned short*)(stgl + ((i & 3) + 8 * (i >> 2)) * RC_STG);
#pragma unroll
        for (int c8 = 0; c8 < 8; ++c8) srow[32 * c8] = (unsigned short)(cvtpk2((acc[c8][i] - mu) * rs, 0.f) & 0xffffu);
    }
    LDS_WAIT(); asm volatile("" ::: "memory");
#pragma unroll 4
    for (int i = 0; i < 16; ++i) { const int idx = lane + 64 * i, row = idx >> 5, ch = idx & 31;
        const v4u y = *(const LAS v4u*)(stg + row * RC_STG + ch * 16);
        const bf16* ogp = OGCB + (mbase + 32 * w + row) * 2048 + hd * DV + ch * 8; const v4u og = *(const GAS v4u*)ogp; bf16* op = OUTP + (mbase + 32 * w + row) * (size_t)oldp + hd * DV + ch * 8;
        const float* gw = F.ret_gn_w + hd * DV + ch * 8; const f32x4 g0 = *(const f32x4*)gw, g1 = *(const f32x4*)(gw + 4); v4u o;
        o[0] = cvtpk2(pg8::bflo(y[0]) * g0[0] * pg8::bflo(og[0]), pg8::bfhi(y[0]) * g0[1] * pg8::bfhi(og[0]));
        o[1] = cvtpk2(pg8::bflo(y[1]) * g0[2] * pg8::bflo(og[1]), pg8::bfhi(y[1]) * g0[3] * pg8::bfhi(og[1]));
        o[2] = cvtpk2(pg8::bflo(y[2]) * g1[0] * pg8::bflo(og[2]), pg8::bfhi(y[2]) * g1[1] * pg8::bfhi(og[2]));
        o[3] = cvtpk2(pg8::bflo(y[3]) * g1[2] * pg8::bflo(og[3]), pg8::bfhi(y[3]) * g1[3] * pg8::bfhi(og[3]));
        *(GAS v4u*)op = o; }
    __syncthreads();
}
__device__ __forceinline__ void p8_final(Frame& F, float* outp) {
    const int lane_ = pg8::lane_id_v(), tid_ = F.wave * 64 + lane_; (void)tid_;
    const float* ssq = (const float*)(F.ws + WS_SSQ3);
    const int gw = F.vcu * NWAVES + F.wave, NGW = F.G * NWAVES;
    f32x4 wv[4];
#pragma unroll
    for (int j = 0; j < 4; ++j) wv[j] = *(const f32x4*)(F.final_norm_w + 4 * lane_ + 256 * j);
    for (int m = gw; m < M; m += NGW) {
        float s = (lane_ < 16) ? ssq[(size_t)m * 16 + lane_] : 0.f; s = wave_sum(s);
        const float rstd = 1.0f / sqrtf(s * (1.0f / D) + EPS);
        const GAS f32x4* xr = (const GAS f32x4*)(F.out + (size_t)m * D) + lane_; GAS f32x4* xo = (GAS f32x4*)(outp + (size_t)m * D) + lane_;
#pragma unroll
        for (int j = 0; j < 4; ++j) { const f32x4 v = xr[64 * j]; xo[64 * j] = v * rstd * wv[j]; }
    }
}

constexpr int N_PHASES = 11;
struct Args { const void* in[16]; float* out; unsigned char* ws; int ph_lo, ph_hi, use_bar, pad; };
__global__ void __launch_bounds__(NWAVES * 64, 2) hyb_fwd(Args args) {
    extern __shared__ __attribute__((aligned(16))) unsigned char lds[];
    Frame F;
    F.lds = (LAS unsigned char*)lds; F.MISC = (volatile LAS unsigned*)(F.lds + MISC_OFF);
    F.wave = __builtin_amdgcn_readfirstlane((int)threadIdx.x >> 6);
    F.G = gridDim.x; { const int bx = blockIdx.x; F.vcu = (F.G % 8 == 0) ? (bx % 8) * (F.G / 8) + bx / 8 : bx; }
    F.ws = args.ws; F.out = args.out; F.ctl = (gu32*)(args.ws + WS_CTL);
    F.x = (const float*)args.in[0]; F.c = (const float*)args.in[1]; F.positions = (const int*)args.in[2]; F.w_ada = (const float*)args.in[3]; F.b_ada = (const float*)args.in[4];
    F.norm1_w = (const float*)args.in[5]; F.w_in = (const float*)args.in[6]; F.ret_gn_w = (const float*)args.in[7]; F.conv_w = (const float*)args.in[8]; F.w_ret_out = (const float*)args.in[9];
    F.w_conv_out = (const float*)args.in[10]; F.w_o = (const float*)args.in[11]; F.norm2_w = (const float*)args.in[12]; F.w_ff1 = (const float*)args.in[13]; F.w_ff2 = (const float*)args.in[14];
    F.final_norm_w = (const float*)args.in[15];
    for (int u = F.wave * 64 + pg8::lane_id_v(); u < (LDS_BYTES - LDSCTL_OFF) / 4; u += NWAVES * 64) ((LAS unsigned*)(F.lds + LDSCTL_OFF))[u] = 0u;
    __syncthreads();
    XcdBarrier bar; bar.bar = (unsigned*)(F.ctl + CW_BAR); bar.x = 0; bar.st = nullptr;
    if (args.use_bar) bar = xcd_barrier_post((unsigned*)(F.ctl + CW_BAR), F.MISC + 8, F.wave);
    const int lo = args.ph_lo, hi = args.ph_hi;
#ifndef PH_MASK
#define PH_MASK 0x7ff
#endif
#define IN(k) (((PH_MASK >> (k)) & 1) && lo <= (k) && (k) < hi)
#ifndef PH_TWICE
#define PH_TWICE 0
#endif
#define REP(k) for (int rep_ = 0; rep_ < (((PH_TWICE >> (k)) & 1) ? 2 : 1); ++rep_)
#ifdef PH_TA
    unsigned long long ta_ = __builtin_amdgcn_s_memrealtime(), tb_ = ta_;
#define STAMP(id) do { if ((id) == PH_TA) ta_ = __builtin_amdgcn_s_memrealtime(); if ((id) == PH_TB) tb_ = __builtin_amdgcn_s_memrealtime(); } while (0)
#else
#define STAMP(id) do { } while (0)
#endif
#define SEAM(k) do { STAMP(2 * (k)); if (IN(k) && IN((k) + 1)) xcd_barrier(bar, F.wave); STAMP(2 * (k) + 1); } while (0)
    unsigned char* ws = args.ws;
    bf16* U = (bf16*)((unsigned char*)args.out + OUT_U);

#ifdef PH_MAXP0
    const unsigned long long tk0_ = __builtin_amdgcn_s_memrealtime();
    if (IN(0)) { p0_prologue(F); }
    if (F.wave == 0 && pg8::lane_id_v() == 0) __hip_atomic_store((unsigned*)(F.ctl + 16384 + blockIdx.x), (unsigned)(__builtin_amdgcn_s_memrealtime() - tk0_), __ATOMIC_RELAXED, __HIP_MEMORY_SCOPE_AGENT);
    SEAM(0);
    unsigned mx_ = 0, amx_ = 0;
    if (blockIdx.x == 0 && F.wave == 0) { for (int i = 0; i < (int)gridDim.x; ++i) { const unsigned v = __hip_atomic_load((unsigned*)(F.ctl + 16384 + i), __ATOMIC_RELAXED, __HIP_MEMORY_SCOPE_AGENT); if (v > mx_) { mx_ = v; amx_ = i; } } }
#else
    if (IN(0)) REP(0) { p0_prologue(F); } SEAM(0);
#endif
    if (IN(1)) REP(1) { p1_unorm(F); } SEAM(1);
    if (IN(2)) REP(2) {
        pg8::Gemm g{U, (const bf16*)(ws + WS_WIN), M, NPROJ, D}; pg8::StaticOrder S; S.init(M, NPROJ, F.G, (int)blockIdx.x);
        pg8::EpiProj E{(bf16*)(ws + WS_QK), (bf16*)(ws + WS_V), (bf16*)(ws + WS_OGCB), (bf16*)((unsigned char*)args.out + OUT_Z), (bf16*)(ws + WS_GATES), F.positions};
        pg8::gemm_phase<pg8::EpiProj, pg8::StaticOrder, true, true>(F.lds + RING_OFF, g, S, E, F.wave);
    } SEAM(2);
    if (IN(3)) { REP(3) { for (int u = F.vcu; u < 256; u += F.G) p3a_kvsum(F, u); } for (int bk = F.vcu; bk < 256; bk += F.G) p3a_conv(F, bk); REP(11) { p3a_bias2(F); } } SEAM(3);
    if (IN(4)) REP(4) { p3b_scan(F); } SEAM(4);
#ifdef PH_XBAR
    for (int xb_ = 0; xb_ < PH_XBAR; ++xb_) xcd_barrier(bar, F.wave);
#endif
    if (IN(5)) REP(5) { const bool dummy = ((PH_TWICE >> 5) & 1) && rep_ == 0;
        for (int u = F.vcu; u < 256; u += F.G) p3c_retout(F, u, dummy ? (bf16*)((unsigned char*)args.out + OUT_Z) : (bf16*)(ws + WS_OGCB), dummy ? 1024 : 2048); } SEAM(5);
    if (IN(6)) REP(6) {
        pg8::Gemm g{(const bf16*)(ws + WS_OGCB), (const bf16*)(ws + WS_WRC), M, D, 2 * D}; pg8::StaticOrder S; S.init(M, D, F.G, (int)blockIdx.x);
        pg8::EpiMerge E{(const bf16*)(ws + WS_GATES), (bf16*)(ws + WS_MERGED)};
        pg8::gemm_phase<pg8::EpiMerge, pg8::StaticOrder, false, true>(F.lds + RING_OFF, g, S, E, F.wave);
    } SEAM(6);
    if (IN(7)) REP(7) {
        pg8::Gemm g{(const bf16*)(ws + WS_MERGED), (const bf16*)(ws + WS_WO), M, D, D}; pg8::StaticOrder S; S.init(M, D, F.G, (int)blockIdx.x);
        pg8::EpiRes1 E{F.x, args.out, (bf16*)(ws + WS_HHAT), (const float*)(ws + WS_MODF), F.norm2_w, (float*)(ws + WS_SSQ2)};
        pg8::gemm_phase<pg8::EpiRes1, pg8::StaticOrder, false, true>(F.lds + RING_OFF, g, S, E, F.wave);
    } SEAM(7);
    if (IN(8)) REP(8) {
        pg8::Gemm g{(const bf16*)(ws + WS_HHAT), (const bf16*)(ws + WS_W1), M, FF, D}; pg8::StaticOrder S; S.init(M, FF, F.G, (int)blockIdx.x);
        pg8::Unit u0; LAS float* tab = (LAS float*)(F.lds + TAB_OFF); const int tid_ = F.wave * 64 + pg8::lane_id_v();
        if (S.next(0, u0)) { if (tid_ < 256) { const float* sq = (const float*)(ws + WS_SSQ2) + (size_t)(u0.pm * 256 + tid_) * 16; const f32x4 a = *(const f32x4*)sq, b = *(const f32x4*)(sq + 4), c = *(const f32x4*)(sq + 8), d = *(const f32x4*)(sq + 12);
            const float s = ((a[0] + a[1]) + (a[2] + a[3])) + ((b[0] + b[1]) + (b[2] + b[3])) + ((c[0] + c[1]) + (c[2] + c[3])) + ((d[0] + d[1]) + (d[2] + d[3]));
            tab[tid_] = 1.0f / sqrtf(s * (1.0f / D) + EPS); } }
        __syncthreads();
        pg8::EpiFF1 E{(const float*)(ws + WS_BIAS2), (const LAS float*)tab, (bf16*)(ws + WS_HID)};
        pg8::gemm_phase<pg8::EpiFF1, pg8::StaticOrder, true, true>(F.lds + RING_OFF, g, S, E, F.wave);
    } SEAM(8);
    if (IN(9)) REP(9) {
        pg8::Gemm g{(const bf16*)(ws + WS_HID), (const bf16*)(ws + WS_W2), M, D, FF}; pg8::StaticOrder S; S.init(M, D, F.G, (int)blockIdx.x);
        const bool dummy = ((PH_TWICE >> 9) & 1) && rep_ == 0;
        pg8::EpiRes2 E{args.out, dummy ? (float*)(ws + WS_GATES) : args.out, (const float*)(ws + WS_MODF), (float*)(ws + WS_SSQ3)};
        pg8::gemm_phase<pg8::EpiRes2, pg8::StaticOrder, false, true>(F.lds + RING_OFF, g, S, E, F.wave);
    } SEAM(9);
    if (IN(10)) REP(10) { const bool dummy = ((PH_TWICE >> 10) & 1) && rep_ == 0; p8_final(F, dummy ? (float*)(ws + WS_GATES) : args.out); }
#ifdef PH_MAXP0
    if (blockIdx.x == 0 && F.wave == 0) { const unsigned long long te = __builtin_amdgcn_s_memrealtime(), d = (PH_MAXP0 == 1) ? (unsigned long long)mx_ * 4ull : (unsigned long long)amx_ * 100ull; while (__builtin_amdgcn_s_memrealtime() - te < d) __builtin_amdgcn_s_sleep(8); }
#endif
#ifdef PH_TA
    STAMP(20); STAMP(21);
    if ((int)blockIdx.x == PH_BLK && F.wave == 0) { const unsigned long long te = __builtin_amdgcn_s_memrealtime(), d = (tb_ - ta_) * 4ull; while (__builtin_amdgcn_s_memrealtime() - te < d) __builtin_amdgcn_s_sleep(8); }
#endif
#undef IN
#undef SEAM
}

#ifndef HYB_N_LAUNCHES
#define HYB_N_LAUNCHES 1
#endif
extern "C" void kernel_launch(void* const* d_in, const int* in_sizes, int n_in, void* d_out, int out_size, void* d_ws, size_t ws_size, hipStream_t stream) {
    static int grid = 0;
    if (grid == 0) {
        if (n_in != 16 || in_sizes[0] != M * D || out_size != M * D || ws_size < WS_END) { fprintf(stderr, "kernel_launch: unexpected shapes (n_in %d, in0 %d, out %d, ws %zu); nothing launched\n", n_in, n_in > 0 ? in_sizes[0] : -1, out_size, ws_size); grid = -1; return; }
        int dev = 0, cus = 0, per_cu = 0;
        if (hipGetDevice(&dev) != hipSuccess || hipDeviceGetAttribute(&cus, hipDeviceAttributeMultiprocessorCount, dev) != hipSuccess) { grid = -1; return; }
        if (hipFuncSetAttribute((const void*)hyb_fwd, hipFuncAttributeMaxDynamicSharedMemorySize, LDS_BYTES) != hipSuccess) { fprintf(stderr, "kernel_launch: hipFuncSetAttribute failed\n"); grid = -1; return; }
        if (hipOccupancyMaxActiveBlocksPerMultiprocessor(&per_cu, (const void*)hyb_fwd, NWAVES * 64, LDS_BYTES) != hipSuccess || per_cu < 1) { fprintf(stderr, "kernel_launch: occupancy query says %d workgroups per CU; nothing launched\n", per_cu); (void)hipGetLastError(); grid = -1; return; }
        { bool okp = true; pg8::StaticOrder S; for (int c = 0; c < cus && okp; ++c) { S.init(M, FF, cus, c); pg8::Unit u0, u; if (!S.next(0, u0)) continue; for (int i = 1; S.next(i, u); ++i) okp = okp && (u.pm == u0.pm); }
          if (!okp) { fprintf(stderr, "kernel_launch: FF1's unit order does not keep a workgroup inside one row panel on %d CUs; nothing launched\n", cus); grid = -1; return; } }
        grid = cus;
        if (grid != 256) fprintf(stderr, "kernel_launch: %d CUs (built for 256)\n", grid);
    }
    if (grid < 0) return;
    (void)hipMemsetAsync((char*)d_ws + WS_CTL, 0, CTL_ZERO_BYTES, stream);
    Args a{};
    for (int i = 0; i < 16; ++i) a.in[i] = d_in[i];
    a.out = (float*)d_out; a.ws = (unsigned char*)d_ws;
#if HYB_N_LAUNCHES == 1
    a.ph_lo = 0; a.ph_hi = N_PHASES; a.use_bar = 1;
    hipLaunchKernelGGL(hyb_fwd, dim3(grid), dim3(NWAVES * 64), LDS_BYTES, stream, a);
#ifdef PH_WHOLE2
    (void)hipMemsetAsync((char*)d_ws + WS_CTL, 0, CTL_ZERO_BYTES, stream);
    hipLaunchKernelGGL(hyb_fwd, dim3(grid), dim3(NWAVES * 64), LDS_BYTES, stream, a);
#endif
#else
    for (int p = 0; p < N_PHASES; ++p) { a.ph_lo = p; a.ph_hi = p + 1; a.use_bar = 0; hipLaunchKernelGGL(hyb_fwd, dim3(grid), dim3(NWAVES * 64), LDS_BYTES, stream, a); }
#endif
}
```

```cpp
#include <hip/hip_runtime.h>
#include <cstdio>
#include <cstdint>
namespace pg8 {
#define PG8_LAS __attribute__((address_space(3)))
typedef unsigned short bf16_t;
typedef short bf16x8 __attribute__((ext_vector_type(8)));
typedef float f32x4 __attribute__((ext_vector_type(4)));
typedef unsigned u32x4 __attribute__((ext_vector_type(4)));
constexpr int BM = 256, BK = 64, HALF = 128, HTB = HALF * BK * 2  , STAGE_BYTES = 8 * HTB, NXCD = 8, WGM = 8;

__host__ __device__ __forceinline__ int lds_byte(int r, int c) { const int st = (r >> 4) * 2 + (c >> 5), rr = r & 15, cc = c & 31, ob = rr * 64 + cc * 2; return st * 1024 + (ob ^ (((ob >> 9) & 1) << 5)); }
__host__ __device__ __forceinline__ void stage_rc(int b, int& R, int& C) { const int st = b / 1024, sb = b % 1024, swz = sb ^ (((sb >> 9) & 1) << 5); R = (st >> 1) * 16 + swz / 64; C = (st & 1) * 32 + (swz % 64) / 2; }
__host__ __device__ __forceinline__ int perm32(int rho) { const int n = rho >> 4, i = rho & 15; return 8 * (i >> 2) + 4 * n + (i & 3); }

struct Unit { int pm, pn; };
struct Gemm { const bf16_t* A; const bf16_t* Bt; int M, N, K; size_t a_pstride; };

struct StaticOrder {
    int nM, nN, nwg, G, c;
    __host__ __device__ void init(int M, int N, int G_, int c_) { nM = M / BM; nN = N / BM; nwg = nM * nN; G = G_; c = c_; }
    __host__ __device__ bool next(int i, Unit& u) const {
        const long L = (long)i * G + c; if (L >= nwg) return false;
        int wgid = (int)L; { const int q = nwg / NXCD, r = nwg % NXCD, xcd = wgid % NXCD, off = wgid / NXCD; wgid = (xcd < r ? xcd * (q + 1) : r * (q + 1) + (xcd - r) * q) + off; }
        const int nig = WGM * nN, gid = wgid / nig, fm = gid * WGM, gsz = (nM - fm) < WGM ? (nM - fm) : WGM;
        u.pm = fm + ((wgid % nig) % gsz); u.pn = (wgid % nig) / gsz; return true;
    }
    __device__ __forceinline__ void a_ready(const Unit&) const {}
    __device__ __forceinline__ void done(const Unit&) const {}
};

__device__ __forceinline__ unsigned cvt_pk_bf16(float lo, float hi) { unsigned r; asm volatile("v_cvt_pk_bf16_f32 %0, %1, %2" : "=v"(r) : "v"(lo), "v"(hi)); return r; }
typedef float f32x2 __attribute__((ext_vector_type(2)));
__device__ __forceinline__ int lane_id_v() { int l; asm volatile("v_mbcnt_lo_u32_b32 %0, -1, 0\n\tv_mbcnt_hi_u32_b32 %0, -1, %0" : "=v"(l)); return l; }
typedef unsigned u32x2 __attribute__((ext_vector_type(2)));
__device__ __forceinline__ unsigned cvtpk(float lo, float hi) { typedef float f2_t __attribute__((ext_vector_type(2))); typedef __bf16 b2_t __attribute__((ext_vector_type(2))); f2_t v = {lo, hi}; b2_t b = __builtin_convertvector(v, b2_t); return __builtin_bit_cast(unsigned, b); }
__device__ __forceinline__ float bflo(unsigned w) { return __builtin_bit_cast(float, w << 16); }
__device__ __forceinline__ float bfhi(unsigned w) { return __builtin_bit_cast(float, w & 0xffff0000u); }
__device__ __forceinline__ float fast_rcp(float x) { return __builtin_amdgcn_rcpf(x); }
__device__ __forceinline__ float sigmoidf_(float x) { return fast_rcp(1.0f + __expf(-x)); }
__device__ __forceinline__ void sincos_rev(float ang, float& s, float& c) {
    const float I2P = 0.15915493667125702f, I2P_LO = 6.420638326565253e-09f;
    const float r = ang * I2P; float e = __builtin_fmaf(ang, I2P, -r); e = __builtin_fmaf(ang, I2P_LO, e);
    const float k = __builtin_rintf(r); const float f = (r - k) + e;
    s = __builtin_amdgcn_sinf(f); c = __builtin_amdgcn_cosf(f);
}
__device__ __forceinline__ u32x4 pack8(const f32x4 a, const f32x4 b) { u32x4 w; w.x = cvtpk(a[0], a[1]); w.y = cvtpk(a[2], a[3]); w.z = cvtpk(b[0], b[1]); w.w = cvtpk(b[2], b[3]); return w; }

struct EpiProj {
    static constexpr bool PERM = true, AFTER_DRAIN = false, HAS_MID = false;
    bf16_t* QK; bf16_t* V; bf16_t* R; bf16_t* Z; const int* pos;
    __device__ __forceinline__ void mid(f32x4 (&)[2][2][4][2], const Unit&, int, int, int, int) const {}
    __device__ __forceinline__ void operator()(const f32x4 (&acc)[2][2][4][2], const Unit& u, int wr, int wc, int fr, int fq) const {
        const int row0 = u.pm * BM + wr * 64 + fr, cw = wc * 32 + 8 * fq, pn = u.pn;
        if (pn < 4) {
            const float ksc = pn >= 2 ? 0.08838834764831845f : 1.0f;
            const int g = 4 * wc + fq; float invf[4];
#pragma unroll
            for (int i = 0; i < 4; ++i) invf[i] = exp2f(-(float)(4 * g + i) * (13.287712379549449f / 64.0f));
#pragma unroll
            for (int ai = 0; ai < 2; ++ai)
#pragma unroll
                for (int m = 0; m < 4; ++m) { const int row = row0 + ai * HALF + m * 16; const float p = (float)pos[row];
                    f32x4 cs, sn;
#pragma unroll
                    for (int i = 0; i < 4; ++i) { float s_, c_; sincos_rev(p * invf[i], s_, c_); cs[i] = c_ * ksc; sn[i] = s_ * ksc; }
                    bf16_t* rowp = QK + (size_t)row * 1024 + pn * 256 + cw;
#pragma unroll
                    for (int bj = 0; bj < 2; ++bj) { const f32x4 x1 = acc[ai][bj][m][0], x2 = acc[ai][bj][m][1];
                        const f32x4 o1 = x1 * cs - x2 * sn, o2 = x1 * sn + x2 * cs;
                        *(u32x4*)(rowp + bj * HALF) = pack8(o1, o2); } }
        } else if (pn >= 16 && pn < 24) {
#pragma unroll
            for (int ai = 0; ai < 2; ++ai)
#pragma unroll
                for (int m = 0; m < 4; ++m) { const int row = row0 + ai * HALF + m * 16; bf16_t* rowp = Z + (size_t)row * 1024 + (((pn - 16) * 256 + cw) >> 1);
#pragma unroll
                    for (int bj = 0; bj < 2; ++bj) { const f32x4 z = acc[ai][bj][m][0] * acc[ai][bj][m][1]; u32x2 w; w.x = cvtpk(z[0], z[1]); w.y = cvtpk(z[2], z[3]);
                        *(u32x2*)(rowp + bj * (HALF / 2)) = w; } }
        } else {
            bf16_t* base; int ld, mode;
            if (pn < 8) { base = V + (size_t)u.pm * BM * 1024 + (pn - 4) * 256; ld = 1024; mode = 0; }
            else if (pn < 12) { base = R + (size_t)u.pm * 1048576 + (pn - 8) * 256; ld = 2048; mode = 1; }
            else if (pn < 16) { base = R + (size_t)u.pm * 1048576 + 1024 + (pn - 12) * 256; ld = 2048; mode = 0; }
            else { base = R + (size_t)u.pm * 1048576 + 524288 + (pn - 24) * 256; ld = 2048; mode = 2; }
            const int rl0 = wr * 64 + fr;
#pragma unroll
            for (int ai = 0; ai < 2; ++ai)
#pragma unroll
                for (int m = 0; m < 4; ++m) { const int rl = rl0 + ai * HALF + m * 16; bf16_t* rowp = base + (size_t)rl * ld + cw;
#pragma unroll
                    for (int bj = 0; bj < 2; ++bj) { f32x4 v0 = acc[ai][bj][m][0], v1 = acc[ai][bj][m][1];
                        if (mode != 0) {
#pragma unroll
                            for (int i = 0; i < 4; ++i) { const float s0 = sigmoidf_(v0[i]), s1 = sigmoidf_(v1[i]); v0[i] = mode == 1 ? v0[i] * s0 : s0; v1[i] = mode == 1 ? v1[i] * s1 : s1; } }
                        *(u32x4*)(rowp + bj * HALF) = pack8(v0, v1); } }
        }
    }
};

struct EpiMerge {
    static constexpr bool PERM = true, AFTER_DRAIN = false, HAS_MID = true;
    const bf16_t* R; bf16_t* MERGED;
    __device__ __forceinline__ void mid(f32x4 (&acc)[2][2][4][2], const Unit& u, int wr, int wc, int fr, int fq) const {
        const int rl0 = wr * 64 + fr, col0 = u.pn * BM + wc * 32 + 8 * fq; const bf16_t* G = R + (size_t)u.pm * 1048576 + 524288;
#pragma unroll
        for (int ai = 0; ai < 2; ++ai)
#pragma unroll
            for (int m = 0; m < 4; ++m) { const bf16_t* rowp = G + (size_t)(rl0 + ai * HALF + m * 16) * 2048 + col0;
#pragma unroll
                for (int bj = 0; bj < 2; ++bj) { const u32x4 ga = *(const u32x4*)(rowp + bj * HALF), gb = *(const u32x4*)(rowp + 1024 + bj * HALF);
#pragma unroll
                    for (int j = 0; j < 4; ++j) { const float a0 = bflo(ga[j]), a1 = bfhi(ga[j]); const float b0 = fmaxf(bflo(gb[j]), 1e-30f), b1 = fmaxf(bfhi(gb[j]), 1e-30f);
                        acc[ai][bj][m][j >> 1][2 * (j & 1)] *= a0 * fast_rcp(b0); acc[ai][bj][m][j >> 1][2 * (j & 1) + 1] *= a1 * fast_rcp(b1); } } }
    }
    __device__ __forceinline__ void operator()(const f32x4 (&acc)[2][2][4][2], const Unit& u, int wr, int wc, int fr, int fq) const {
        const int row0 = u.pm * BM + wr * 64 + fr, col0 = u.pn * BM + wc * 32 + 8 * fq;
#pragma unroll
        for (int ai = 0; ai < 2; ++ai)
#pragma unroll
            for (int m = 0; m < 4; ++m) { const int row = row0 + ai * HALF + m * 16; const bf16_t* gp = R + (size_t)u.pm * 1048576 + 524288 + (size_t)(row - u.pm * BM) * 2048 + 1024 + col0; bf16_t* op = MERGED + (size_t)row * 1024 + col0;
#pragma unroll
                for (int bj = 0; bj < 2; ++bj) { const u32x4 gb = *(const u32x4*)(gp + bj * HALF); f32x4 v0 = acc[ai][bj][m][0], v1 = acc[ai][bj][m][1];
                    v0[0] *= fmaxf(bflo(gb[0]), 1e-30f); v0[1] *= fmaxf(bfhi(gb[0]), 1e-30f); v0[2] *= fmaxf(bflo(gb[1]), 1e-30f); v0[3] *= fmaxf(bfhi(gb[1]), 1e-30f);
                    v1[0] *= fmaxf(bflo(gb[2]), 1e-30f); v1[1] *= fmaxf(bfhi(gb[2]), 1e-30f); v1[2] *= fmaxf(bflo(gb[3]), 1e-30f); v1[3] *= fmaxf(bfhi(gb[3]), 1e-30f);
                    *(u32x4*)(op + bj * HALF) = pack8(v0, v1); } }
    }
};

struct EpiRes1 {
    static constexpr bool PERM = true, AFTER_DRAIN = false, HAS_MID = false;
    const float* x; float* h1; bf16_t* hhat; const float* modf; const float* norm2w; float* ssq;
    __device__ __forceinline__ void mid(f32x4 (&)[2][2][4][2], const Unit&, int, int, int, int) const {}
    __device__ __forceinline__ void operator()(const f32x4 (&acc)[2][2][4][2], const Unit& u, int wr, int wc, int fr, int fq) const {
        const int row0 = u.pm * BM + wr * 64 + fr, col0 = u.pn * BM + wc * 32 + 8 * fq, b = u.pm >> 4;
        f32x4 g1[2][2], cs[2][2];
#pragma unroll
        for (int bj = 0; bj < 2; ++bj)
#pragma unroll
            for (int n = 0; n < 2; ++n) { const int c = col0 + bj * HALF + 4 * n; g1[bj][n] = *(const f32x4*)(modf + b * 6144 + 2048 + c);
                const f32x4 sc = *(const f32x4*)(modf + b * 6144 + 4096 + c), w = *(const f32x4*)(norm2w + c); cs[bj][n] = w * (sc + 1.0f); }
#pragma unroll
        for (int ai = 0; ai < 2; ++ai)
#pragma unroll
            for (int m = 0; m < 4; ++m) { const int row = row0 + ai * HALF + m * 16; const size_t off = (size_t)row * 1024 + col0; float q = 0.f;
#pragma unroll
                for (int bj = 0; bj < 2; ++bj) { const f32x4 x0 = *(const f32x4*)(x + off + bj * HALF), x1 = *(const f32x4*)(x + off + bj * HALF + 4);
                    const f32x4 h0 = x0 + g1[bj][0] * acc[ai][bj][m][0], hb = x1 + g1[bj][1] * acc[ai][bj][m][1];
                    *(f32x4*)(h1 + off + bj * HALF) = h0; *(f32x4*)(h1 + off + bj * HALF + 4) = hb;
                    q += (h0[0] * h0[0] + h0[1] * h0[1]) + (h0[2] * h0[2] + h0[3] * h0[3]) + (hb[0] * hb[0] + hb[1] * hb[1]) + (hb[2] * hb[2] + hb[3] * hb[3]);
                    *(u32x4*)(hhat + off + bj * HALF) = pack8(h0 * cs[bj][0], hb * cs[bj][1]); }
                q += __shfl_xor(q, 16); q += __shfl_xor(q, 32);
                if (fq == 0) ssq[(size_t)row * 16 + u.pn * 4 + wc] = q; }
    }
};

struct EpiFF1 {
    static constexpr bool PERM = true, AFTER_DRAIN = false, HAS_MID = false;
    const float* bias2; const PG8_LAS float* rstd; bf16_t* HID;
    __device__ __forceinline__ void mid(f32x4 (&)[2][2][4][2], const Unit&, int, int, int, int) const {}
    __device__ __forceinline__ void operator()(const f32x4 (&acc)[2][2][4][2], const Unit& u, int wr, int wc, int fr, int fq) const {
        const int rl0 = wr * 64 + fr, col0 = u.pn * BM + wc * 32 + 8 * fq, b = u.pm >> 4;
        f32x4 bv[2][2];
#pragma unroll
        for (int bj = 0; bj < 2; ++bj)
#pragma unroll
            for (int n = 0; n < 2; ++n) bv[bj][n] = *(const f32x4*)(bias2 + b * 4096 + col0 + bj * HALF + 4 * n);
#pragma unroll
        for (int ai = 0; ai < 2; ++ai)
#pragma unroll
            for (int m = 0; m < 4; ++m) { const int rl = rl0 + ai * HALF + m * 16; const float rs = rstd[rl]; bf16_t* op = HID + (size_t)(u.pm * BM + rl) * 4096 + col0;
#pragma unroll
                for (int bj = 0; bj < 2; ++bj) { f32x4 v0 = acc[ai][bj][m][0] * rs + bv[bj][0], v1 = acc[ai][bj][m][1] * rs + bv[bj][1];
#pragma unroll
                    for (int i = 0; i < 4; ++i) { const float a = fmaxf(v0[i], 0.f), c = fmaxf(v1[i], 0.f); v0[i] = a * a; v1[i] = c * c; }
                    *(u32x4*)(op + bj * HALF) = pack8(v0, v1); } }
    }
};

struct EpiRes2 {
    static constexpr bool PERM = true, AFTER_DRAIN = false, HAS_MID = false;
    const float* h; float* ho; const float* modf; float* ssq;
    __device__ __forceinline__ void mid(f32x4 (&)[2][2][4][2], const Unit&, int, int, int, int) const {}
    __device__ __forceinline__ void operator()(const f32x4 (&acc)[2][2][4][2], const Unit& u, int wr, int wc, int fr, int fq) const {
        const int row0 = u.pm * BM + wr * 64 + fr, col0 = u.pn * BM + wc * 32 + 8 * fq, b = u.pm >> 4;
        f32x4 g2[2][2];
#pragma unroll
        for (int bj = 0; bj < 2; ++bj)
#pragma unroll
            for (int n = 0; n < 2; ++n) g2[bj][n] = *(const f32x4*)(modf + b * 6144 + 5120 + col0 + bj * HALF + 4 * n);
#pragma unroll
        for (int ai = 0; ai < 2; ++ai)
#pragma unroll
            for (int m = 0; m < 4; ++m) { const int row = row0 + ai * HALF + m * 16; const size_t off = (size_t)row * 1024 + col0; float q = 0.f;
#pragma unroll
                for (int bj = 0; bj < 2; ++bj) { const f32x4 x0 = *(const f32x4*)(h + off + bj * HALF), x1 = *(const f32x4*)(h + off + bj * HALF + 4);
                    const f32x4 h0 = x0 + g2[bj][0] * acc[ai][bj][m][0], hb = x1 + g2[bj][1] * acc[ai][bj][m][1];
                    *(f32x4*)(ho + off + bj * HALF) = h0; *(f32x4*)(ho + off + bj * HALF + 4) = hb;
                    q += (h0[0] * h0[0] + h0[1] * h0[1]) + (h0[2] * h0[2] + h0[3] * h0[3]) + (hb[0] * hb[0] + hb[1] * hb[1]) + (hb[2] * hb[2] + hb[3] * hb[3]); }
                q += __shfl_xor(q, 16); q += __shfl_xor(q, 32);
                if (fq == 0) ssq[(size_t)row * 16 + u.pn * 4 + wc] = q; }
    }
};

template <class Epi, class Sched, bool ALIGN_EPI = false, bool SP2 = false>
__device__ __forceinline__ void gemm_phase(PG8_LAS unsigned char* lds, const Gemm g, const Sched& S, const Epi& E, const int wid) {
    const int lane = lane_id_v(), tid = wid * 64 + lane, wr = wid >> 2, wc = wid & 3, fr = lane & 15, fq = lane >> 4;
    const int K = g.K, nt = K / BK;
    unsigned voffA[2], voffB[2];
#pragma unroll
    for (int i = 0; i < 2; ++i) { int R, C; stage_rc(tid * 16 + i * 8192, R, C); const int Rb = Epi::PERM ? ((R & ~31) + perm32(R & 31)) : R;
        voffA[i] = (unsigned)(R * K + C) * 2u; voffB[i] = (unsigned)(Rb * K + C) * 2u; }
    const size_t kstep = (size_t)(BK * 2);
    const size_t hstep = (size_t)HALF * K * 2;
    const size_t tstep = 2 * hstep;
    const unsigned ldsw = (unsigned)wid * 1024u;
    const int aoff = lds_byte(wr * 64 + fr, fq * 8), boff = lds_byte(wc * 32 + fr, fq * 8);
#define PG8_SA(b, h) (((b) * 2 + (h)) * HTB)
#define PG8_SB(b, h) ((4 + (b) * 2 + (h)) * HTB)
#define PG8_STAGE(bufoff, gbase, voff) do { _Pragma("unroll") for (int _i = 0; _i < 2; ++_i) \
        __builtin_amdgcn_global_load_lds((const unsigned*)((const char*)(gbase) + (voff)[_i]), (PG8_LAS unsigned*)(lds + (bufoff) + ldsw + _i * 8192), 16, 0, 0); } while (0)
#define PG8_LDA(dst, b, h) do { _Pragma("unroll") for (int m = 0; m < 4; ++m) _Pragma("unroll") for (int k = 0; k < 2; ++k) dst[m][k] = *(const PG8_LAS bf16x8*)(lds + PG8_SA(b, h) + aoff + m * 2048 + k * 1024); } while (0)
#define PG8_LDB(dst, b, h) do { _Pragma("unroll") for (int n = 0; n < 2; ++n) _Pragma("unroll") for (int k = 0; k < 2; ++k) dst[n][k] = *(const PG8_LAS bf16x8*)(lds + PG8_SB(b, h) + boff + n * 2048 + k * 1024); } while (0)
#define PG8_MMA(ai, bj, At, Bt) do { __builtin_amdgcn_s_setprio(1); _Pragma("unroll") for (int m = 0; m < 4; ++m) _Pragma("unroll") for (int n = 0; n < 2; ++n) _Pragma("unroll") for (int k = 0; k < 2; ++k) \
        acc[ai][bj][m][n] = __builtin_amdgcn_mfma_f32_16x16x32_bf16(Bt[n][k], At[m][k], acc[ai][bj][m][n], 0, 0, 0); __builtin_amdgcn_s_setprio(0); } while (0)
#define PG8_WAIT_V(n) asm volatile("s_waitcnt vmcnt(" #n ")" ::: "memory")
#define PG8_WAIT_L(n) asm volatile("s_waitcnt lgkmcnt(" #n ")" ::: "memory")
#define PG8_BAR __builtin_amdgcn_s_barrier()
#define PG8_SCHED __builtin_amdgcn_sched_barrier(0)
    Unit cur, nxt; int ui = 0;
    if (!S.next(0, cur)) return;
    f32x4 acc[2][2][4][2];
#pragma unroll
    for (int a = 0; a < 2; ++a)
#pragma unroll
        for (int b = 0; b < 2; ++b)
#pragma unroll
            for (int m = 0; m < 4; ++m)
#pragma unroll
                for (int n = 0; n < 2; ++n) acc[a][b][m][n] = (f32x4){0.f, 0.f, 0.f, 0.f};
    bf16x8 At[4][2], B0[2][2], B1[2][2];
    const char* cA = (const char*)g.A + (size_t)cur.pm * g.a_pstride; const char* cB = (const char*)g.Bt + (size_t)cur.pn * tstep;
    S.a_ready(cur);
    if constexpr (SP2) {
        PG8_STAGE(PG8_SB(0, 0), cB, voffB); PG8_STAGE(PG8_SB(0, 1), cB + hstep, voffB); PG8_STAGE(PG8_SA(0, 0), cA, voffA); PG8_STAGE(PG8_SA(0, 1), cA + hstep, voffA);
        if (wr == 1) PG8_BAR;
        PG8_WAIT_V(2); PG8_BAR;
        PG8_STAGE(PG8_SB(1, 0), cB + kstep, voffB); PG8_STAGE(PG8_SA(1, 0), cA + kstep, voffA); PG8_STAGE(PG8_SB(1, 1), cB + hstep + kstep, voffB);
        PG8_WAIT_V(6); PG8_BAR;
    } else {
        PG8_STAGE(PG8_SB(0, 0), cB, voffB); PG8_STAGE(PG8_SA(0, 0), cA, voffA); PG8_STAGE(PG8_SB(0, 1), cB + hstep, voffB); PG8_STAGE(PG8_SA(0, 1), cA + hstep, voffA);
        if (wr == 1) PG8_BAR;
        PG8_WAIT_V(4); PG8_BAR;
        PG8_STAGE(PG8_SB(1, 0), cB + kstep, voffB); PG8_STAGE(PG8_SA(1, 0), cA + kstep, voffA); PG8_STAGE(PG8_SB(1, 1), cB + hstep + kstep, voffB);
        PG8_WAIT_V(6); PG8_BAR;
    }
    for (;;) {
        const bool has_next = S.next(ui + 1, nxt);
        const char* nA = has_next ? (const char*)g.A + (size_t)nxt.pm * g.a_pstride : cA; const char* nB = has_next ? (const char*)g.Bt + (size_t)nxt.pn * tstep : cB;
        for (int t = 0; t < nt; t += 2) {
            if constexpr (Epi::HAS_MID) { if (t == (nt >> 1)) { int fr_e = fr, fq_e = fq; asm volatile("" : "+v"(fr_e), "+v"(fq_e)); E.mid(acc, cur, wr, wc, fr_e, fq_e); } }
            const bool last = (t == nt - 2);
            const char* a1 = cA + (size_t)(t + 1) * kstep;
            const char* a2 = last ? nA : cA + (size_t)(t + 2) * kstep; const char* b2 = last ? nB : cB + (size_t)(t + 2) * kstep;
            const char* a3 = a2 + kstep; const char* b3 = b2 + kstep;
            if (last && has_next) S.a_ready(nxt);
            if constexpr (SP2) {
            PG8_LDB(B0, 0, 0); PG8_LDB(B1, 0, 1); PG8_SCHED; PG8_LDA(At, 0, 0); PG8_STAGE(PG8_SA(1, 1), a1 + hstep, voffA);
            PG8_WAIT_V(8); PG8_WAIT_L(0); PG8_BAR; PG8_MMA(0, 0, At, B0); PG8_MMA(0, 1, At, B1); PG8_BAR; PG8_SCHED;
            PG8_LDA(At, 0, 1); PG8_STAGE(PG8_SB(0, 0), b2, voffB); PG8_STAGE(PG8_SB(0, 1), b2 + hstep, voffB); PG8_STAGE(PG8_SA(0, 0), a2, voffA);
            PG8_WAIT_V(8); PG8_WAIT_L(0); PG8_BAR; PG8_MMA(1, 0, At, B0); PG8_MMA(1, 1, At, B1); PG8_BAR; PG8_SCHED;
            PG8_LDB(B0, 1, 0); PG8_LDB(B1, 1, 1); PG8_SCHED; PG8_LDA(At, 1, 0); PG8_STAGE(PG8_SA(0, 1), a2 + hstep, voffA);
            PG8_WAIT_V(8); PG8_WAIT_L(0); PG8_BAR; PG8_MMA(0, 0, At, B0); PG8_MMA(0, 1, At, B1); PG8_BAR; PG8_SCHED;
            PG8_LDA(At, 1, 1); PG8_STAGE(PG8_SB(1, 0), b3, voffB); PG8_STAGE(PG8_SB(1, 1), b3 + hstep, voffB); PG8_STAGE(PG8_SA(1, 0), a3, voffA);
            PG8_WAIT_V(8); PG8_WAIT_L(0); PG8_BAR; PG8_MMA(1, 0, At, B0); PG8_MMA(1, 1, At, B1); PG8_BAR; PG8_SCHED;
            } else {
            PG8_LDB(B0, 0, 0); PG8_SCHED; PG8_LDA(At, 0, 0); PG8_STAGE(PG8_SA(1, 1), a1 + hstep, voffA);
            PG8_WAIT_L(8); PG8_BAR; PG8_WAIT_L(0); PG8_MMA(0, 0, At, B0); PG8_BAR; PG8_SCHED;
            PG8_LDB(B1, 0, 1); PG8_STAGE(PG8_SB(0, 0), b2, voffB);
            PG8_BAR; PG8_WAIT_L(0); PG8_MMA(0, 1, At, B1); PG8_BAR;
            PG8_LDA(At, 0, 1); PG8_STAGE(PG8_SA(0, 0), a2, voffA);
            PG8_BAR; PG8_WAIT_L(0); PG8_MMA(1, 0, At, B0); PG8_BAR; PG8_SCHED;
            PG8_STAGE(PG8_SB(0, 1), b2 + hstep, voffB);
            PG8_WAIT_V(6); PG8_BAR; PG8_MMA(1, 1, At, B1); PG8_BAR;
            PG8_LDB(B0, 1, 0); PG8_SCHED; PG8_LDA(At, 1, 0); PG8_STAGE(PG8_SA(0, 1), a2 + hstep, voffA);
            PG8_WAIT_L(8); PG8_BAR; PG8_WAIT_L(0); PG8_MMA(0, 0, At, B0); PG8_BAR; PG8_SCHED;
            PG8_LDB(B1, 1, 1); PG8_STAGE(PG8_SB(1, 0), b3, voffB);
            PG8_BAR; PG8_WAIT_L(0); PG8_MMA(0, 1, At, B1); PG8_BAR;
            PG8_LDA(At, 1, 1); PG8_STAGE(PG8_SA(1, 0), a3, voffA);
            PG8_BAR; PG8_WAIT_L(0); PG8_MMA(1, 0, At, B0); PG8_BAR; PG8_SCHED;
            PG8_STAGE(PG8_SB(1, 1), b3 + hstep, voffB);
            PG8_WAIT_V(6); PG8_BAR; PG8_MMA(1, 1, At, B1); PG8_BAR;
            }
        }
        if constexpr (ALIGN_EPI) { if (wr == 0) PG8_BAR; }
        if constexpr (!Epi::AFTER_DRAIN) { int fr_e = fr, fq_e = fq; asm volatile("" : "+v"(fr_e), "+v"(fq_e));
            E(acc, cur, wr, wc, fr_e, fq_e); S.done(cur); }
        if (!has_next) break;
#pragma unroll
        for (int a = 0; a < 2; ++a)
#pragma unroll
            for (int b = 0; b < 2; ++b)
#pragma unroll
                for (int m = 0; m < 4; ++m)
#pragma unroll
                    for (int n = 0; n < 2; ++n) acc[a][b][m][n] = (f32x4){0.f, 0.f, 0.f, 0.f};
        cur = nxt; cA = nA; cB = nB; ++ui;
        if constexpr (ALIGN_EPI) { if (wr == 1) PG8_BAR; }
    }
    PG8_WAIT_V(0);
    if constexpr (!ALIGN_EPI) { if (wr == 0) PG8_BAR; }
    PG8_BAR;
    if constexpr (Epi::AFTER_DRAIN) { E.fused(acc, cur, wr, wc, fr, fq, lds, wid, lane); S.done(cur); }
#undef PG8_SA
#undef PG8_SB
#undef PG8_STAGE
#undef PG8_LDA
#undef PG8_LDB
#undef PG8_MMA
#undef PG8_WAIT_V
#undef PG8_WAIT_L
#undef PG8_BAR
#undef PG8_SCHED
}
}

#define GAS __attribute__((address_space(1)))
#define LAS __attribute__((address_space(3)))
typedef unsigned short bf16;
typedef unsigned v4u __attribute__((ext_vector_type(4)));
typedef float f32x4 __attribute__((ext_vector_type(4)));
typedef short bf16x8 __attribute__((ext_vector_type(8)));
typedef GAS unsigned gu32;
typedef GAS unsigned long long gu64;
#define RLX_AGENT __ATOMIC_RELAXED, __HIP_MEMORY_SCOPE_AGENT
#define LDS_WAIT() asm volatile("s_waitcnt lgkmcnt(0)" ::: "memory")
#define VM_WAIT() asm volatile("s_waitcnt vmcnt(0)" ::: "memory")
__device__ __forceinline__ unsigned long long rt() { return __builtin_amdgcn_s_memrealtime(); }
__device__ __forceinline__ unsigned f2bf(float f) { unsigned u = __builtin_bit_cast(unsigned, f); return (u + 0x7fffu + ((u >> 16) & 1u)) >> 16; }
__device__ __forceinline__ unsigned pk2(float lo, float hi) { return f2bf(lo) | (f2bf(hi) << 16); }

#define XB_TMO      128
#define XB_XCNT(j)  (256  + 64 * (j))
#define XB_XSUB(j)  (1280 + 64 * (j))
#define XB_XGEN(j)  (2304 + 64 * (j))
#define XB_TOP      3328
#define XB_TOPGEN   3392
#define XCD_BAR_WORDS 3456
#define XB_SPIN_CAP (1u << 18)

__device__ __forceinline__ unsigned xb_ld(unsigned* p)              { return __hip_atomic_load(p, __ATOMIC_RELAXED, __HIP_MEMORY_SCOPE_AGENT); }
__device__ __forceinline__ unsigned xb_add(unsigned* p, unsigned v) { return __hip_atomic_fetch_add(p, v, __ATOMIC_RELAXED, __HIP_MEMORY_SCOPE_AGENT); }
__device__ __forceinline__ unsigned xb_xcc_id() { return (unsigned)__builtin_amdgcn_s_getreg((3 << 11) | 20) & 0xFu; }
#define XB_SPIN(cond, bar) do { unsigned _sp = 0; while (cond) { __builtin_amdgcn_s_sleep(1); \
    if ((++_sp & 255u) == 0u) { if (xb_ld(&(bar)[XB_TMO])) break; if (_sp > XB_SPIN_CAP) { atomicAdd(&(bar)[XB_TMO], 1u); break; } } } } while (0)

struct XcdBarrier {
    unsigned* bar; unsigned x;
    volatile LAS unsigned* st;
};

__device__ __forceinline__ XcdBarrier xcd_barrier_post(unsigned* bar, volatile LAS unsigned* st, const int wave) {
    XcdBarrier b; b.bar = bar; b.x = xb_xcc_id(); b.st = st;
    if (wave == 0 && pg8::lane_id_v() == 0) (void)xb_add(&bar[XB_XCNT(b.x)], 1u);
    return b;
}
__device__ __forceinline__ void xcd_barrier_complete(unsigned* bar, unsigned x, unsigned& nloc, unsigned& nx) {
    const unsigned G = gridDim.x * gridDim.y * gridDim.z;
    unsigned sum, cnt, mine, sp = 0u;
    for (;;) {
        sum = 0u; cnt = 0u; mine = 0u;
#pragma unroll
        for (unsigned j = 0; j < 16; ++j) { const unsigned c = xb_ld(&bar[XB_XCNT(j)]); sum += c; cnt += (c > 0u) ? 1u : 0u; mine = (j == x) ? c : mine; }
        if (sum == G) break;
        __builtin_amdgcn_s_sleep(1);
        if ((++sp & 255u) == 0u) { if (xb_ld(&bar[XB_TMO])) break; if (sp > XB_SPIN_CAP) { atomicAdd(&bar[XB_TMO], 1u); break; } }
    }
    nloc = mine > 0u ? mine : 1u; nx = cnt > 0u ? cnt : 1u;
}

__device__ __forceinline__ void xcd_barrier(const XcdBarrier& b, const int wave) {
    asm volatile("s_waitcnt vmcnt(0)" ::: "memory");
    __syncthreads();
    if (wave == 0 && pg8::lane_id_v() == 0) {
        unsigned* bar = b.bar;
        __builtin_amdgcn_s_waitcnt(0);
        unsigned nloc = b.st[0], nx = b.st[1];
        if (nloc == 0u) { xcd_barrier_complete(bar, b.x, nloc, nx); b.st[0] = nloc; b.st[1] = nx; }
        const unsigned old = xb_add(&bar[XB_XSUB(b.x)], 1u);
        const unsigned gen = old / nloc;
        if (old + 1u == (gen + 1u) * nloc) {
            __builtin_amdgcn_fence(__ATOMIC_RELEASE, "agent");
            asm volatile("s_waitcnt vmcnt(0)" ::: "memory");
            const unsigned og = xb_add(&bar[XB_TOP], 1u);
            const unsigned tg = og / nx;
            if (og + 1u == (tg + 1u) * nx) xb_add(&bar[XB_TOPGEN], 1u);
            else XB_SPIN(xb_ld(&bar[XB_TOPGEN]) == tg, bar);
            __builtin_amdgcn_fence(__ATOMIC_ACQUIRE, "agent");
            xb_add(&bar[XB_XGEN(b.x)], 1u);
            asm volatile("s_waitcnt vmcnt(0)" ::: "memory");
        } else {
            XB_SPIN(xb_ld(&bar[XB_XGEN(b.x)]) == gen, bar);
            __builtin_amdgcn_fence(__ATOMIC_ACQUIRE, "agent");
            asm volatile("s_waitcnt vmcnt(0)" ::: "memory");
        }
    }
    __syncthreads();
}


__device__ __forceinline__ void group_sync(unsigned* cnt, unsigned want, unsigned* tmo, const int wave) {
    asm volatile("s_waitcnt vmcnt(0)" ::: "memory");
    __syncthreads();
    if (wave == 0 && pg8::lane_id_v() == 0) {
        __builtin_amdgcn_fence(__ATOMIC_RELEASE, "agent");
        asm volatile("s_waitcnt vmcnt(0)" ::: "memory");
        (void)xb_add(cnt, 1u);
        unsigned sp = 0u;
        while (xb_ld(cnt) < want) { __builtin_amdgcn_s_sleep(1); if ((++sp & 255u) == 0u) { if (xb_ld(tmo)) break; if (sp > XB_SPIN_CAP) { atomicAdd(tmo, 1u); break; } } }
        __builtin_amdgcn_fence(__ATOMIC_ACQUIRE, "agent");
        asm volatile("s_waitcnt vmcnt(0)" ::: "memory");
    }
    __syncthreads();
}

constexpr int NWAVES = 8;
constexpr int BATCH = 4, SEQ = 4096, D = 1024, M = BATCH * SEQ, NPROJ = 8192, FF = 4096, NMOD = 6 * D;
constexpr int RH = 4, DK = 128, DV = 256, SCH = 256  , NJ = SEQ / SCH  ;
constexpr float EPS = 1e-6f;
constexpr int KS_MOD = 8;
constexpr size_t MiB = 1u << 20;
constexpr size_t WS_CTL = 0, CTL_ZERO_BYTES = 1 * MiB;
constexpr size_t WS_MODP = 1 * MiB;
constexpr size_t WS_MODF = 2 * MiB + 512 * 1024;
constexpr size_t WS_BIAS2 = WS_MODF + 128 * 1024;
constexpr size_t WS_SSQ2 = 3 * MiB, WS_SSQ3 = 4 * MiB;
constexpr size_t WS_WIN = 5 * MiB, WS_WRC = 21 * MiB, WS_WO = 25 * MiB, WS_W1 = 27 * MiB, WS_W2 = 35 * MiB;
constexpr size_t WS_ST = WS_WIN;
constexpr size_t WS_QK = 44 * MiB, WS_V = 76 * MiB, WS_R = 108 * MiB, WS_END = 236 * MiB;
constexpr size_t WS_MERGED = WS_QK, WS_HHAT = WS_V, WS_HID = WS_R;
constexpr size_t OUT_U = 0, OUT_Z = 32 * MiB, OUT_KV = 0;
static_assert(WS_W2 + (size_t)D * FF * 2 <= WS_QK && WS_HID + (size_t)M * FF * 2 <= WS_END, "d_ws map");
constexpr int CW_TMO = 0, CW_BAR = 4096, CW_GRP = 32768;
constexpr int RING_OFF = 0, PHASE_BYTES = 139264, LDSCTL_OFF = PHASE_BYTES, MISC_OFF = LDSCTL_OFF + 320, TAB_OFF = LDSCTL_OFF + 1024, LDS_BYTES = PHASE_BYTES + 4096;

struct Frame {
    LAS unsigned char* lds; volatile LAS unsigned* MISC; gu32* ctl;
    int wave, vcu, G;
    const float *x, *c, *w_ada, *b_ada, *norm1_w, *w_in, *ret_gn_w, *conv_w, *w_ret_out, *w_conv_out, *w_o, *norm2_w, *w_ff1, *w_ff2, *final_norm_w; const int* positions;
    float* out; unsigned char* ws;
};
__device__ __forceinline__ float wave_sum(float v) {
#pragma unroll
    for (int o = 1; o < 64; o <<= 1) v += __shfl_xor(v, o);
    return v;
}
__device__ __forceinline__ unsigned cvtpk2(float lo, float hi) { return pg8::cvtpk(lo, hi); }

__device__ __forceinline__ int vmap_in(int n) {
    if (n < 1024) { const int hb = n & ~127, d = n & 127; const int dd = d & 63; return hb + 8 * (dd >> 2) + (d >= 64 ? 4 : 0) + (dd & 3); }
    if (n >= 4096 && n < 6144) { const int j = (n - 4096) & 1023; return 4096 + 8 * (j >> 2) + (n >= 5120 ? 4 : 0) + (j & 3); }
    return n;
}
struct P0Tile { const float* W; bf16* WT; int N, ldt, kofs, k0, n0, vm; };
__device__ __forceinline__ P0Tile p0_tile(const Frame& F, int t) {
    P0Tile T; int r = t;
    if (r < 512) { T.W = F.w_in; T.WT = (bf16*)(F.ws + WS_WIN); T.N = NPROJ; T.ldt = D; T.kofs = 0; T.vm = 1; T.n0 = 512 * (r >> 5); T.k0 = 32 * (r & 31); return T; } r -= 512;
    if (r < 64) { T.W = F.w_ret_out; T.WT = (bf16*)(F.ws + WS_WRC); T.N = D; T.ldt = 2 * D; T.kofs = 0; T.vm = 0; T.n0 = 512 * (r >> 5); T.k0 = 32 * (r & 31); return T; } r -= 64;
    if (r < 64) { T.W = F.w_conv_out; T.WT = (bf16*)(F.ws + WS_WRC); T.N = D; T.ldt = 2 * D; T.kofs = D; T.vm = 0; T.n0 = 512 * (r >> 5); T.k0 = 32 * (r & 31); return T; } r -= 64;
    if (r < 64) { T.W = F.w_o; T.WT = (bf16*)(F.ws + WS_WO); T.N = D; T.ldt = D; T.kofs = 0; T.vm = 0; T.n0 = 512 * (r >> 5); T.k0 = 32 * (r & 31); return T; } r -= 64;
    if (r < 256) { T.W = F.w_ff1; T.WT = (bf16*)(F.ws + WS_W1); T.N = FF; T.ldt = D; T.kofs = 0; T.vm = 0; T.n0 = 512 * (r >> 5); T.k0 = 32 * (r & 31); return T; } r -= 256;
    T.W = F.w_ff2; T.WT = (bf16*)(F.ws + WS_W2); T.N = D; T.ldt = FF; T.kofs = 0; T.vm = 0; T.n0 = 512 * (r >> 7); T.k0 = 32 * (r & 127); return T;
}
constexpr int P0_NTILES = 512 + 3 * 64 + 256 + 256;
__device__ __forceinline__ void p0_dma(const P0Tile& T, LAS unsigned char* buf, int wave, int lane) {
#pragma unroll
    for (int i = 0; i < 8; ++i) { const int row = 4 * wave + (i >> 1), half = i & 1;
        __builtin_amdgcn_global_load_lds((const unsigned*)(T.W + (size_t)(T.k0 + row) * T.N + T.n0 + half * 256 + lane * 4), (LAS unsigned*)(buf + row * 2048 + half * 1024), 16, 0, 2  ); }
}
__device__ __forceinline__ float siluf_(float x) { return x / (1.0f + __expf(-x)); }
__device__ __forceinline__ void p0_prologue(Frame& F) {
    const int lane_ = pg8::lane_id_v(), tid_ = F.wave * 64 + lane_; (void)tid_;
    const int gw = F.vcu * NWAVES + F.wave, NGW = F.G * NWAVES;
    for (int vb = F.vcu; vb < 32 * KS_MOD; vb += F.G) {
        const int cb = vb & 31, ks = vb >> 5, k0 = ks * (D / KS_MOD) + 16 * F.wave; const int col = 192 * cb + 4 * (lane_ < 48 ? lane_ : 0);
        f32x4 a0 = {0.f, 0.f, 0.f, 0.f}, a1 = a0, a2 = a0, a3 = a0;
        const float* wp = F.w_ada + (size_t)k0 * NMOD + col;
        f32x4 wv[16];
#pragma unroll
        for (int kk = 0; kk < 16; ++kk) wv[kk] = __builtin_nontemporal_load((const GAS f32x4*)(wp + (size_t)kk * NMOD));
#pragma unroll
        for (int kk = 0; kk < 16; ++kk) { const int k = k0 + kk; const float s0 = siluf_(F.c[k]), s1 = siluf_(F.c[D + k]), s2 = siluf_(F.c[2 * D + k]), s3 = siluf_(F.c[3 * D + k]);
            a0 += wv[kk] * s0; a1 += wv[kk] * s1; a2 += wv[kk] * s2; a3 += wv[kk] * s3; }
        LAS f32x4* red = (LAS f32x4*)(F.lds + RING_OFF);
        if (lane_ < 48) { LAS f32x4* rp = red + (F.wave * 4) * 48 + lane_; rp[0] = a0; rp[48] = a1; rp[96] = a2; rp[144] = a3; }
        __syncthreads();
        if (tid_ < 192) { f32x4 sacc = {0.f, 0.f, 0.f, 0.f};
#pragma unroll
            for (int w = 0; w < NWAVES; ++w) sacc += red[w * 192 + tid_];
            *(f32x4*)((float*)(F.ws + WS_MODP) + (size_t)ks * 4 * NMOD + (size_t)(tid_ / 48) * NMOD + 192 * cb + 4 * (tid_ % 48)) = sacc; }
        __syncthreads();
    }
    const int t0 = (int)(((long)F.vcu * P0_NTILES) / F.G), t1 = (int)(((long)(F.vcu + 1) * P0_NTILES) / F.G);
    if (t0 < t1) { const P0Tile T0 = p0_tile(F, t0); p0_dma(T0, F.lds + RING_OFF, F.wave, lane_); }
    for (int t = t0; t < t1; ++t) {
        LAS unsigned char* buf = F.lds + RING_OFF + ((t - t0) & 1) * 65536;
        const P0Tile T = p0_tile(F, t);
        __syncthreads();
        if (t + 1 < t1) { const P0Tile Tn = p0_tile(F, t + 1); p0_dma(Tn, F.lds + RING_OFF + ((t + 1 - t0) & 1) * 65536, F.wave, lane_); }
        float v[32];
#pragma unroll
        for (int k = 0; k < 32; ++k) v[k] = *(const LAS float*)(buf + k * 2048 + tid_ * 4);
        const int n = T.n0 + tid_, vr = T.vm ? vmap_in(n) : n;
        GAS v4u* dst = (GAS v4u*)(T.WT + (size_t)vr * T.ldt + T.kofs + T.k0);
#pragma unroll
        for (int c = 0; c < 4; ++c) { v4u o; o.x = cvtpk2(v[8 * c], v[8 * c + 1]); o.y = cvtpk2(v[8 * c + 2], v[8 * c + 3]); o.z = cvtpk2(v[8 * c + 4], v[8 * c + 5]); o.w = cvtpk2(v[8 * c + 6], v[8 * c + 7]); dst[c] = o; }
    }
    __syncthreads();
}

__device__ __forceinline__ float modp_sum(const float* modp, int idx) { float s = 0.f;
#pragma unroll
    for (int ks = 0; ks < KS_MOD; ++ks) s += modp[(size_t)ks * 4 * NMOD + idx];
    return s; }
__device__ __forceinline__ void p1_unorm(Frame& F) {
    const int lane_ = pg8::lane_id_v(), tid_ = F.wave * 64 + lane_; (void)tid_;
    const float* modp = (const float*)(F.ws + WS_MODP); float* modf = (float*)(F.ws + WS_MODF);
    const int blk = F.vcu;
    const int b = blk >> 6;
    LAS float* cs1 = (LAS float*)(F.lds + RING_OFF); LAS float* sh1 = cs1 + D;
    for (int k = tid_; k < D; k += NWAVES * 64) {
        const float sh = modp_sum(modp, b * NMOD + k) + F.b_ada[k], sc = modp_sum(modp, b * NMOD + D + k) + F.b_ada[D + k];
        cs1[k] = F.norm1_w[k] * (1.0f + sc); sh1[k] = sh; }
    if (tid_ < 96) { const int idx = blk * 96 + tid_; if (idx < 4 * NMOD) modf[idx] = modp_sum(modp, idx) + F.b_ada[idx % NMOD]; }
    __syncthreads();
    bf16* U = (bf16*)((unsigned char*)F.out + OUT_U);
    for (int r0 = 0; r0 < 8; r0 += 4) {
        f32x4 v[4][4]; float ss[4];
#pragma unroll
        for (int q = 0; q < 4; ++q) { const int m = blk * 64 + F.wave * 8 + r0 + q; const GAS f32x4* xr = (const GAS f32x4*)(F.x + (size_t)m * D) + lane_;
#pragma unroll
            for (int j = 0; j < 4; ++j) v[q][j] = __builtin_nontemporal_load(xr + 64 * j); }
#pragma unroll
        for (int q = 0; q < 4; ++q) { float s = 0.f;
#pragma unroll
            for (int j = 0; j < 4; ++j) s += (v[q][j].x * v[q][j].x + v[q][j].y * v[q][j].y) + (v[q][j].z * v[q][j].z + v[q][j].w * v[q][j].w);
            ss[q] = 1.0f / sqrtf(wave_sum(s) * (1.0f / D) + EPS); }
#pragma unroll
        for (int q = 0; q < 4; ++q) { const int m = blk * 64 + F.wave * 8 + r0 + q; GAS unsigned long long* o8 = (GAS unsigned long long*)(U + (size_t)m * D) + lane_;
#pragma unroll
            for (int j = 0; j < 4; ++j) { const int k = 4 * lane_ + 256 * j; const f32x4 a = *(const LAS f32x4*)(cs1 + k), sh = *(const LAS f32x4*)(sh1 + k);
                const f32x4 u = v[q][j] * ss[q] * a + sh;
                o8[64 * j] = (unsigned long long)cvtpk2(u.x, u.y) | ((unsigned long long)cvtpk2(u.z, u.w) << 32); } }
    }
}

typedef short s16x4 __attribute__((ext_vector_type(4)));
typedef float f32x16 __attribute__((ext_vector_type(16)));
#define MFMA32(a, b, c) __builtin_amdgcn_mfma_f32_32x32x16_bf16((a), (b), (c), 0, 0, 0)
__device__ __forceinline__ int crow(int reg, int hh) { return (reg & 3) + 8 * (reg >> 2) + 4 * hh; }
__device__ __forceinline__ bf16x8 tr_frag(LAS unsigned char* p) {
    const s16x4 lo = __builtin_amdgcn_ds_read_tr16_b64_v4i16((LAS s16x4*)p), hi = __builtin_amdgcn_ds_read_tr16_b64_v4i16((LAS s16x4*)(p + 512));
    return __builtin_shufflevector(lo, hi, 0, 1, 2, 3, 4, 5, 6, 7);
}
__device__ __forceinline__ float log2_gamma(int hd) { return log2f(1.0f - exp2f(-5.0f - (float)hd)); }
constexpr int RT_K = 0, RT_V = 8192, RT_BLK = 24576;
__device__ __forceinline__ void p3a_kvsum(Frame& F, int unit) {
    const int lane_ = pg8::lane_id_v(), tid_ = F.wave * 64 + lane_; (void)tid_;
    const int bh = unit >> 4, J = unit & 15, b = bh >> 2, hd = bh & 3;
    const bf16* QK = (const bf16*)(F.ws + WS_QK); const bf16* V = (const bf16*)(F.ws + WS_V);
    float* KV = (float*)((unsigned char*)F.out + OUT_KV) + (size_t)unit * (DV * DK);
    const int tid = tid_, lane = lane_, w = F.wave, r = lane & 31, hh = lane >> 5;
    const float l2g = log2_gamma(hd);
    const size_t mbase = (size_t)b * SEQ + (size_t)J * SCH;
    const int krow_ = tid >> 4, kch = tid & 15;
    const bf16* kp = QK + (mbase + krow_) * 1024 + 512 + hd * DK + kch * 8;
    const bf16* vp0 = V + (mbase + (tid >> 5)) * 1024 + hd * DV + (tid & 31) * 8;
    const int kdst = RT_K + (kch >> 2) * 2048 + krow_ * 64 + (kch & 3) * 16;
    const int vdst0 = RT_V + ((tid & 31) >> 2) * 2048 + (tid >> 5) * 64 + (tid & 3) * 16;
    const int lane_off = (4 * hh + ((lane & 15) >> 2)) * 64 + ((lane >> 4) & 1) * 32 + (lane & 3) * 8;
    f32x16 acc[4];
#pragma unroll
    for (int d = 0; d < 4; ++d)
#pragma unroll
        for (int i = 0; i < 16; ++i) acc[d][i] = 0.f;
    v4u kreg = *(const GAS v4u*)kp, vreg0 = *(const GAS v4u*)vp0, vreg1 = *(const GAS v4u*)(vp0 + 16 * 1024);
    for (int sb = 0; sb < 8; ++sb) {
        __syncthreads();
        { const float dec = __builtin_amdgcn_exp2f((float)(255 - (32 * sb + krow_)) * l2g); v4u o;
#pragma unroll
          for (int j = 0; j < 4; ++j) o[j] = cvtpk2(pg8::bflo(kreg[j]) * dec, pg8::bfhi(kreg[j]) * dec);
          *(LAS v4u*)(F.lds + kdst) = o; *(LAS v4u*)(F.lds + vdst0) = vreg0; *(LAS v4u*)(F.lds + vdst0 + 16 * 64) = vreg1; }
        __syncthreads();
        if (sb < 7) { const size_t o = (size_t)(sb + 1) * 32 * 1024; kreg = *(const GAS v4u*)(kp + o); vreg0 = *(const GAS v4u*)(vp0 + o); vreg1 = *(const GAS v4u*)(vp0 + o + 16 * 1024); }
#pragma unroll
        for (int ks2 = 0; ks2 < 2; ++ks2) {
            const bf16x8 bv = tr_frag(F.lds + RT_V + w * 2048 + ks2 * 1024 + lane_off);
#pragma unroll
            for (int d = 0; d < 4; ++d) { const bf16x8 ak = tr_frag(F.lds + RT_K + d * 2048 + ks2 * 1024 + lane_off); acc[d] = MFMA32(ak, bv, acc[d]); }
        }
    }
#pragma unroll
    for (int d = 0; d < 4; ++d)
#pragma unroll
        for (int g = 0; g < 4; ++g) { f32x4 o = {acc[d][4 * g], acc[d][4 * g + 1], acc[d][4 * g + 2], acc[d][4 * g + 3]};
            *(GAS f32x4*)(KV + (size_t)(32 * w + r) * DK + 32 * d + 8 * g + 4 * hh) = o; }
    __syncthreads();
}
__device__ __forceinline__ void p3a_conv(Frame& F, int blk) {
    const int lane_ = pg8::lane_id_v(), tid_ = F.wave * 64 + lane_; (void)tid_;
    bf16* Rb = (bf16*)(F.ws + WS_R); const bf16* Z = (const bf16*)((unsigned char*)F.out + OUT_Z);
    const int cc = tid_ & 127, rg = tid_ >> 7, m0 = blk * 64 + rg * 16, c0 = cc * 8;
    float w0[8], w1[8], w2[8];
#pragma unroll
    for (int e = 0; e < 8; ++e) { w0[e] = F.conv_w[c0 + e]; w1[e] = F.conv_w[D + c0 + e]; w2[e] = F.conv_w[2 * D + c0 + e]; }
    v4u zm2 = {0u, 0u, 0u, 0u}, zm1 = {0u, 0u, 0u, 0u};
    if ((m0 & (SEQ - 1)) != 0) { zm2 = *(const GAS v4u*)(Z + (size_t)(m0 - 2) * 1024 + c0); zm1 = *(const GAS v4u*)(Z + (size_t)(m0 - 1) * 1024 + c0); }
#pragma unroll 4
    for (int i = 0; i < 16; ++i) { const int m = m0 + i;
        const v4u z0 = *(const GAS v4u*)(Z + (size_t)m * 1024 + c0); bf16* cp = Rb + (size_t)(m >> 8) * 1048576 + (size_t)(m & 255) * 2048 + 1024 + c0; const v4u cb = *(const GAS v4u*)cp; v4u o;
#pragma unroll
        for (int j = 0; j < 4; ++j) {
            const float lo = pg8::bflo(cb[j]) * (w0[2 * j] * pg8::bflo(zm2[j]) + w1[2 * j] * pg8::bflo(zm1[j]) + w2[2 * j] * pg8::bflo(z0[j]));
            const float hi = pg8::bfhi(cb[j]) * (w0[2 * j + 1] * pg8::bfhi(zm2[j]) + w1[2 * j + 1] * pg8::bfhi(zm1[j]) + w2[2 * j + 1] * pg8::bfhi(z0[j]));
            o[j] = cvtpk2(lo, hi); }
        *(GAS v4u*)cp = o; zm2 = zm1; zm1 = z0; }
}
__device__ __forceinline__ void p3a_bias2(Frame& F) {
    const int lane_ = pg8::lane_id_v(), tid_ = F.wave * 64 + lane_; (void)tid_;
    const float* modf = (const float*)(F.ws + WS_MODF); const bf16* W1_t = (const bf16*)(F.ws + WS_W1); float* bias2 = (float*)(F.ws + WS_BIAS2);
    const int gw = F.vcu * NWAVES + F.wave, NGW = F.G * NWAVES;
    for (int f = gw; f < FF; f += NGW) { float a[4] = {0.f, 0.f, 0.f, 0.f};
#pragma unroll
        for (int i = 0; i < 2; ++i) { const int k0 = (lane_ + 64 * i) * 8; const v4u wv = *(const GAS v4u*)(W1_t + (size_t)f * D + k0);
#pragma unroll
            for (int bb = 0; bb < 4; ++bb) { const float* sh = modf + bb * NMOD + 3 * D + k0; const f32x4 s0 = *(const f32x4*)sh, s1 = *(const f32x4*)(sh + 4);
                a[bb] += pg8::bflo(wv[0]) * s0[0] + pg8::bfhi(wv[0]) * s0[1] + pg8::bflo(wv[1]) * s0[2] + pg8::bfhi(wv[1]) * s0[3]
                       + pg8::bflo(wv[2]) * s1[0] + pg8::bfhi(wv[2]) * s1[1] + pg8::bflo(wv[3]) * s1[2] + pg8::bfhi(wv[3]) * s1[3]; } }
#pragma unroll
        for (int bb = 0; bb < 4; ++bb) { const float s = wave_sum(a[bb]); if (lane_ == 0) bias2[bb * FF + f] = s; } }
}
__device__ __forceinline__ void p3b_scan(Frame& F) {
    const int lane_ = pg8::lane_id_v(), tid_ = F.wave * 64 + lane_; (void)tid_;
    const float* KV = (const float*)((unsigned char*)F.out + OUT_KV); bf16* ST = (bf16*)(F.ws + WS_ST);
    const int NT = F.G * NWAVES * 64;
    for (int t = F.vcu * (NWAVES * 64) + tid_; t < 16 * (DV * DK / 4); t += NT) {
        const int bh = t / (DV * DK / 4), e = (t % (DV * DK / 4)) * 4; const float g = exp2f(256.0f * log2_gamma(bh & 3));
        f32x4 kv[NJ];
#pragma unroll
        for (int J = 0; J < NJ; ++J) kv[J] = *(const GAS f32x4*)(KV + ((size_t)(bh * NJ + J)) * (DV * DK) + e);
        f32x4 S = {0.f, 0.f, 0.f, 0.f};
#pragma unroll
        for (int J = 0; J < NJ; ++J) { *(GAS unsigned long long*)(ST + ((size_t)(bh * NJ + J)) * (DV * DK) + e) = (unsigned long long)cvtpk2(S[0], S[1]) | ((unsigned long long)cvtpk2(S[2], S[3]) << 32);
            S = S * g + kv[J]; }
    }
}
constexpr int RC_ST = 0, RC_STP = 272, RC_BLK0 = 69632, RC_STG = 528;
__device__ __forceinline__ void p3c_retout(Frame& F, int unit, bf16* OUTP, bool dummy_out) {
    const int lane_ = pg8::lane_id_v(), tid_ = F.wave * 64 + lane_; (void)tid_;
    const int bh = unit >> 4, J = unit & 15, b = bh >> 2, hd = bh & 3;
    const bf16* QK = (const bf16*)(F.ws + WS_QK); const bf16* V = (const bf16*)(F.ws + WS_V); const bf16* ST = (const bf16*)(F.ws + WS_ST) + (size_t)unit * (DV * DK);
    const bf16* Rb = (const bf16*)(F.ws + WS_R);
    const int tid = tid_, lane = lane_, w = F.wave, r = lane & 31, hh = lane >> 5;
    const float l2g = log2_gamma(hd);
    const size_t mbase = (size_t)b * SEQ + (size_t)J * SCH;
    const int krow_ = tid >> 4, kch = tid & 15;
    const bf16* kp = QK + (mbase + krow_) * 1024 + 512 + hd * DK + kch * 8;
    const bf16* vp0 = V + (mbase + (tid >> 5)) * 1024 + hd * DV + (tid & 31) * 8;
    const int kdst = RT_K + (kch >> 2) * 2048 + krow_ * 64 + (kch & 3) * 16;
    const int vdst0 = RT_V + ((tid & 31) >> 2) * 2048 + (tid >> 5) * 64 + (tid & 3) * 16;
    const int lane_off = (4 * hh + ((lane & 15) >> 2)) * 64 + ((lane >> 4) & 1) * 32 + (lane & 3) * 8;
    v4u kreg = *(const GAS v4u*)kp, vreg0 = *(const GAS v4u*)vp0, vreg1 = *(const GAS v4u*)(vp0 + 16 * 1024);
#pragma unroll
    for (int i = 0; i < 8; ++i) { const int idx = tid + 512 * i, row = idx >> 4, ch = idx & 15; *(LAS v4u*)(F.lds + RC_ST + row * RC_STP + ch * 16) = *(const GAS v4u*)(ST + (size_t)row * DK + ch * 8); }
    bf16x8 qf[8];
    { const bf16* qp = QK + (mbase + 32 * w + r) * 1024 + hd * DK + 8 * hh;
#pragma unroll
      for (int ks = 0; ks < 8; ++ks) qf[ks] = *(const GAS bf16x8*)(qp + 16 * ks); }
    f32x16 acc[8];
#pragma unroll
    for (int c8 = 0; c8 < 8; ++c8)
#pragma unroll
        for (int i = 0; i < 16; ++i) acc[c8][i] = 0.f;
    __syncthreads();
#pragma unroll
    for (int c8 = 0; c8 < 8; ++c8)
        {
#pragma unroll
          for (int ks = 0; ks < 8; ++ks) { const bf16x8 sf = *(const LAS bf16x8*)(F.lds + RC_ST + (32 * c8 + r) * RC_STP + (16 * ks + 8 * hh) * 2); acc[c8] = MFMA32(qf[ks], sf, acc[c8]); } __builtin_amdgcn_sched_barrier(0); }
    int t1v = 32 * w + 4 * hh + 1; asm volatile("" : "+v"(t1v));
#pragma unroll
    for (int i = 0; i < 16; ++i) { const float sc = __builtin_amdgcn_exp2f((float)(t1v + (i & 3) + 8 * (i >> 2)) * l2g);
#pragma unroll
        for (int c8 = 0; c8 < 8; ++c8) acc[c8][i] *= sc; }
    const int sbmax = w | 1;
    __syncthreads();
    LAS unsigned char* qsl = F.lds + RC_ST + w * 8192 + lane * 16;
#pragma unroll
    for (int ks = 0; ks < 8; ++ks) *(LAS bf16x8*)(qsl + ks * 1024) = qf[ks];
    for (int sb = 0; sb < 8; ++sb) {
        LAS unsigned char* buf = F.lds + RC_BLK0 + (sb & 1) * RT_BLK;
        *(LAS v4u*)(buf + kdst) = kreg; *(LAS v4u*)(buf + vdst0) = vreg0; *(LAS v4u*)(buf + vdst0 + 16 * 64) = vreg1;
        __syncthreads();
        if (sb < 7) { const size_t o = (size_t)(sb + 1) * 32 * 1024; kreg = *(const GAS v4u*)(kp + o); vreg0 = *(const GAS v4u*)(vp0 + o); vreg1 = *(const GAS v4u*)(vp0 + o + 16 * 1024); }
        if (sb <= sbmax) {
            f32x16 X;
#pragma unroll
            for (int i = 0; i < 16; ++i) X[i] = 0.f;
#pragma unroll
            for (int ks = 0; ks < 8; ++ks) { const bf16x8 kf = *(const LAS bf16x8*)(buf + RT_K + (ks >> 1) * 2048 + r * 64 + (ks & 1) * 32 + hh * 16); const bf16x8 qv = *(const LAS bf16x8*)(qsl + ks * 1024); X = MFMA32(kf, qv, X); }
            int tcv = 32 * w + r - 32 * sb - 4 * hh; asm volatile("" : "+v"(tcv));
#pragma unroll
            for (int i = 0; i < 16; ++i) { const int dt = tcv - ((i & 3) + 8 * (i >> 2)); X[i] *= __builtin_amdgcn_exp2f((float)(dt < 0 ? -dt : dt) * l2g); }
            bf16x8 pa[2];
#pragma unroll
            for (int s2 = 0; s2 < 2; ++s2) { v4u p; p[0] = cvtpk2(X[8 * s2], X[8 * s2 + 1]); p[1] = cvtpk2(X[8 * s2 + 2], X[8 * s2 + 3]); p[2] = cvtpk2(X[8 * s2 + 4], X[8 * s2 + 5]); p[3] = cvtpk2(X[8 * s2 + 6], X[8 * s2 + 7]);
                pa[s2] = __builtin_bit_cast(bf16x8, p); }
#pragma unroll
            for (int c8 = 0; c8 < 8; ++c8)
                {
#pragma unroll
                  for (int s2 = 0; s2 < 2; ++s2) { const bf16x8 bv = tr_frag(buf + RT_V + c8 * 2048 + s2 * 1024 + lane_off); acc[c8] = MFMA32(pa[s2], bv, acc[c8]); } if (c8 & 1) __builtin_amdgcn_sched_barrier(0); }
        }
    }
    __syncthreads();
    LAS unsigned char* stg = F.lds + w * (32 * RC_STG);
    LAS unsigned char* stgl = stg + 4 * hh * RC_STG + 2 * r;
#pragma unroll
    for (int i = 0; i < 16; ++i) {
        float s = 0.f;
#pragma unroll
        for (int c8 = 0; c8 < 8; ++c8) s += acc[c8][i];
        s += __shfl_xor(s, 1); s += __shfl_xor(s, 2); s += __shfl_xor(s, 4); s += __shfl_xor(s, 8); s += __shfl_xor(s, 16);
        const float mu = s * (1.0f / DV); float q = 0.f;
#pragma unroll
        for (int c8 = 0; c8 < 8; ++c8) { const float d = acc[c8][i] - mu; q += d * d; }
        q += __shfl_xor(q, 1); q += __shfl_xor(q, 2); q += __shfl_xor(q, 4); q += __shfl_xor(q, 8); q += __shfl_xor(q, 16);
        const float rs = 1.0f / sqrtf(q * (1.0f / DV) + EPS);
        LAS unsigned short* srow = (LAS unsigned short*)(stgl + ((i & 3) + 8 * (i >> 2)) * RC_STG);
#pragma unroll
        for (int c8 = 0; c8 < 8; ++c8) srow[32 * c8] = (unsigned short)(cvtpk2((acc[c8][i] - mu) * rs, 0.f) & 0xffffu);
    }
    LDS_WAIT(); asm volatile("" ::: "memory");
#pragma unroll 4
    for (int i = 0; i < 16; ++i) { const int idx = lane + 64 * i, row = idx >> 5, ch = idx & 31;
        const v4u y = *(const LAS v4u*)(stg + row * RC_STG + ch * 16);
        const size_t mrow = mbase + 32 * w + row; const bf16* ogp = Rb + (mrow >> 8) * 1048576 + (mrow & 255) * 2048 + hd * DV + ch * 8; const v4u og = *(const GAS v4u*)ogp; bf16* op = OUTP + (dummy_out ? mrow * 1024 : (mrow >> 8) * 1048576 + (mrow & 255) * 2048) + hd * DV + ch * 8;
        const float* gw = F.ret_gn_w + hd * DV + ch * 8; const f32x4 g0 = *(const f32x4*)gw, g1 = *(const f32x4*)(gw + 4); v4u o;
        o[0] = cvtpk2(pg8::bflo(y[0]) * g0[0] * pg8::bflo(og[0]), pg8::bfhi(y[0]) * g0[1] * pg8::bfhi(og[0]));
        o[1] = cvtpk2(pg8::bflo(y[1]) * g0[2] * pg8::bflo(og[1]), pg8::bfhi(y[1]) * g0[3] * pg8::bfhi(og[1]));
        o[2] = cvtpk2(pg8::bflo(y[2]) * g1[0] * pg8::bflo(og[2]), pg8::bfhi(y[2]) * g1[1] * pg8::bfhi(og[2]));
        o[3] = cvtpk2(pg8::bflo(y[3]) * g1[2] * pg8::bflo(og[3]), pg8::bfhi(y[3]) * g1[3] * pg8::bfhi(og[3]));
        *(GAS v4u*)op = o; }
    __syncthreads();
}
__device__ __forceinline__ void p8_final(Frame& F, float* outp) {
    const int lane_ = pg8::lane_id_v(), tid_ = F.wave * 64 + lane_; (void)tid_;
    const float* ssq = (const float*)(F.ws + WS_SSQ3);
    const int gw = F.vcu * NWAVES + F.wave, NGW = F.G * NWAVES;
    f32x4 wv[4];
#pragma unroll
    for (int j = 0; j < 4; ++j) wv[j] = *(const f32x4*)(F.final_norm_w + 4 * lane_ + 256 * j);
    for (int m = gw; m < M; m += NGW) {
        float s = (lane_ < 16) ? ssq[(size_t)m * 16 + lane_] : 0.f; s = wave_sum(s);
        const float rstd = 1.0f / sqrtf(s * (1.0f / D) + EPS);
        const GAS f32x4* xr = (const GAS f32x4*)(F.out + (size_t)m * D) + lane_; GAS f32x4* xo = (GAS f32x4*)(outp + (size_t)m * D) + lane_;
#pragma unroll
        for (int j = 0; j < 4; ++j) { const f32x4 v = xr[64 * j]; xo[64 * j] = v * rstd * wv[j]; }
    }
}

namespace pg8 {
struct EpiRes2Norm {
    static constexpr bool PERM = true, AFTER_DRAIN = true, HAS_MID = false;
    const float* h1; float* out; const float* modf; const float* wf; float* ssq; unsigned* cnt; unsigned* tmo;
    __device__ __forceinline__ void mid(f32x4 (&)[2][2][4][2], const Unit&, int, int, int, int) const {}
    __device__ __forceinline__ void fused(f32x4 (&acc)[2][2][4][2], const Unit& u, int wr, int wc, int fr_, int fq_, PG8_LAS unsigned char* lds, int wid, int lane) const {
        int fr = fr_, fq = fq_; asm volatile("" : "+v"(fr), "+v"(fq));
        const int rl0 = wr * 64 + fr, row0 = u.pm * BM + rl0, col0 = u.pn * BM + wc * 32 + 8 * fq, b = u.pm >> 4;
        PG8_LAS float* P = (PG8_LAS float*)lds;
        { f32x4 g2[2][2];
#pragma unroll
          for (int bj = 0; bj < 2; ++bj)
#pragma unroll
            for (int n = 0; n < 2; ++n) g2[bj][n] = *(const f32x4*)(modf + b * 6144 + 5120 + col0 + bj * HALF + 4 * n);
#pragma unroll
          for (int ai = 0; ai < 2; ++ai)
#pragma unroll
            for (int m = 0; m < 4; ++m) { const size_t off = (size_t)(row0 + ai * HALF + m * 16) * 1024 + col0; float q = 0.f;
#pragma unroll
                for (int bj = 0; bj < 2; ++bj) { const f32x4 x0 = *(const f32x4*)(h1 + off + bj * HALF), x1 = *(const f32x4*)(h1 + off + bj * HALF + 4);
                    const f32x4 h0 = x0 + g2[bj][0] * acc[ai][bj][m][0], hb = x1 + g2[bj][1] * acc[ai][bj][m][1];
                    acc[ai][bj][m][0] = h0; acc[ai][bj][m][1] = hb;
                    q += (h0[0] * h0[0] + h0[1] * h0[1]) + (h0[2] * h0[2] + h0[3] * h0[3]) + (hb[0] * hb[0] + hb[1] * hb[1]) + (hb[2] * hb[2] + hb[3] * hb[3]); }
                q += __shfl_xor(q, 16); q += __shfl_xor(q, 32);
                if (fq == 0) P[(rl0 + ai * HALF + m * 16) * 4 + wc] = q; } }
        asm volatile("s_waitcnt lgkmcnt(0)" ::: "memory"); __builtin_amdgcn_s_barrier(); asm volatile("" ::: "memory");
        { const int t = wid * 64 + lane; if (t < 256) { const f32x4 p = *(const PG8_LAS f32x4*)(P + t * 4); ssq[(size_t)(u.pm * BM + t) * 4 + u.pn] = (p[0] + p[1]) + (p[2] + p[3]); } }
        group_sync(cnt, 4u, tmo, wid);
        f32x4 wv[2][2];
#pragma unroll
        for (int bj = 0; bj < 2; ++bj)
#pragma unroll
            for (int n = 0; n < 2; ++n) wv[bj][n] = *(const f32x4*)(wf + col0 + bj * HALF + 4 * n);
#pragma unroll
        for (int ai = 0; ai < 2; ++ai)
#pragma unroll
            for (int m = 0; m < 4; ++m) { const int row = row0 + ai * HALF + m * 16; const f32x4 p = *(const f32x4*)(ssq + (size_t)row * 4);
                const float rs = 1.0f / sqrtf(((p[0] + p[1]) + (p[2] + p[3])) * (1.0f / 1024.0f) + 1e-6f); const size_t off = (size_t)row * 1024 + col0;
#pragma unroll
                for (int bj = 0; bj < 2; ++bj) { *(f32x4*)(out + off + bj * HALF) = acc[ai][bj][m][0] * rs * wv[bj][0]; *(f32x4*)(out + off + bj * HALF + 4) = acc[ai][bj][m][1] * rs * wv[bj][1]; } }
    }
};
}

constexpr int N_PHASES = 10;
struct Args { const void* in[16]; float* out; unsigned char* ws; int ph_lo, ph_hi, use_bar, pad; };
__global__ void __launch_bounds__(NWAVES * 64, 2) hyb_fwd(Args args) {
    extern __shared__ __attribute__((aligned(16))) unsigned char lds[];
    Frame F;
    F.lds = (LAS unsigned char*)lds; F.MISC = (volatile LAS unsigned*)(F.lds + MISC_OFF);
    F.wave = __builtin_amdgcn_readfirstlane((int)threadIdx.x >> 6);
    F.G = gridDim.x; { const int bx = blockIdx.x; F.vcu = (F.G % 8 == 0) ? (bx % 8) * (F.G / 8) + bx / 8 : bx; }
    F.ws = args.ws; F.out = args.out; F.ctl = (gu32*)(args.ws + WS_CTL);
    F.x = (const float*)args.in[0]; F.c = (const float*)args.in[1]; F.positions = (const int*)args.in[2]; F.w_ada = (const float*)args.in[3]; F.b_ada = (const float*)args.in[4];
    F.norm1_w = (const float*)args.in[5]; F.w_in = (const float*)args.in[6]; F.ret_gn_w = (const float*)args.in[7]; F.conv_w = (const float*)args.in[8]; F.w_ret_out = (const float*)args.in[9];
    F.w_conv_out = (const float*)args.in[10]; F.w_o = (const float*)args.in[11]; F.norm2_w = (const float*)args.in[12]; F.w_ff1 = (const float*)args.in[13]; F.w_ff2 = (const float*)args.in[14];
    F.final_norm_w = (const float*)args.in[15];
    for (int u = F.wave * 64 + pg8::lane_id_v(); u < (LDS_BYTES - LDSCTL_OFF) / 4; u += NWAVES * 64) ((LAS unsigned*)(F.lds + LDSCTL_OFF))[u] = 0u;
    __syncthreads();
    XcdBarrier bar; bar.bar = (unsigned*)(F.ctl + CW_BAR); bar.x = 0; bar.st = nullptr;
    if (args.use_bar) bar = xcd_barrier_post((unsigned*)(F.ctl + CW_BAR), F.MISC + 8, F.wave);
    const int lo = args.ph_lo, hi = args.ph_hi;
#ifndef PH_MASK
#define PH_MASK 0x7ff
#endif
#define IN(k) (((PH_MASK >> (k)) & 1) && lo <= (k) && (k) < hi)
#ifndef PH_TWICE
#define PH_TWICE 0
#endif
#define REP(k) for (int rep_ = 0; rep_ < (((PH_TWICE >> (k)) & 1) ? 2 : 1); ++rep_)
#ifdef PH_TA
    unsigned long long ta_ = __builtin_amdgcn_s_memrealtime(), tb_ = ta_;
#define STAMP(id) do { if ((id) == PH_TA) ta_ = __builtin_amdgcn_s_memrealtime(); if ((id) == PH_TB) tb_ = __builtin_amdgcn_s_memrealtime(); } while (0)
#else
#define STAMP(id) do { } while (0)
#endif
#define GSYNC(stage) group_sync((unsigned*)(F.ctl + CW_GRP + ((stage) * 64 + gpm_) * 64), 4u, (unsigned*)(F.ctl + CW_BAR + XB_TMO), F.wave)
#define SEAM(k) do { STAMP(2 * (k)); if (IN(k) && IN((k) + 1)) xcd_barrier(bar, F.wave); STAMP(2 * (k) + 1); } while (0)
    unsigned char* ws = args.ws;
    bf16* U = (bf16*)((unsigned char*)args.out + OUT_U);

#ifdef PH_MAXP0
    const unsigned long long tk0_ = __builtin_amdgcn_s_memrealtime();
    if (IN(0)) { p0_prologue(F); }
    if (F.wave == 0 && pg8::lane_id_v() == 0) __hip_atomic_store((unsigned*)(F.ctl + 16384 + blockIdx.x), (unsigned)(__builtin_amdgcn_s_memrealtime() - tk0_), __ATOMIC_RELAXED, __HIP_MEMORY_SCOPE_AGENT);
    SEAM(0);
    unsigned mx_ = 0, amx_ = 0;
    if (blockIdx.x == 0 && F.wave == 0) { for (int i = 0; i < (int)gridDim.x; ++i) { const unsigned v = __hip_atomic_load((unsigned*)(F.ctl + 16384 + i), __ATOMIC_RELAXED, __HIP_MEMORY_SCOPE_AGENT); if (v > mx_) { mx_ = v; amx_ = i; } } }
#else
    if (IN(0)) REP(0) { p0_prologue(F); } SEAM(0);
#endif
    if (IN(1)) REP(1) { p1_unorm(F); } SEAM(1);
    if (IN(2)) REP(2) {
        pg8::Gemm g{U, (const bf16*)(ws + WS_WIN), M, NPROJ, D, (size_t)256 * D * 2}; pg8::StaticOrder S; S.init(M, NPROJ, F.G, (int)blockIdx.x);
        pg8::EpiProj E{(bf16*)(ws + WS_QK), (bf16*)(ws + WS_V), (bf16*)(ws + WS_R), (bf16*)((unsigned char*)args.out + OUT_Z), F.positions};
        pg8::gemm_phase<pg8::EpiProj, pg8::StaticOrder, true, true>(F.lds + RING_OFF, g, S, E, F.wave);
    } SEAM(2);
    if (IN(3)) { REP(3) { for (int u = F.vcu; u < 256; u += F.G) p3a_kvsum(F, u); } for (int bk = F.vcu; bk < 256; bk += F.G) p3a_conv(F, bk); REP(11) { p3a_bias2(F); } } SEAM(3);
    if (IN(4)) REP(4) { p3b_scan(F); } SEAM(4);
#ifdef PH_XBAR
    for (int xb_ = 0; xb_ < PH_XBAR; ++xb_) xcd_barrier(bar, F.wave);
#endif
    if (IN(5)) REP(5) { const bool dummy = ((PH_TWICE >> 5) & 1) && rep_ == 0;
        for (int u = F.vcu; u < 256; u += F.G) p3c_retout(F, u, dummy ? (bf16*)((unsigned char*)args.out + OUT_Z) : (bf16*)(ws + WS_R), dummy); } SEAM(5);
    int gpm_ = 0; { pg8::StaticOrder S; S.init(M, D, F.G, (int)blockIdx.x); pg8::Unit u0; if (S.next(0, u0)) gpm_ = u0.pm; }
    if (IN(6)) REP(6) {
        pg8::Gemm g{(const bf16*)(ws + WS_R), (const bf16*)(ws + WS_WRC), M, D, 2 * D, (size_t)2 * MiB}; pg8::StaticOrder S; S.init(M, D, F.G, (int)blockIdx.x);
        pg8::EpiMerge E{(const bf16*)(ws + WS_R), (bf16*)(ws + WS_MERGED)};
        pg8::gemm_phase<pg8::EpiMerge, pg8::StaticOrder, false, true>(F.lds + RING_OFF, g, S, E, F.wave);
    } if (IN(6) && IN(7)) { STAMP(12); GSYNC(0); STAMP(13); }
    if (IN(7)) REP(7) {
        pg8::Gemm g{(const bf16*)(ws + WS_MERGED), (const bf16*)(ws + WS_WO), M, D, D, (size_t)256 * D * 2}; pg8::StaticOrder S; S.init(M, D, F.G, (int)blockIdx.x);
        pg8::EpiRes1 E{F.x, args.out, (bf16*)(ws + WS_HHAT), (const float*)(ws + WS_MODF), F.norm2_w, (float*)(ws + WS_SSQ2)};
        pg8::gemm_phase<pg8::EpiRes1, pg8::StaticOrder, false, true>(F.lds + RING_OFF, g, S, E, F.wave);
    } if (IN(7) && IN(8)) { STAMP(14); GSYNC(1); STAMP(15); }
    if (IN(8)) REP(8) {
        pg8::Gemm g{(const bf16*)(ws + WS_HHAT), (const bf16*)(ws + WS_W1), M, FF, D, (size_t)256 * D * 2}; pg8::StaticOrder S; S.init(M, FF, F.G, (int)blockIdx.x);
        pg8::Unit u0; LAS float* tab = (LAS float*)(F.lds + TAB_OFF); const int tid_ = F.wave * 64 + pg8::lane_id_v();
        if (S.next(0, u0)) { if (tid_ < 256) { const float* sq = (const float*)(ws + WS_SSQ2) + (size_t)(u0.pm * 256 + tid_) * 16; const f32x4 a = *(const f32x4*)sq, b = *(const f32x4*)(sq + 4), c = *(const f32x4*)(sq + 8), d = *(const f32x4*)(sq + 12);
            const float s = ((a[0] + a[1]) + (a[2] + a[3])) + ((b[0] + b[1]) + (b[2] + b[3])) + ((c[0] + c[1]) + (c[2] + c[3])) + ((d[0] + d[1]) + (d[2] + d[3]));
            tab[tid_] = 1.0f / sqrtf(s * (1.0f / D) + EPS); } }
        __syncthreads();
        pg8::EpiFF1 E{(const float*)(ws + WS_BIAS2), (const LAS float*)tab, (bf16*)(ws + WS_HID)};
        pg8::gemm_phase<pg8::EpiFF1, pg8::StaticOrder, true, true>(F.lds + RING_OFF, g, S, E, F.wave);
    } if (IN(8) && IN(9)) { STAMP(16); GSYNC(2); STAMP(17); }
    if (IN(9)) {
        pg8::Gemm g{(const bf16*)(ws + WS_HID), (const bf16*)(ws + WS_W2), M, D, FF, (size_t)256 * FF * 2}; pg8::StaticOrder S; S.init(M, D, F.G, (int)blockIdx.x);
        pg8::EpiRes2Norm E{args.out, args.out, (const float*)(ws + WS_MODF), F.final_norm_w, (float*)(ws + WS_SSQ3), (unsigned*)(F.ctl + CW_GRP + (3 * 64 + gpm_) * 64), (unsigned*)(F.ctl + CW_BAR + XB_TMO)};
        pg8::gemm_phase<pg8::EpiRes2Norm, pg8::StaticOrder, false, true>(F.lds + RING_OFF, g, S, E, F.wave);
    }
    STAMP(18); STAMP(19);
#ifdef PH_MAXP0
    if (blockIdx.x == 0 && F.wave == 0) { const unsigned long long te = __builtin_amdgcn_s_memrealtime(), d = (PH_MAXP0 == 1) ? (unsigned long long)mx_ * 4ull : (unsigned long long)amx_ * 100ull; while (__builtin_amdgcn_s_memrealtime() - te < d) __builtin_amdgcn_s_sleep(8); }
#endif
#ifdef PH_TA
    STAMP(20); STAMP(21);
    if ((int)blockIdx.x == PH_BLK && F.wave == 0) { const unsigned long long te = __builtin_amdgcn_s_memrealtime(), d = (tb_ - ta_) * 4ull; while (__builtin_amdgcn_s_memrealtime() - te < d) __builtin_amdgcn_s_sleep(8); }
#endif
#undef IN
#undef SEAM
}

#ifndef HYB_N_LAUNCHES
#define HYB_N_LAUNCHES 1
#endif
extern "C" void kernel_launch(void* const* d_in, const int* in_sizes, int n_in, void* d_out, int out_size, void* d_ws, size_t ws_size, hipStream_t stream) {
    static int grid = 0;
    if (grid == 0) {
        if (n_in != 16 || in_sizes[0] != M * D || out_size != M * D || ws_size < WS_END) { fprintf(stderr, "kernel_launch: unexpected shapes (n_in %d, in0 %d, out %d, ws %zu); nothing launched\n", n_in, n_in > 0 ? in_sizes[0] : -1, out_size, ws_size); grid = -1; return; }
        int dev = 0, cus = 0, per_cu = 0;
        if (hipGetDevice(&dev) != hipSuccess || hipDeviceGetAttribute(&cus, hipDeviceAttributeMultiprocessorCount, dev) != hipSuccess) { grid = -1; return; }
        if (hipFuncSetAttribute((const void*)hyb_fwd, hipFuncAttributeMaxDynamicSharedMemorySize, LDS_BYTES) != hipSuccess) { fprintf(stderr, "kernel_launch: hipFuncSetAttribute failed\n"); grid = -1; return; }
        if (hipOccupancyMaxActiveBlocksPerMultiprocessor(&per_cu, (const void*)hyb_fwd, NWAVES * 64, LDS_BYTES) != hipSuccess || per_cu < 1) { fprintf(stderr, "kernel_launch: occupancy query says %d workgroups per CU; nothing launched\n", per_cu); (void)hipGetLastError(); grid = -1; return; }
        { bool okp = true; pg8::StaticOrder S; for (int c = 0; c < cus && okp; ++c) { S.init(M, FF, cus, c); pg8::Unit u0, u; if (!S.next(0, u0)) continue; for (int i = 1; S.next(i, u); ++i) okp = okp && (u.pm == u0.pm); }
          if (!okp) { fprintf(stderr, "kernel_launch: FF1's unit order does not keep a workgroup inside one row panel on %d CUs; nothing launched\n", cus); grid = -1; return; } }
        { bool okp = true; pg8::StaticOrder S1, S4; for (int c = 0; c < cus && okp; ++c) { S1.init(M, D, cus, c); S4.init(M, FF, cus, c); pg8::Unit a, b2; okp = S1.next(0, a) && S4.next(0, b2) && a.pm == b2.pm && !S1.next(1, b2); }
          if (!okp || cus != 256) { fprintf(stderr, "kernel_launch: the row-panel chain needs 256 CUs with one N=1024 unit each in the panel of their FF1 units; nothing launched\n"); grid = -1; return; } }
        grid = cus;
        if (grid != 256) fprintf(stderr, "kernel_launch: %d CUs (built for 256)\n", grid);
    }
    if (grid < 0) return;
    (void)hipMemsetAsync((char*)d_ws + WS_CTL, 0, CTL_ZERO_BYTES, stream);
    Args a{};
    for (int i = 0; i < 16; ++i) a.in[i] = d_in[i];
    a.out = (float*)d_out; a.ws = (unsigned char*)d_ws;
#if HYB_N_LAUNCHES == 1
    a.ph_lo = 0; a.ph_hi = N_PHASES; a.use_bar = 1;
    hipLaunchKernelGGL(hyb_fwd, dim3(grid), dim3(NWAVES * 64), LDS_BYTES, stream, a);
#ifdef PH_WHOLE2
    (void)hipMemsetAsync((char*)d_ws + WS_CTL, 0, CTL_ZERO_BYTES, stream);
    hipLaunchKernelGGL(hyb_fwd, dim3(grid), dim3(NWAVES * 64), LDS_BYTES, stream, a);
#endif
#else
    for (int p = 0; p < N_PHASES; ++p) { a.ph_lo = p; a.ph_hi = p + 1; a.use_bar = 0; hipLaunchKernelGGL(hyb_fwd, dim3(grid), dim3(NWAVES * 64), LDS_BYTES, stream, a); }
#endif
}
```

```cpp
#include <hip/hip_runtime.h>
#include <cstdio>
#include <cstdint>
namespace pg8 {
#define PG8_LAS __attribute__((address_space(3)))
typedef unsigned short bf16_t;
typedef short bf16x8 __attribute__((ext_vector_type(8)));
typedef float f32x4 __attribute__((ext_vector_type(4)));
typedef unsigned u32x4 __attribute__((ext_vector_type(4)));
constexpr int BM = 256, BK = 64, HALF = 128, HTB = HALF * BK * 2  , STAGE_BYTES = 8 * HTB, NXCD = 8, WGM = 8;

__host__ __device__ __forceinline__ int lds_byte(int r, int c) { const int st = (r >> 4) * 2 + (c >> 5), rr = r & 15, cc = c & 31, ob = rr * 64 + cc * 2; return st * 1024 + (ob ^ (((ob >> 9) & 1) << 5)); }
__host__ __device__ __forceinline__ void stage_rc(int b, int& R, int& C) { const int st = b / 1024, sb = b % 1024, swz = sb ^ (((sb >> 9) & 1) << 5); R = (st >> 1) * 16 + swz / 64; C = (st & 1) * 32 + (swz % 64) / 2; }
__host__ __device__ __forceinline__ int perm32(int rho) { const int n = rho >> 4, i = rho & 15; return 8 * (i >> 2) + 4 * n + (i & 3); }

struct Unit { int pm, pn; };
struct Gemm { const bf16_t* A; const bf16_t* Bt; int M, N, K; size_t a_pstride; };

struct StaticOrder {
    int nM, nN, nwg, G, c;
    __host__ __device__ void init(int M, int N, int G_, int c_) { nM = M / BM; nN = N / BM; nwg = nM * nN; G = G_; c = c_; }
    __host__ __device__ bool next(int i, Unit& u) const {
        const long L = (long)i * G + c; if (L >= nwg) return false;
        int wgid = (int)L; { const int q = nwg / NXCD, r = nwg % NXCD, xcd = wgid % NXCD, off = wgid / NXCD; wgid = (xcd < r ? xcd * (q + 1) : r * (q + 1) + (xcd - r) * q) + off; }
        const int nig = WGM * nN, gid = wgid / nig, fm = gid * WGM, gsz = (nM - fm) < WGM ? (nM - fm) : WGM;
        u.pm = fm + ((wgid % nig) % gsz); u.pn = (wgid % nig) / gsz; return true;
    }
    __device__ __forceinline__ void a_ready(const Unit&) const {}
    __device__ __forceinline__ void done(const Unit&) const {}
};

__device__ __forceinline__ unsigned cvt_pk_bf16(float lo, float hi) { unsigned r; asm volatile("v_cvt_pk_bf16_f32 %0, %1, %2" : "=v"(r) : "v"(lo), "v"(hi)); return r; }
typedef float f32x2 __attribute__((ext_vector_type(2)));
__device__ __forceinline__ int lane_id_v() { int l; asm volatile("v_mbcnt_lo_u32_b32 %0, -1, 0\n\tv_mbcnt_hi_u32_b32 %0, -1, %0" : "=v"(l)); return l; }
typedef unsigned u32x2 __attribute__((ext_vector_type(2)));
__device__ __forceinline__ unsigned cvtpk(float lo, float hi) { typedef float f2_t __attribute__((ext_vector_type(2))); typedef __bf16 b2_t __attribute__((ext_vector_type(2))); f2_t v = {lo, hi}; b2_t b = __builtin_convertvector(v, b2_t); return __builtin_bit_cast(unsigned, b); }
__device__ __forceinline__ float bflo(unsigned w) { return __builtin_bit_cast(float, w << 16); }
__device__ __forceinline__ float bfhi(unsigned w) { return __builtin_bit_cast(float, w & 0xffff0000u); }
__device__ __forceinline__ float fast_rcp(float x) { return __builtin_amdgcn_rcpf(x); }
__device__ __forceinline__ float sigmoidf_(float x) { return fast_rcp(1.0f + __expf(-x)); }
__device__ __forceinline__ void sincos_rev(float ang, float& s, float& c) {
    const float I2P = 0.15915493667125702f, I2P_LO = 6.420638326565253e-09f;
    const float r = ang * I2P; float e = __builtin_fmaf(ang, I2P, -r); e = __builtin_fmaf(ang, I2P_LO, e);
    const float k = __builtin_rintf(r); const float f = (r - k) + e;
    s = __builtin_amdgcn_sinf(f); c = __builtin_amdgcn_cosf(f);
}
__device__ __forceinline__ u32x4 pack8(const f32x4 a, const f32x4 b) { u32x4 w; w.x = cvtpk(a[0], a[1]); w.y = cvtpk(a[2], a[3]); w.z = cvtpk(b[0], b[1]); w.w = cvtpk(b[2], b[3]); return w; }

struct EpiProj {
    static constexpr int EPI_ID = 1;
    static constexpr bool PERM = true, AFTER_DRAIN = false, HAS_MID = false;
    bf16_t* QK; bf16_t* V; bf16_t* R; bf16_t* Z; const int* pos;
    __device__ __forceinline__ void mid(f32x4 (&)[2][2][4][2], const Unit&, int, int, int, int) const {}
    __device__ __forceinline__ void operator()(const f32x4 (&acc)[2][2][4][2], const Unit& u, int wr, int wc, int fr, int fq) const {
        const int row0 = u.pm * BM + wr * 64 + fr, cw = wc * 32 + 8 * fq, pn = u.pn;
        if (pn < 4) {
            const float ksc = pn >= 2 ? 0.08838834764831845f : 1.0f;
            const int g = 4 * wc + fq; float invf[4];
#pragma unroll
            for (int i = 0; i < 4; ++i) invf[i] = exp2f(-(float)(4 * g + i) * (13.287712379549449f / 64.0f));
#pragma unroll
            for (int ai = 0; ai < 2; ++ai)
#pragma unroll
                for (int m = 0; m < 4; ++m) { const int row = row0 + ai * HALF + m * 16; const float p = (float)pos[row];
                    f32x4 cs, sn;
#pragma unroll
                    for (int i = 0; i < 4; ++i) { float s_, c_; sincos_rev(p * invf[i], s_, c_); cs[i] = c_ * ksc; sn[i] = s_ * ksc; }
                    bf16_t* rowp = QK + (size_t)row * 1024 + pn * 256 + cw;
#pragma unroll
                    for (int bj = 0; bj < 2; ++bj) { const f32x4 x1 = acc[ai][bj][m][0], x2 = acc[ai][bj][m][1];
                        const f32x4 o1 = x1 * cs - x2 * sn, o2 = x1 * sn + x2 * cs;
                        *(u32x4*)(rowp + bj * HALF) = pack8(o1, o2); } }
        } else if (pn >= 16 && pn < 24) {
#pragma unroll
            for (int ai = 0; ai < 2; ++ai)
#pragma unroll
                for (int m = 0; m < 4; ++m) { const int row = row0 + ai * HALF + m * 16; bf16_t* rowp = Z + (size_t)row * 1024 + (((pn - 16) * 256 + cw) >> 1);
#pragma unroll
                    for (int bj = 0; bj < 2; ++bj) { const f32x4 z = acc[ai][bj][m][0] * acc[ai][bj][m][1]; u32x2 w; w.x = cvtpk(z[0], z[1]); w.y = cvtpk(z[2], z[3]);
                        *(u32x2*)(rowp + bj * (HALF / 2)) = w; } }
        } else {
            bf16_t* base; int ld, mode;
            if (pn < 8) { base = V + (size_t)u.pm * BM * 1024 + (pn - 4) * 256; ld = 1024; mode = 0; }
            else if (pn < 12) { base = R + (size_t)u.pm * 1048576 + (pn - 8) * 256; ld = 2048; mode = 1; }
            else if (pn < 16) { base = R + (size_t)u.pm * 1048576 + 1024 + (pn - 12) * 256; ld = 2048; mode = 0; }
            else { base = R + (size_t)u.pm * 1048576 + 524288 + (pn - 24) * 256; ld = 2048; mode = 2; }
            const int rl0 = wr * 64 + fr;
#pragma unroll
            for (int ai = 0; ai < 2; ++ai)
#pragma unroll
                for (int m = 0; m < 4; ++m) { const int rl = rl0 + ai * HALF + m * 16; bf16_t* rowp = base + (size_t)rl * ld + cw;
#pragma unroll
                    for (int bj = 0; bj < 2; ++bj) { f32x4 v0 = acc[ai][bj][m][0], v1 = acc[ai][bj][m][1];
                        if (mode != 0) {
#pragma unroll
                            for (int i = 0; i < 4; ++i) { const float s0 = sigmoidf_(v0[i]), s1 = sigmoidf_(v1[i]); v0[i] = mode == 1 ? v0[i] * s0 : s0; v1[i] = mode == 1 ? v1[i] * s1 : s1; } }
                        *(u32x4*)(rowp + bj * HALF) = pack8(v0, v1); } }
        }
    }
};

struct EpiMerge {
    static constexpr int EPI_ID = 2;
    static constexpr bool PERM = true, AFTER_DRAIN = false, HAS_MID = true;
    const bf16_t* R; bf16_t* MERGED;
    __device__ __forceinline__ void mid(f32x4 (&acc)[2][2][4][2], const Unit& u, int wr, int wc, int fr, int fq) const {
        const int rl0 = wr * 64 + fr, col0 = u.pn * BM + wc * 32 + 8 * fq; const bf16_t* G = R + (size_t)u.pm * 1048576 + 524288;
#pragma unroll
        for (int ai = 0; ai < 2; ++ai)
#pragma unroll
            for (int m = 0; m < 4; ++m) { const bf16_t* rowp = G + (size_t)(rl0 + ai * HALF + m * 16) * 2048 + col0;
#pragma unroll
                for (int bj = 0; bj < 2; ++bj) { const u32x4 ga = *(const u32x4*)(rowp + bj * HALF), gb = *(const u32x4*)(rowp + 1024 + bj * HALF);
#pragma unroll
                    for (int j = 0; j < 4; ++j) { const float a0 = bflo(ga[j]), a1 = bfhi(ga[j]); const float b0 = fmaxf(bflo(gb[j]), 1e-30f), b1 = fmaxf(bfhi(gb[j]), 1e-30f);
                        acc[ai][bj][m][j >> 1][2 * (j & 1)] *= a0 * fast_rcp(b0); acc[ai][bj][m][j >> 1][2 * (j & 1) + 1] *= a1 * fast_rcp(b1); } } }
    }
    __device__ __forceinline__ void operator()(const f32x4 (&acc)[2][2][4][2], const Unit& u, int wr, int wc, int fr, int fq) const {
        const int row0 = u.pm * BM + wr * 64 + fr, col0 = u.pn * BM + wc * 32 + 8 * fq;
#pragma unroll
        for (int ai = 0; ai < 2; ++ai)
#pragma unroll
            for (int m = 0; m < 4; ++m) { const int row = row0 + ai * HALF + m * 16; const bf16_t* gp = R + (size_t)u.pm * 1048576 + 524288 + (size_t)(row - u.pm * BM) * 2048 + 1024 + col0; bf16_t* op = MERGED + (size_t)row * 1024 + col0;
#pragma unroll
                for (int bj = 0; bj < 2; ++bj) { const u32x4 gb = *(const u32x4*)(gp + bj * HALF); f32x4 v0 = acc[ai][bj][m][0], v1 = acc[ai][bj][m][1];
                    v0[0] *= fmaxf(bflo(gb[0]), 1e-30f); v0[1] *= fmaxf(bfhi(gb[0]), 1e-30f); v0[2] *= fmaxf(bflo(gb[1]), 1e-30f); v0[3] *= fmaxf(bfhi(gb[1]), 1e-30f);
                    v1[0] *= fmaxf(bflo(gb[2]), 1e-30f); v1[1] *= fmaxf(bfhi(gb[2]), 1e-30f); v1[2] *= fmaxf(bflo(gb[3]), 1e-30f); v1[3] *= fmaxf(bfhi(gb[3]), 1e-30f);
                    *(u32x4*)(op + bj * HALF) = pack8(v0, v1); } }
    }
};

struct EpiRes1 {
    static constexpr int EPI_ID = 3;
    static constexpr bool PERM = true, AFTER_DRAIN = false, HAS_MID = false;
    const float* x; float* h1; bf16_t* hhat; const float* modf; const float* norm2w; float* ssq;
    __device__ __forceinline__ void mid(f32x4 (&)[2][2][4][2], const Unit&, int, int, int, int) const {}
    __device__ __forceinline__ void operator()(const f32x4 (&acc)[2][2][4][2], const Unit& u, int wr, int wc, int fr, int fq) const {
        const int row0 = u.pm * BM + wr * 64 + fr, col0 = u.pn * BM + wc * 32 + 8 * fq, b = u.pm >> 4;
        f32x4 g1[2][2], cs[2][2];
#pragma unroll
        for (int bj = 0; bj < 2; ++bj)
#pragma unroll
            for (int n = 0; n < 2; ++n) { const int c = col0 + bj * HALF + 4 * n; g1[bj][n] = *(const f32x4*)(modf + b * 6144 + 2048 + c);
                const f32x4 sc = *(const f32x4*)(modf + b * 6144 + 4096 + c), w = *(const f32x4*)(norm2w + c); cs[bj][n] = w * (sc + 1.0f); }
#pragma unroll
        for (int ai = 0; ai < 2; ++ai)
#pragma unroll
            for (int m = 0; m < 4; ++m) { const int row = row0 + ai * HALF + m * 16; const size_t off = (size_t)row * 1024 + col0; float q = 0.f;
#pragma unroll
                for (int bj = 0; bj < 2; ++bj) { const f32x4 x0 = *(const f32x4*)(x + off + bj * HALF), x1 = *(const f32x4*)(x + off + bj * HALF + 4);
                    const f32x4 h0 = x0 + g1[bj][0] * acc[ai][bj][m][0], hb = x1 + g1[bj][1] * acc[ai][bj][m][1];
                    *(f32x4*)(h1 + off + bj * HALF) = h0; *(f32x4*)(h1 + off + bj * HALF + 4) = hb;
                    q += (h0[0] * h0[0] + h0[1] * h0[1]) + (h0[2] * h0[2] + h0[3] * h0[3]) + (hb[0] * hb[0] + hb[1] * hb[1]) + (hb[2] * hb[2] + hb[3] * hb[3]);
                    *(u32x4*)(hhat + off + bj * HALF) = pack8(h0 * cs[bj][0], hb * cs[bj][1]); }
                q += __shfl_xor(q, 16); q += __shfl_xor(q, 32);
                if (fq == 0) ssq[(size_t)row * 16 + u.pn * 4 + wc] = q; }
    }
};

struct EpiFF1 {
    static constexpr int EPI_ID = 4;
    static constexpr bool PERM = true, AFTER_DRAIN = false, HAS_MID = false;
    const float* bias2; const PG8_LAS float* rstd; bf16_t* HID;
    __device__ __forceinline__ void mid(f32x4 (&)[2][2][4][2], const Unit&, int, int, int, int) const {}
    __device__ __forceinline__ void operator()(const f32x4 (&acc)[2][2][4][2], const Unit& u, int wr, int wc, int fr, int fq) const {
        const int rl0 = wr * 64 + fr, col0 = u.pn * BM + wc * 32 + 8 * fq, b = u.pm >> 4;
        f32x4 bv[2][2];
#pragma unroll
        for (int bj = 0; bj < 2; ++bj)
#pragma unroll
            for (int n = 0; n < 2; ++n) bv[bj][n] = *(const f32x4*)(bias2 + b * 4096 + col0 + bj * HALF + 4 * n);
#pragma unroll
        for (int ai = 0; ai < 2; ++ai)
#pragma unroll
            for (int m = 0; m < 4; ++m) { const int rl = rl0 + ai * HALF + m * 16; const float rs = rstd[rl]; bf16_t* op = HID + (size_t)(u.pm * BM + rl) * 4096 + col0;
#pragma unroll
                for (int bj = 0; bj < 2; ++bj) { f32x4 v0 = acc[ai][bj][m][0] * rs + bv[bj][0], v1 = acc[ai][bj][m][1] * rs + bv[bj][1];
#pragma unroll
                    for (int i = 0; i < 4; ++i) { const float a = fmaxf(v0[i], 0.f), c = fmaxf(v1[i], 0.f); v0[i] = a * a; v1[i] = c * c; }
                    *(u32x4*)(op + bj * HALF) = pack8(v0, v1); } }
    }
};

struct EpiRes2 {
    static constexpr int EPI_ID = 5;
    static constexpr bool PERM = true, AFTER_DRAIN = false, HAS_MID = false;
    const float* h; float* ho; const float* modf; float* ssq;
    __device__ __forceinline__ void mid(f32x4 (&)[2][2][4][2], const Unit&, int, int, int, int) const {}
    __device__ __forceinline__ void operator()(const f32x4 (&acc)[2][2][4][2], const Unit& u, int wr, int wc, int fr, int fq) const {
        const int row0 = u.pm * BM + wr * 64 + fr, col0 = u.pn * BM + wc * 32 + 8 * fq, b = u.pm >> 4;
        f32x4 g2[2][2];
#pragma unroll
        for (int bj = 0; bj < 2; ++bj)
#pragma unroll
            for (int n = 0; n < 2; ++n) g2[bj][n] = *(const f32x4*)(modf + b * 6144 + 5120 + col0 + bj * HALF + 4 * n);
#pragma unroll
        for (int ai = 0; ai < 2; ++ai)
#pragma unroll
            for (int m = 0; m < 4; ++m) { const int row = row0 + ai * HALF + m * 16; const size_t off = (size_t)row * 1024 + col0; float q = 0.f;
#pragma unroll
                for (int bj = 0; bj < 2; ++bj) { const f32x4 x0 = *(const f32x4*)(h + off + bj * HALF), x1 = *(const f32x4*)(h + off + bj * HALF + 4);
                    const f32x4 h0 = x0 + g2[bj][0] * acc[ai][bj][m][0], hb = x1 + g2[bj][1] * acc[ai][bj][m][1];
                    *(f32x4*)(ho + off + bj * HALF) = h0; *(f32x4*)(ho + off + bj * HALF + 4) = hb;
                    q += (h0[0] * h0[0] + h0[1] * h0[1]) + (h0[2] * h0[2] + h0[3] * h0[3]) + (hb[0] * hb[0] + hb[1] * hb[1]) + (hb[2] * hb[2] + hb[3] * hb[3]); }
                q += __shfl_xor(q, 16); q += __shfl_xor(q, 32);
                if (fq == 0) ssq[(size_t)row * 16 + u.pn * 4 + wc] = q; }
    }
};

template <class Epi, class Sched, bool ALIGN_EPI = false, bool SP2 = false>
__device__ __forceinline__ void gemm_phase(PG8_LAS unsigned char* lds, const Gemm g, const Sched& S, const Epi& E, const int wid) {
    const int lane = lane_id_v(), tid = wid * 64 + lane, wr = wid >> 2, wc = wid & 3, fr = lane & 15, fq = lane >> 4;
    const int K = g.K, nt = K / BK;
    unsigned voffA[2], voffB[2];
#pragma unroll
    for (int i = 0; i < 2; ++i) { int R, C; stage_rc(tid * 16 + i * 8192, R, C); const int Rb = Epi::PERM ? ((R & ~31) + perm32(R & 31)) : R;
        voffA[i] = (unsigned)(R * K + C) * 2u; voffB[i] = (unsigned)(Rb * K + C) * 2u; }
    const size_t kstep = (size_t)(BK * 2);
    const size_t hstep = (size_t)HALF * K * 2;
    const size_t tstep = 2 * hstep;
    const unsigned ldsw = (unsigned)wid * 1024u;
    const int aoff = lds_byte(wr * 64 + fr, fq * 8), boff = lds_byte(wc * 32 + fr, fq * 8);
#define PG8_SA(b, h) (((b) * 2 + (h)) * HTB)
#define PG8_SB(b, h) ((4 + (b) * 2 + (h)) * HTB)
#define PG8_STAGE(bufoff, gbase, voff) do { _Pragma("unroll") for (int _i = 0; _i < 2; ++_i) \
        __builtin_amdgcn_global_load_lds((const unsigned*)((const char*)(gbase) + (voff)[_i]), (PG8_LAS unsigned*)(lds + (bufoff) + ldsw + _i * 8192), 16, 0, 0); } while (0)
#define PG8_LDA(dst, b, h) do { _Pragma("unroll") for (int m = 0; m < 4; ++m) _Pragma("unroll") for (int k = 0; k < 2; ++k) dst[m][k] = *(const PG8_LAS bf16x8*)(lds + PG8_SA(b, h) + aoff + m * 2048 + k * 1024); } while (0)
#define PG8_LDB(dst, b, h) do { _Pragma("unroll") for (int n = 0; n < 2; ++n) _Pragma("unroll") for (int k = 0; k < 2; ++k) dst[n][k] = *(const PG8_LAS bf16x8*)(lds + PG8_SB(b, h) + boff + n * 2048 + k * 1024); } while (0)
#define PG8_MMA(ai, bj, At, Bt) do { __builtin_amdgcn_s_setprio(1); _Pragma("unroll") for (int m = 0; m < 4; ++m) _Pragma("unroll") for (int n = 0; n < 2; ++n) _Pragma("unroll") for (int k = 0; k < 2; ++k) \
        acc[ai][bj][m][n] = __builtin_amdgcn_mfma_f32_16x16x32_bf16(Bt[n][k], At[m][k], acc[ai][bj][m][n], 0, 0, 0); __builtin_amdgcn_s_setprio(0); } while (0)
#define PG8_WAIT_V(n) asm volatile("s_waitcnt vmcnt(" #n ")" ::: "memory")
#define PG8_WAIT_L(n) asm volatile("s_waitcnt lgkmcnt(" #n ")" ::: "memory")
#define PG8_BAR __builtin_amdgcn_s_barrier()
#define PG8_SCHED __builtin_amdgcn_sched_barrier(0)
    Unit cur, nxt; int ui = 0;
    if (!S.next(0, cur)) return;
    f32x4 acc[2][2][4][2];
#pragma unroll
    for (int a = 0; a < 2; ++a)
#pragma unroll
        for (int b = 0; b < 2; ++b)
#pragma unroll
            for (int m = 0; m < 4; ++m)
#pragma unroll
                for (int n = 0; n < 2; ++n) acc[a][b][m][n] = (f32x4){0.f, 0.f, 0.f, 0.f};
    bf16x8 At[4][2], B0[2][2], B1[2][2];
    const char* cA = (const char*)g.A + (size_t)cur.pm * g.a_pstride; const char* cB = (const char*)g.Bt + (size_t)cur.pn * tstep;
    S.a_ready(cur);
    if constexpr (SP2) {
        PG8_STAGE(PG8_SB(0, 0), cB, voffB); PG8_STAGE(PG8_SB(0, 1), cB + hstep, voffB); PG8_STAGE(PG8_SA(0, 0), cA, voffA); PG8_STAGE(PG8_SA(0, 1), cA + hstep, voffA);
        if (wr == 1) PG8_BAR;
        PG8_WAIT_V(2); PG8_BAR;
        PG8_STAGE(PG8_SB(1, 0), cB + kstep, voffB); PG8_STAGE(PG8_SA(1, 0), cA + kstep, voffA); PG8_STAGE(PG8_SB(1, 1), cB + hstep + kstep, voffB);
        PG8_WAIT_V(6); PG8_BAR;
    } else {
        PG8_STAGE(PG8_SB(0, 0), cB, voffB); PG8_STAGE(PG8_SA(0, 0), cA, voffA); PG8_STAGE(PG8_SB(0, 1), cB + hstep, voffB); PG8_STAGE(PG8_SA(0, 1), cA + hstep, voffA);
        if (wr == 1) PG8_BAR;
        PG8_WAIT_V(4); PG8_BAR;
        PG8_STAGE(PG8_SB(1, 0), cB + kstep, voffB); PG8_STAGE(PG8_SA(1, 0), cA + kstep, voffA); PG8_STAGE(PG8_SB(1, 1), cB + hstep + kstep, voffB);
        PG8_WAIT_V(6); PG8_BAR;
    }
    for (;;) {
        const bool has_next = S.next(ui + 1, nxt);
        const char* nA = has_next ? (const char*)g.A + (size_t)nxt.pm * g.a_pstride : cA; const char* nB = has_next ? (const char*)g.Bt + (size_t)nxt.pn * tstep : cB;
        for (int t = 0; t < nt; t += 2) {
            if constexpr (Epi::HAS_MID) { if (t == (nt >> 1)) { int fr_e = fr, fq_e = fq; asm volatile("" : "+v"(fr_e), "+v"(fq_e)); E.mid(acc, cur, wr, wc, fr_e, fq_e); } }
            const bool last = (t == nt - 2);
            const char* a1 = cA + (size_t)(t + 1) * kstep;
            const char* a2 = last ? nA : cA + (size_t)(t + 2) * kstep; const char* b2 = last ? nB : cB + (size_t)(t + 2) * kstep;
            const char* a3 = a2 + kstep; const char* b3 = b2 + kstep;
            if (last && has_next) S.a_ready(nxt);
            if constexpr (SP2) {
            PG8_LDB(B0, 0, 0); PG8_LDB(B1, 0, 1); PG8_SCHED; PG8_LDA(At, 0, 0); PG8_STAGE(PG8_SA(1, 1), a1 + hstep, voffA);
            PG8_WAIT_V(8); PG8_WAIT_L(0); PG8_BAR; PG8_MMA(0, 0, At, B0); PG8_MMA(0, 1, At, B1); PG8_BAR; PG8_SCHED;
            PG8_LDA(At, 0, 1); PG8_STAGE(PG8_SB(0, 0), b2, voffB); PG8_STAGE(PG8_SB(0, 1), b2 + hstep, voffB); PG8_STAGE(PG8_SA(0, 0), a2, voffA);
            PG8_WAIT_V(8); PG8_WAIT_L(0); PG8_BAR; PG8_MMA(1, 0, At, B0); PG8_MMA(1, 1, At, B1); PG8_BAR; PG8_SCHED;
            PG8_LDB(B0, 1, 0); PG8_LDB(B1, 1, 1); PG8_SCHED; PG8_LDA(At, 1, 0); PG8_STAGE(PG8_SA(0, 1), a2 + hstep, voffA);
            PG8_WAIT_V(8); PG8_WAIT_L(0); PG8_BAR; PG8_MMA(0, 0, At, B0); PG8_MMA(0, 1, At, B1); PG8_BAR; PG8_SCHED;
            PG8_LDA(At, 1, 1); PG8_STAGE(PG8_SB(1, 0), b3, voffB); PG8_STAGE(PG8_SB(1, 1), b3 + hstep, voffB); PG8_STAGE(PG8_SA(1, 0), a3, voffA);
            PG8_WAIT_V(8); PG8_WAIT_L(0); PG8_BAR; PG8_MMA(1, 0, At, B0); PG8_MMA(1, 1, At, B1); PG8_BAR; PG8_SCHED;
            } else {
            PG8_LDB(B0, 0, 0); PG8_SCHED; PG8_LDA(At, 0, 0); PG8_STAGE(PG8_SA(1, 1), a1 + hstep, voffA);
            PG8_WAIT_L(8); PG8_BAR; PG8_WAIT_L(0); PG8_MMA(0, 0, At, B0); PG8_BAR; PG8_SCHED;
            PG8_LDB(B1, 0, 1); PG8_STAGE(PG8_SB(0, 0), b2, voffB);
            PG8_BAR; PG8_WAIT_L(0); PG8_MMA(0, 1, At, B1); PG8_BAR;
            PG8_LDA(At, 0, 1); PG8_STAGE(PG8_SA(0, 0), a2, voffA);
            PG8_BAR; PG8_WAIT_L(0); PG8_MMA(1, 0, At, B0); PG8_BAR; PG8_SCHED;
            PG8_STAGE(PG8_SB(0, 1), b2 + hstep, voffB);
            PG8_WAIT_V(6); PG8_BAR; PG8_MMA(1, 1, At, B1); PG8_BAR;
            PG8_LDB(B0, 1, 0); PG8_SCHED; PG8_LDA(At, 1, 0); PG8_STAGE(PG8_SA(0, 1), a2 + hstep, voffA);
            PG8_WAIT_L(8); PG8_BAR; PG8_WAIT_L(0); PG8_MMA(0, 0, At, B0); PG8_BAR; PG8_SCHED;
            PG8_LDB(B1, 1, 1); PG8_STAGE(PG8_SB(1, 0), b3, voffB);
            PG8_BAR; PG8_WAIT_L(0); PG8_MMA(0, 1, At, B1); PG8_BAR;
            PG8_LDA(At, 1, 1); PG8_STAGE(PG8_SA(1, 0), a3, voffA);
            PG8_BAR; PG8_WAIT_L(0); PG8_MMA(1, 0, At, B0); PG8_BAR; PG8_SCHED;
            PG8_STAGE(PG8_SB(1, 1), b3 + hstep, voffB);
            PG8_WAIT_V(6); PG8_BAR; PG8_MMA(1, 1, At, B1); PG8_BAR;
            }
        }
        if constexpr (ALIGN_EPI) { if (wr == 0) PG8_BAR; }
        if constexpr (!Epi::AFTER_DRAIN) { int fr_e = fr, fq_e = fq; asm volatile("" : "+v"(fr_e), "+v"(fq_e));
            E(acc, cur, wr, wc, fr_e, fq_e);
#ifdef PH_EPI2
            if (Epi::EPI_ID == PH_EPI2) { asm volatile("" : "+v"(fr_e), "+v"(fq_e)); E(acc, cur, wr, wc, fr_e, fq_e); }
#endif
            S.done(cur); }
        if (!has_next) break;
#pragma unroll
        for (int a = 0; a < 2; ++a)
#pragma unroll
            for (int b = 0; b < 2; ++b)
#pragma unroll
                for (int m = 0; m < 4; ++m)
#pragma unroll
                    for (int n = 0; n < 2; ++n) acc[a][b][m][n] = (f32x4){0.f, 0.f, 0.f, 0.f};
        cur = nxt; cA = nA; cB = nB; ++ui;
        if constexpr (ALIGN_EPI) { if (wr == 1) PG8_BAR; }
    }
    PG8_WAIT_V(0);
    if constexpr (!ALIGN_EPI) { if (wr == 0) PG8_BAR; }
    PG8_BAR;
    if constexpr (Epi::AFTER_DRAIN) { E.fused(acc, cur, wr, wc, fr, fq, lds, wid, lane); S.done(cur); }
#undef PG8_SA
#undef PG8_SB
#undef PG8_STAGE
#undef PG8_LDA
#undef PG8_LDB
#undef PG8_MMA
#undef PG8_WAIT_V
#undef PG8_WAIT_L
#undef PG8_BAR
#undef PG8_SCHED
}
}

#define GAS __attribute__((address_space(1)))
#define LAS __attribute__((address_space(3)))
typedef unsigned short bf16;
typedef unsigned v4u __attribute__((ext_vector_type(4)));
typedef float f32x4 __attribute__((ext_vector_type(4)));
typedef short bf16x8 __attribute__((ext_vector_type(8)));
typedef GAS unsigned gu32;
typedef GAS unsigned long long gu64;
#define RLX_AGENT __ATOMIC_RELAXED, __HIP_MEMORY_SCOPE_AGENT
#define LDS_WAIT() asm volatile("s_waitcnt lgkmcnt(0)" ::: "memory")
#define VM_WAIT() asm volatile("s_waitcnt vmcnt(0)" ::: "memory")
__device__ __forceinline__ unsigned long long rt() { return __builtin_amdgcn_s_memrealtime(); }
__device__ __forceinline__ unsigned f2bf(float f) { unsigned u = __builtin_bit_cast(unsigned, f); return (u + 0x7fffu + ((u >> 16) & 1u)) >> 16; }
__device__ __forceinline__ unsigned pk2(float lo, float hi) { return f2bf(lo) | (f2bf(hi) << 16); }

#define XB_TMO      128
#define XB_XCNT(j)  (256  + 64 * (j))
#define XB_XSUB(j)  (1280 + 64 * (j))
#define XB_XGEN(j)  (2304 + 64 * (j))
#define XB_TOP      3328
#define XB_TOPGEN   3392
#define XCD_BAR_WORDS 3456
#define XB_SPIN_CAP (1u << 18)

__device__ __forceinline__ unsigned xb_ld(unsigned* p)              { return __hip_atomic_load(p, __ATOMIC_RELAXED, __HIP_MEMORY_SCOPE_AGENT); }
__device__ __forceinline__ unsigned xb_add(unsigned* p, unsigned v) { return __hip_atomic_fetch_add(p, v, __ATOMIC_RELAXED, __HIP_MEMORY_SCOPE_AGENT); }
__device__ __forceinline__ unsigned xb_xcc_id() { return (unsigned)__builtin_amdgcn_s_getreg((3 << 11) | 20) & 0xFu; }
#define XB_SPIN(cond, bar) do { unsigned _sp = 0; while (cond) { __builtin_amdgcn_s_sleep(1); \
    if ((++_sp & 255u) == 0u) { if (xb_ld(&(bar)[XB_TMO])) break; if (_sp > XB_SPIN_CAP) { atomicAdd(&(bar)[XB_TMO], 1u); break; } } } } while (0)

struct XcdBarrier {
    unsigned* bar; unsigned x;
    volatile LAS unsigned* st;
};

__device__ __forceinline__ XcdBarrier xcd_barrier_post(unsigned* bar, volatile LAS unsigned* st, const int wave) {
    XcdBarrier b; b.bar = bar; b.x = xb_xcc_id(); b.st = st;
    if (wave == 0 && pg8::lane_id_v() == 0) (void)xb_add(&bar[XB_XCNT(b.x)], 1u);
    return b;
}
__device__ __forceinline__ void xcd_barrier_complete(unsigned* bar, unsigned x, unsigned& nloc, unsigned& nx) {
    const unsigned G = gridDim.x * gridDim.y * gridDim.z;
    unsigned sum, cnt, mine, sp = 0u;
    for (;;) {
        sum = 0u; cnt = 0u; mine = 0u;
#pragma unroll
        for (unsigned j = 0; j < 16; ++j) { const unsigned c = xb_ld(&bar[XB_XCNT(j)]); sum += c; cnt += (c > 0u) ? 1u : 0u; mine = (j == x) ? c : mine; }
        if (sum == G) break;
        __builtin_amdgcn_s_sleep(1);
        if ((++sp & 255u) == 0u) { if (xb_ld(&bar[XB_TMO])) break; if (sp > XB_SPIN_CAP) { atomicAdd(&bar[XB_TMO], 1u); break; } }
    }
    nloc = mine > 0u ? mine : 1u; nx = cnt > 0u ? cnt : 1u;
}

__device__ __forceinline__ void xcd_barrier(const XcdBarrier& b, const int wave) {
    asm volatile("s_waitcnt vmcnt(0)" ::: "memory");
    __syncthreads();
    if (wave == 0 && pg8::lane_id_v() == 0) {
        unsigned* bar = b.bar;
        __builtin_amdgcn_s_waitcnt(0);
        unsigned nloc = b.st[0], nx = b.st[1];
        if (nloc == 0u) { xcd_barrier_complete(bar, b.x, nloc, nx); b.st[0] = nloc; b.st[1] = nx; }
        const unsigned old = xb_add(&bar[XB_XSUB(b.x)], 1u);
        const unsigned gen = old / nloc;
        if (old + 1u == (gen + 1u) * nloc) {
            __builtin_amdgcn_fence(__ATOMIC_RELEASE, "agent");
            asm volatile("s_waitcnt vmcnt(0)" ::: "memory");
            const unsigned og = xb_add(&bar[XB_TOP], 1u);
            const unsigned tg = og / nx;
            if (og + 1u == (tg + 1u) * nx) xb_add(&bar[XB_TOPGEN], 1u);
            else XB_SPIN(xb_ld(&bar[XB_TOPGEN]) == tg, bar);
            __builtin_amdgcn_fence(__ATOMIC_ACQUIRE, "agent");
            xb_add(&bar[XB_XGEN(b.x)], 1u);
            asm volatile("s_waitcnt vmcnt(0)" ::: "memory");
        } else {
            XB_SPIN(xb_ld(&bar[XB_XGEN(b.x)]) == gen, bar);
            __builtin_amdgcn_fence(__ATOMIC_ACQUIRE, "agent");
            asm volatile("s_waitcnt vmcnt(0)" ::: "memory");
        }
    }
    __syncthreads();
}


__device__ __forceinline__ void group_sync(unsigned* cnt, unsigned want, unsigned* tmo, const int wave) {
    asm volatile("s_waitcnt vmcnt(0)" ::: "memory");
    __syncthreads();
    if (wave == 0 && pg8::lane_id_v() == 0) {
        __builtin_amdgcn_fence(__ATOMIC_RELEASE, "agent");
        asm volatile("s_waitcnt vmcnt(0)" ::: "memory");
        (void)xb_add(cnt, 1u);
        unsigned sp = 0u;
        while (xb_ld(cnt) < want) { __builtin_amdgcn_s_sleep(1); if ((++sp & 255u) == 0u) { if (xb_ld(tmo)) break; if (sp > XB_SPIN_CAP) { atomicAdd(tmo, 1u); break; } } }
        __builtin_amdgcn_fence(__ATOMIC_ACQUIRE, "agent");
        asm volatile("s_waitcnt vmcnt(0)" ::: "memory");
    }
    __syncthreads();
}

constexpr int NWAVES = 8;
constexpr int BATCH = 4, SEQ = 4096, D = 1024, M = BATCH * SEQ, NPROJ = 8192, FF = 4096, NMOD = 6 * D;
constexpr int RH = 4, DK = 128, DV = 256, SCH = 256  , NJ = SEQ / SCH  ;
constexpr float EPS = 1e-6f;
constexpr int KS_MOD = 8;
constexpr size_t MiB = 1u << 20;
constexpr size_t WS_CTL = 0, CTL_ZERO_BYTES = 1 * MiB;
constexpr size_t WS_MODP = 1 * MiB;
constexpr size_t WS_MODF = 2 * MiB + 512 * 1024;
constexpr size_t WS_BIAS2 = WS_MODF + 128 * 1024;
constexpr size_t WS_SSQ2 = 3 * MiB, WS_SSQ3 = 4 * MiB;
constexpr size_t WS_WIN = 5 * MiB, WS_WRC = 21 * MiB, WS_WO = 25 * MiB, WS_W1 = 27 * MiB, WS_W2 = 35 * MiB;
constexpr size_t WS_ST = WS_WIN;
constexpr size_t WS_QK = 44 * MiB, WS_V = 76 * MiB, WS_R = 108 * MiB, WS_END = 236 * MiB;
constexpr size_t WS_MERGED = WS_QK, WS_HHAT = WS_V, WS_HID = WS_R;
constexpr size_t OUT_U = 0, OUT_Z = 32 * MiB, OUT_KV = 0;
static_assert(WS_W2 + (size_t)D * FF * 2 <= WS_QK && WS_HID + (size_t)M * FF * 2 <= WS_END, "d_ws map");
constexpr int CW_TMO = 0, CW_BAR = 4096, CW_GRP = 32768;
constexpr int RING_OFF = 0, PHASE_BYTES = 139264, LDSCTL_OFF = PHASE_BYTES, MISC_OFF = LDSCTL_OFF + 320, TAB_OFF = LDSCTL_OFF + 1024, LDS_BYTES = PHASE_BYTES + 4096;

struct Frame {
    LAS unsigned char* lds; volatile LAS unsigned* MISC; gu32* ctl;
    int wave, vcu, G;
    const float *x, *c, *w_ada, *b_ada, *norm1_w, *w_in, *ret_gn_w, *conv_w, *w_ret_out, *w_conv_out, *w_o, *norm2_w, *w_ff1, *w_ff2, *final_norm_w; const int* positions;
    float* out; unsigned char* ws;
};
__device__ __forceinline__ float wave_sum(float v) {
#pragma unroll
    for (int o = 1; o < 64; o <<= 1) v += __shfl_xor(v, o);
    return v;
}
__device__ __forceinline__ unsigned cvtpk2(float lo, float hi) { return pg8::cvtpk(lo, hi); }

__device__ __forceinline__ int vmap_in(int n) {
    if (n < 1024) { const int hb = n & ~127, d = n & 127; const int dd = d & 63; return hb + 8 * (dd >> 2) + (d >= 64 ? 4 : 0) + (dd & 3); }
    if (n >= 4096 && n < 6144) { const int j = (n - 4096) & 1023; return 4096 + 8 * (j >> 2) + (n >= 5120 ? 4 : 0) + (j & 3); }
    return n;
}
struct P0Tile { const float* W; bf16* WT; int N, ldt, kofs, k0, n0, vm; };
__device__ __forceinline__ P0Tile p0_tile(const Frame& F, int t) {
    P0Tile T; int r = t;
    if (r < 512) { T.W = F.w_in; T.WT = (bf16*)(F.ws + WS_WIN); T.N = NPROJ; T.ldt = D; T.kofs = 0; T.vm = 1; T.n0 = 512 * (r >> 5); T.k0 = 32 * (r & 31); return T; } r -= 512;
    if (r < 64) { T.W = F.w_ret_out; T.WT = (bf16*)(F.ws + WS_WRC); T.N = D; T.ldt = 2 * D; T.kofs = 0; T.vm = 0; T.n0 = 512 * (r >> 5); T.k0 = 32 * (r & 31); return T; } r -= 64;
    if (r < 64) { T.W = F.w_conv_out; T.WT = (bf16*)(F.ws + WS_WRC); T.N = D; T.ldt = 2 * D; T.kofs = D; T.vm = 0; T.n0 = 512 * (r >> 5); T.k0 = 32 * (r & 31); return T; } r -= 64;
    if (r < 64) { T.W = F.w_o; T.WT = (bf16*)(F.ws + WS_WO); T.N = D; T.ldt = D; T.kofs = 0; T.vm = 0; T.n0 = 512 * (r >> 5); T.k0 = 32 * (r & 31); return T; } r -= 64;
    if (r < 256) { T.W = F.w_ff1; T.WT = (bf16*)(F.ws + WS_W1); T.N = FF; T.ldt = D; T.kofs = 0; T.vm = 0; T.n0 = 512 * (r >> 5); T.k0 = 32 * (r & 31); return T; } r -= 256;
    T.W = F.w_ff2; T.WT = (bf16*)(F.ws + WS_W2); T.N = D; T.ldt = FF; T.kofs = 0; T.vm = 0; T.n0 = 512 * (r >> 7); T.k0 = 32 * (r & 127); return T;
}
constexpr int P0_NTILES = 512 + 3 * 64 + 256 + 256;
__device__ __forceinline__ void p0_dma(const P0Tile& T, LAS unsigned char* buf, int wave, int lane) {
#pragma unroll
    for (int i = 0; i < 8; ++i) { const int row = 4 * wave + (i >> 1), half = i & 1;
        __builtin_amdgcn_global_load_lds((const unsigned*)(T.W + (size_t)(T.k0 + row) * T.N + T.n0 + half * 256 + lane * 4), (LAS unsigned*)(buf + row * 2048 + half * 1024), 16, 0, 2  ); }
}
__device__ __forceinline__ float siluf_(float x) { return x / (1.0f + __expf(-x)); }
__device__ __forceinline__ void p0_prologue(Frame& F) {
    const int lane_ = pg8::lane_id_v(), tid_ = F.wave * 64 + lane_; (void)tid_;
    const int gw = F.vcu * NWAVES + F.wave, NGW = F.G * NWAVES;
    for (int vb = F.vcu; vb < 32 * KS_MOD; vb += F.G) {
        const int cb = vb & 31, ks = vb >> 5, k0 = ks * (D / KS_MOD) + 16 * F.wave; const int col = 192 * cb + 4 * (lane_ < 48 ? lane_ : 0);
        f32x4 a0 = {0.f, 0.f, 0.f, 0.f}, a1 = a0, a2 = a0, a3 = a0;
        const float* wp = F.w_ada + (size_t)k0 * NMOD + col;
        f32x4 wv[16];
#pragma unroll
        for (int kk = 0; kk < 16; ++kk) wv[kk] = __builtin_nontemporal_load((const GAS f32x4*)(wp + (size_t)kk * NMOD));
#pragma unroll
        for (int kk = 0; kk < 16; ++kk) { const int k = k0 + kk; const float s0 = siluf_(F.c[k]), s1 = siluf_(F.c[D + k]), s2 = siluf_(F.c[2 * D + k]), s3 = siluf_(F.c[3 * D + k]);
            a0 += wv[kk] * s0; a1 += wv[kk] * s1; a2 += wv[kk] * s2; a3 += wv[kk] * s3; }
        LAS f32x4* red = (LAS f32x4*)(F.lds + RING_OFF);
        if (lane_ < 48) { LAS f32x4* rp = red + (F.wave * 4) * 48 + lane_; rp[0] = a0; rp[48] = a1; rp[96] = a2; rp[144] = a3; }
        __syncthreads();
        if (tid_ < 192) { f32x4 sacc = {0.f, 0.f, 0.f, 0.f};
#pragma unroll
            for (int w = 0; w < NWAVES; ++w) sacc += red[w * 192 + tid_];
            *(f32x4*)((float*)(F.ws + WS_MODP) + (size_t)ks * 4 * NMOD + (size_t)(tid_ / 48) * NMOD + 192 * cb + 4 * (tid_ % 48)) = sacc; }
        __syncthreads();
    }
    const int t0 = (int)(((long)F.vcu * P0_NTILES) / F.G), t1 = (int)(((long)(F.vcu + 1) * P0_NTILES) / F.G);
    if (t0 < t1) { const P0Tile T0 = p0_tile(F, t0); p0_dma(T0, F.lds + RING_OFF, F.wave, lane_); }
    for (int t = t0; t < t1; ++t) {
        LAS unsigned char* buf = F.lds + RING_OFF + ((t - t0) & 1) * 65536;
        const P0Tile T = p0_tile(F, t);
        __syncthreads();
        if (t + 1 < t1) { const P0Tile Tn = p0_tile(F, t + 1); p0_dma(Tn, F.lds + RING_OFF + ((t + 1 - t0) & 1) * 65536, F.wave, lane_); }
        float v[32];
#pragma unroll
        for (int k = 0; k < 32; ++k) v[k] = *(const LAS float*)(buf + k * 2048 + tid_ * 4);
        const int n = T.n0 + tid_, vr = T.vm ? vmap_in(n) : n;
        GAS v4u* dst = (GAS v4u*)(T.WT + (size_t)vr * T.ldt + T.kofs + T.k0);
#pragma unroll
        for (int c = 0; c < 4; ++c) { v4u o; o.x = cvtpk2(v[8 * c], v[8 * c + 1]); o.y = cvtpk2(v[8 * c + 2], v[8 * c + 3]); o.z = cvtpk2(v[8 * c + 4], v[8 * c + 5]); o.w = cvtpk2(v[8 * c + 6], v[8 * c + 7]); dst[c] = o; }
    }
    __syncthreads();
}

__device__ __forceinline__ float modp_sum(const float* modp, int idx) { float s = 0.f;
#pragma unroll
    for (int ks = 0; ks < KS_MOD; ++ks) s += modp[(size_t)ks * 4 * NMOD + idx];
    return s; }
__device__ __forceinline__ void p1_unorm(Frame& F) {
    const int lane_ = pg8::lane_id_v(), tid_ = F.wave * 64 + lane_; (void)tid_;
    const float* modp = (const float*)(F.ws + WS_MODP); float* modf = (float*)(F.ws + WS_MODF);
    const int blk = F.vcu;
    const int b = blk >> 6;
    LAS float* cs1 = (LAS float*)(F.lds + RING_OFF); LAS float* sh1 = cs1 + D;
    for (int k = tid_; k < D; k += NWAVES * 64) {
        const float sh = modp_sum(modp, b * NMOD + k) + F.b_ada[k], sc = modp_sum(modp, b * NMOD + D + k) + F.b_ada[D + k];
        cs1[k] = F.norm1_w[k] * (1.0f + sc); sh1[k] = sh; }
    if (tid_ < 96) { const int idx = blk * 96 + tid_; if (idx < 4 * NMOD) modf[idx] = modp_sum(modp, idx) + F.b_ada[idx % NMOD]; }
    __syncthreads();
    bf16* U = (bf16*)((unsigned char*)F.out + OUT_U);
    for (int r0 = 0; r0 < 8; r0 += 4) {
        f32x4 v[4][4]; float ss[4];
#pragma unroll
        for (int q = 0; q < 4; ++q) { const int m = blk * 64 + F.wave * 8 + r0 + q; const GAS f32x4* xr = (const GAS f32x4*)(F.x + (size_t)m * D) + lane_;
#pragma unroll
            for (int j = 0; j < 4; ++j) v[q][j] = __builtin_nontemporal_load(xr + 64 * j); }
#pragma unroll
        for (int q = 0; q < 4; ++q) { float s = 0.f;
#pragma unroll
            for (int j = 0; j < 4; ++j) s += (v[q][j].x * v[q][j].x + v[q][j].y * v[q][j].y) + (v[q][j].z * v[q][j].z + v[q][j].w * v[q][j].w);
            ss[q] = 1.0f / sqrtf(wave_sum(s) * (1.0f / D) + EPS); }
#pragma unroll
        for (int q = 0; q < 4; ++q) { const int m = blk * 64 + F.wave * 8 + r0 + q; GAS unsigned long long* o8 = (GAS unsigned long long*)(U + (size_t)m * D) + lane_;
#pragma unroll
            for (int j = 0; j < 4; ++j) { const int k = 4 * lane_ + 256 * j; const f32x4 a = *(const LAS f32x4*)(cs1 + k), sh = *(const LAS f32x4*)(sh1 + k);
                const f32x4 u = v[q][j] * ss[q] * a + sh;
                o8[64 * j] = (unsigned long long)cvtpk2(u.x, u.y) | ((unsigned long long)cvtpk2(u.z, u.w) << 32); } }
    }
}

typedef short s16x4 __attribute__((ext_vector_type(4)));
typedef float f32x16 __attribute__((ext_vector_type(16)));
#define MFMA32(a, b, c) __builtin_amdgcn_mfma_f32_32x32x16_bf16((a), (b), (c), 0, 0, 0)
__device__ __forceinline__ int crow(int reg, int hh) { return (reg & 3) + 8 * (reg >> 2) + 4 * hh; }
__device__ __forceinline__ bf16x8 tr_frag(LAS unsigned char* p) {
    const s16x4 lo = __builtin_amdgcn_ds_read_tr16_b64_v4i16((LAS s16x4*)p), hi = __builtin_amdgcn_ds_read_tr16_b64_v4i16((LAS s16x4*)(p + 512));
    return __builtin_shufflevector(lo, hi, 0, 1, 2, 3, 4, 5, 6, 7);
}
__device__ __forceinline__ float log2_gamma(int hd) { return log2f(1.0f - exp2f(-5.0f - (float)hd)); }
constexpr int RT_K = 0, RT_V = 8192, RT_BLK = 24576;
__device__ __forceinline__ void p3a_kvsum(Frame& F, int unit) {
    const int lane_ = pg8::lane_id_v(), tid_ = F.wave * 64 + lane_; (void)tid_;
    const int bh = unit >> 4, J = unit & 15, b = bh >> 2, hd = bh & 3;
    const bf16* QK = (const bf16*)(F.ws + WS_QK); const bf16* V = (const bf16*)(F.ws + WS_V);
    float* KV = (float*)((unsigned char*)F.out + OUT_KV) + (size_t)unit * (DV * DK);
    const int tid = tid_, lane = lane_, w = F.wave, r = lane & 31, hh = lane >> 5;
    const float l2g = log2_gamma(hd);
    const size_t mbase = (size_t)b * SEQ + (size_t)J * SCH;
    const int krow_ = tid >> 4, kch = tid & 15;
    const bf16* kp = QK + (mbase + krow_) * 1024 + 512 + hd * DK + kch * 8;
    const bf16* vp0 = V + (mbase + (tid >> 5)) * 1024 + hd * DV + (tid & 31) * 8;
    const int kdst = RT_K + (kch >> 2) * 2048 + krow_ * 64 + (kch & 3) * 16;
    const int vdst0 = RT_V + ((tid & 31) >> 2) * 2048 + (tid >> 5) * 64 + (tid & 3) * 16;
    const int lane_off = (4 * hh + ((lane & 15) >> 2)) * 64 + ((lane >> 4) & 1) * 32 + (lane & 3) * 8;
    f32x16 acc[4];
#pragma unroll
    for (int d = 0; d < 4; ++d)
#pragma unroll
        for (int i = 0; i < 16; ++i) acc[d][i] = 0.f;
    v4u kreg = *(const GAS v4u*)kp, vreg0 = *(const GAS v4u*)vp0, vreg1 = *(const GAS v4u*)(vp0 + 16 * 1024);
    for (int sb = 0; sb < 8; ++sb) {
        __syncthreads();
        { const float dec = __builtin_amdgcn_exp2f((float)(255 - (32 * sb + krow_)) * l2g); v4u o;
#pragma unroll
          for (int j = 0; j < 4; ++j) o[j] = cvtpk2(pg8::bflo(kreg[j]) * dec, pg8::bfhi(kreg[j]) * dec);
          *(LAS v4u*)(F.lds + kdst) = o; *(LAS v4u*)(F.lds + vdst0) = vreg0; *(LAS v4u*)(F.lds + vdst0 + 16 * 64) = vreg1; }
        __syncthreads();
        if (sb < 7) { const size_t o = (size_t)(sb + 1) * 32 * 1024; kreg = *(const GAS v4u*)(kp + o); vreg0 = *(const GAS v4u*)(vp0 + o); vreg1 = *(const GAS v4u*)(vp0 + o + 16 * 1024); }
#pragma unroll
        for (int ks2 = 0; ks2 < 2; ++ks2) {
            const bf16x8 bv = tr_frag(F.lds + RT_V + w * 2048 + ks2 * 1024 + lane_off);
#pragma unroll
            for (int d = 0; d < 4; ++d) { const bf16x8 ak = tr_frag(F.lds + RT_K + d * 2048 + ks2 * 1024 + lane_off); acc[d] = MFMA32(ak, bv, acc[d]); }
        }
    }
#pragma unroll
    for (int d = 0; d < 4; ++d)
#pragma unroll
        for (int g = 0; g < 4; ++g) { f32x4 o = {acc[d][4 * g], acc[d][4 * g + 1], acc[d][4 * g + 2], acc[d][4 * g + 3]};
            *(GAS f32x4*)(KV + (size_t)(32 * w + r) * DK + 32 * d + 8 * g + 4 * hh) = o; }
    __syncthreads();
}
__device__ __forceinline__ void p3a_conv(Frame& F, int blk) {
    const int lane_ = pg8::lane_id_v(), tid_ = F.wave * 64 + lane_; (void)tid_;
    bf16* Rb = (bf16*)(F.ws + WS_R); const bf16* Z = (const bf16*)((unsigned char*)F.out + OUT_Z);
    const int cc = tid_ & 127, rg = tid_ >> 7, m0 = blk * 64 + rg * 16, c0 = cc * 8;
    float w0[8], w1[8], w2[8];
#pragma unroll
    for (int e = 0; e < 8; ++e) { w0[e] = F.conv_w[c0 + e]; w1[e] = F.conv_w[D + c0 + e]; w2[e] = F.conv_w[2 * D + c0 + e]; }
    v4u zm2 = {0u, 0u, 0u, 0u}, zm1 = {0u, 0u, 0u, 0u};
    if ((m0 & (SEQ - 1)) != 0) { zm2 = __builtin_nontemporal_load((const GAS v4u*)(Z + (size_t)(m0 - 2) * 1024 + c0)); zm1 = __builtin_nontemporal_load((const GAS v4u*)(Z + (size_t)(m0 - 1) * 1024 + c0)); }
    bf16* cp0 = Rb + (size_t)(m0 >> 8) * 1048576 + (size_t)(m0 & 255) * 2048 + 1024 + c0;
#pragma unroll
    for (int i0 = 0; i0 < 16; i0 += 8) {
        v4u zz[8], cbv[8];
#pragma unroll
        for (int i = 0; i < 8; ++i) { zz[i] = __builtin_nontemporal_load((const GAS v4u*)(Z + (size_t)(m0 + i0 + i) * 1024 + c0)); cbv[i] = *(const GAS v4u*)(cp0 + (size_t)(i0 + i) * 2048); }
#pragma unroll
        for (int i = 0; i < 8; ++i) { const v4u z0 = zz[i], cb = cbv[i]; v4u o;
#pragma unroll
            for (int j = 0; j < 4; ++j) {
                const float lo = pg8::bflo(cb[j]) * (w0[2 * j] * pg8::bflo(zm2[j]) + w1[2 * j] * pg8::bflo(zm1[j]) + w2[2 * j] * pg8::bflo(z0[j]));
                const float hi = pg8::bfhi(cb[j]) * (w0[2 * j + 1] * pg8::bfhi(zm2[j]) + w1[2 * j + 1] * pg8::bfhi(zm1[j]) + w2[2 * j + 1] * pg8::bfhi(z0[j]));
                o[j] = cvtpk2(lo, hi); }
            *(GAS v4u*)(cp0 + (size_t)(i0 + i) * 2048) = o; zm2 = zm1; zm1 = z0; }
    }
}
__device__ __forceinline__ void p3a_bias2(Frame& F) {
    const int lane_ = pg8::lane_id_v(), tid_ = F.wave * 64 + lane_; (void)tid_;
    const float* modf = (const float*)(F.ws + WS_MODF); const bf16* W1_t = (const bf16*)(F.ws + WS_W1); float* bias2 = (float*)(F.ws + WS_BIAS2);
    const int gw = F.vcu * NWAVES + F.wave, NGW = F.G * NWAVES;
    for (int f = gw; f < FF; f += NGW) { float a[4] = {0.f, 0.f, 0.f, 0.f};
#pragma unroll
        for (int i = 0; i < 2; ++i) { const int k0 = (lane_ + 64 * i) * 8; const v4u wv = *(const GAS v4u*)(W1_t + (size_t)f * D + k0);
#pragma unroll
            for (int bb = 0; bb < 4; ++bb) { const float* sh = modf + bb * NMOD + 3 * D + k0; const f32x4 s0 = *(const f32x4*)sh, s1 = *(const f32x4*)(sh + 4);
                a[bb] += pg8::bflo(wv[0]) * s0[0] + pg8::bfhi(wv[0]) * s0[1] + pg8::bflo(wv[1]) * s0[2] + pg8::bfhi(wv[1]) * s0[3]
                       + pg8::bflo(wv[2]) * s1[0] + pg8::bfhi(wv[2]) * s1[1] + pg8::bflo(wv[3]) * s1[2] + pg8::bfhi(wv[3]) * s1[3]; } }
#pragma unroll
        for (int bb = 0; bb < 4; ++bb) { const float s = wave_sum(a[bb]); if (lane_ == 0) bias2[bb * FF + f] = s; } }
}
__device__ __forceinline__ void p3b_scan(Frame& F, int bh, int j) {
    const int lane_ = pg8::lane_id_v(), tid_ = F.wave * 64 + lane_;
    const float* KV = (const float*)((unsigned char*)F.out + OUT_KV); bf16* ST = (bf16*)(F.ws + WS_ST);
    const int e = j * 2048 + tid_ * 4; const float g = exp2f(256.0f * log2_gamma(bh & 3));
    f32x4 kv[NJ];
#pragma unroll
    for (int J = 0; J < NJ; ++J) kv[J] = *(const GAS f32x4*)(KV + ((size_t)(bh * NJ + J)) * (DV * DK) + e);
    f32x4 S = {0.f, 0.f, 0.f, 0.f};
#pragma unroll
    for (int J = 0; J < NJ; ++J) { *(GAS unsigned long long*)(ST + ((size_t)(bh * NJ + J)) * (DV * DK) + e) = (unsigned long long)cvtpk2(S[0], S[1]) | ((unsigned long long)cvtpk2(S[2], S[3]) << 32);
        S = S * g + kv[J]; }
}
constexpr int RC_ST = 0, RC_STP = 272, RC_BLK0 = 69632, RC_STG = 528;
__device__ __forceinline__ void p3c_retout(Frame& F, int unit, bf16* OUTP, bool dummy_out) {
    const int lane_ = pg8::lane_id_v(), tid_ = F.wave * 64 + lane_; (void)tid_;
    const int bh = unit >> 4, J = unit & 15, b = bh >> 2, hd = bh & 3;
    const bf16* QK = (const bf16*)(F.ws + WS_QK); const bf16* V = (const bf16*)(F.ws + WS_V); const bf16* ST = (const bf16*)(F.ws + WS_ST) + (size_t)unit * (DV * DK);
    const bf16* Rb = (const bf16*)(F.ws + WS_R);
    const int tid = tid_, lane = lane_, w = F.wave, r = lane & 31, hh = lane >> 5;
    const float l2g = log2_gamma(hd);
    const size_t mbase = (size_t)b * SEQ + (size_t)J * SCH;
    const int krow_ = tid >> 4, kch = tid & 15;
    const bf16* kp = QK + (mbase + krow_) * 1024 + 512 + hd * DK + kch * 8;
    const bf16* vp0 = V + (mbase + (tid >> 5)) * 1024 + hd * DV + (tid & 31) * 8;
    const int kdst = RT_K + (kch >> 2) * 2048 + krow_ * 64 + (kch & 3) * 16;
    const int vdst0 = RT_V + ((tid & 31) >> 2) * 2048 + (tid >> 5) * 64 + (tid & 3) * 16;
    const int lane_off = (4 * hh + ((lane & 15) >> 2)) * 64 + ((lane >> 4) & 1) * 32 + (lane & 3) * 8;
    v4u kreg = *(const GAS v4u*)kp, vreg0 = *(const GAS v4u*)vp0, vreg1 = *(const GAS v4u*)(vp0 + 16 * 1024);
#pragma unroll
    for (int i = 0; i < 8; ++i) { const int idx = tid + 512 * i, row = idx >> 4, ch = idx & 15; *(LAS v4u*)(F.lds + RC_ST + row * RC_STP + ch * 16) = *(const GAS v4u*)(ST + (size_t)row * DK + ch * 8); }
    bf16x8 qf[8];
    { const bf16* qp = QK + (mbase + 32 * w + r) * 1024 + hd * DK + 8 * hh;
#pragma unroll
      for (int ks = 0; ks < 8; ++ks) qf[ks] = *(const GAS bf16x8*)(qp + 16 * ks); }
    f32x16 acc[8];
#pragma unroll
    for (int c8 = 0; c8 < 8; ++c8)
#pragma unroll
        for (int i = 0; i < 16; ++i) acc[c8][i] = 0.f;
    __syncthreads();
#pragma unroll
    for (int c8 = 0; c8 < 8; ++c8)
        {
#pragma unroll
          for (int ks = 0; ks < 8; ++ks) { const bf16x8 sf = *(const LAS bf16x8*)(F.lds + RC_ST + (32 * c8 + r) * RC_STP + (16 * ks + 8 * hh) * 2); acc[c8] = MFMA32(qf[ks], sf, acc[c8]); } __builtin_amdgcn_sched_barrier(0); }
    int t1v = 32 * w + 4 * hh + 1; asm volatile("" : "+v"(t1v));
#pragma unroll
    for (int i = 0; i < 16; ++i) { const float sc = __builtin_amdgcn_exp2f((float)(t1v + (i & 3) + 8 * (i >> 2)) * l2g);
#pragma unroll
        for (int c8 = 0; c8 < 8; ++c8) acc[c8][i] *= sc; }
    const int sbmax = w | 1;
    __syncthreads();
    LAS unsigned char* qsl = F.lds + RC_ST + w * 8192 + lane * 16;
#pragma unroll
    for (int ks = 0; ks < 8; ++ks) *(LAS bf16x8*)(qsl + ks * 1024) = qf[ks];
    for (int sb = 0; sb < 8; ++sb) {
        LAS unsigned char* buf = F.lds + RC_BLK0 + (sb & 1) * RT_BLK;
        *(LAS v4u*)(buf + kdst) = kreg; *(LAS v4u*)(buf + vdst0) = vreg0; *(LAS v4u*)(buf + vdst0 + 16 * 64) = vreg1;
        __syncthreads();
        if (sb < 7) { const size_t o = (size_t)(sb + 1) * 32 * 1024; kreg = *(const GAS v4u*)(kp + o); vreg0 = *(const GAS v4u*)(vp0 + o); vreg1 = *(const GAS v4u*)(vp0 + o + 16 * 1024); }
        if (sb <= sbmax) {
            f32x16 X;
#pragma unroll
            for (int i = 0; i < 16; ++i) X[i] = 0.f;
#pragma unroll
            for (int ks = 0; ks < 8; ++ks) { const bf16x8 kf = *(const LAS bf16x8*)(buf + RT_K + (ks >> 1) * 2048 + r * 64 + (ks & 1) * 32 + hh * 16); const bf16x8 qv = *(const LAS bf16x8*)(qsl + ks * 1024); X = MFMA32(kf, qv, X); }
            int tcv = 32 * w + r - 32 * sb - 4 * hh; asm volatile("" : "+v"(tcv));
#pragma unroll
            for (int i = 0; i < 16; ++i) { const int dt = tcv - ((i & 3) + 8 * (i >> 2)); X[i] *= __builtin_amdgcn_exp2f((float)(dt < 0 ? -dt : dt) * l2g); }
            bf16x8 pa[2];
#pragma unroll
            for (int s2 = 0; s2 < 2; ++s2) { v4u p; p[0] = cvtpk2(X[8 * s2], X[8 * s2 + 1]); p[1] = cvtpk2(X[8 * s2 + 2], X[8 * s2 + 3]); p[2] = cvtpk2(X[8 * s2 + 4], X[8 * s2 + 5]); p[3] = cvtpk2(X[8 * s2 + 6], X[8 * s2 + 7]);
                pa[s2] = __builtin_bit_cast(bf16x8, p); }
#pragma unroll
            for (int c8 = 0; c8 < 8; ++c8)
                {
#pragma unroll
                  for (int s2 = 0; s2 < 2; ++s2) { const bf16x8 bv = tr_frag(buf + RT_V + c8 * 2048 + s2 * 1024 + lane_off); acc[c8] = MFMA32(pa[s2], bv, acc[c8]); } if (c8 & 1) __builtin_amdgcn_sched_barrier(0); }
        }
    }
    __syncthreads();
    LAS unsigned char* stg = F.lds + w * (32 * RC_STG);
    LAS unsigned char* stgl = stg + 4 * hh * RC_STG + 2 * r;
#pragma unroll
    for (int i = 0; i < 16; ++i) {
        float s = 0.f;
#pragma unroll
        for (int c8 = 0; c8 < 8; ++c8) s += acc[c8][i];
        s += __shfl_xor(s, 1); s += __shfl_xor(s, 2); s += __shfl_xor(s, 4); s += __shfl_xor(s, 8); s += __shfl_xor(s, 16);
        const float mu = s * (1.0f / DV); float q = 0.f;
#pragma unroll
        for (int c8 = 0; c8 < 8; ++c8) { const float d = acc[c8][i] - mu; q += d * d; }
        q += __shfl_xor(q, 1); q += __shfl_xor(q, 2); q += __shfl_xor(q, 4); q += __shfl_xor(q, 8); q += __shfl_xor(q, 16);
        const float rs = 1.0f / sqrtf(q * (1.0f / DV) + EPS);
        LAS unsigned short* srow = (LAS unsigned short*)(stgl + ((i & 3) + 8 * (i >> 2)) * RC_STG);
#pragma unroll
        for (int c8 = 0; c8 < 8; ++c8) srow[32 * c8] = (unsigned short)(cvtpk2((acc[c8][i] - mu) * rs, 0.f) & 0xffffu);
    }
    LDS_WAIT(); asm volatile("" ::: "memory");
#pragma unroll 4
    for (int i = 0; i < 16; ++i) { const int idx = lane + 64 * i, row = idx >> 5, ch = idx & 31;
        const v4u y = *(const LAS v4u*)(stg + row * RC_STG + ch * 16);
        const size_t mrow = mbase + 32 * w + row; const bf16* ogp = Rb + (mrow >> 8) * 1048576 + (mrow & 255) * 2048 + hd * DV + ch * 8; const v4u og = *(const GAS v4u*)ogp; bf16* op = OUTP + (dummy_out ? mrow * 1024 : (mrow >> 8) * 1048576 + (mrow & 255) * 2048) + hd * DV + ch * 8;
        const float* gw = F.ret_gn_w + hd * DV + ch * 8; const f32x4 g0 = *(const f32x4*)gw, g1 = *(const f32x4*)(gw + 4); v4u o;
        o[0] = cvtpk2(pg8::bflo(y[0]) * g0[0] * pg8::bflo(og[0]), pg8::bfhi(y[0]) * g0[1] * pg8::bfhi(og[0]));
        o[1] = cvtpk2(pg8::bflo(y[1]) * g0[2] * pg8::bflo(og[1]), pg8::bfhi(y[1]) * g0[3] * pg8::bfhi(og[1]));
        o[2] = cvtpk2(pg8::bflo(y[2]) * g1[0] * pg8::bflo(og[2]), pg8::bfhi(y[2]) * g1[1] * pg8::bfhi(og[2]));
        o[3] = cvtpk2(pg8::bflo(y[3]) * g1[2] * pg8::bflo(og[3]), pg8::bfhi(y[3]) * g1[3] * pg8::bfhi(og[3]));
        *(GAS v4u*)op = o; }
    __syncthreads();
}
__device__ __forceinline__ void p8_final(Frame& F, float* outp) {
    const int lane_ = pg8::lane_id_v(), tid_ = F.wave * 64 + lane_; (void)tid_;
    const float* ssq = (const float*)(F.ws + WS_SSQ3);
    const int gw = F.vcu * NWAVES + F.wave, NGW = F.G * NWAVES;
    f32x4 wv[4];
#pragma unroll
    for (int j = 0; j < 4; ++j) wv[j] = *(const f32x4*)(F.final_norm_w + 4 * lane_ + 256 * j);
    for (int m = gw; m < M; m += NGW) {
        float s = (lane_ < 16) ? ssq[(size_t)m * 16 + lane_] : 0.f; s = wave_sum(s);
        const float rstd = 1.0f / sqrtf(s * (1.0f / D) + EPS);
        const GAS f32x4* xr = (const GAS f32x4*)(F.out + (size_t)m * D) + lane_; GAS f32x4* xo = (GAS f32x4*)(outp + (size_t)m * D) + lane_;
#pragma unroll
        for (int j = 0; j < 4; ++j) { const f32x4 v = xr[64 * j]; xo[64 * j] = v * rstd * wv[j]; }
    }
}

namespace pg8 {
struct EpiRes2Norm {
    static constexpr int EPI_ID = 6;
    static constexpr bool PERM = true, AFTER_DRAIN = true, HAS_MID = false;
    const float* h1; float* out; const float* modf; const float* wf; float* ssq; unsigned* cnt; unsigned* tmo;
    __device__ __forceinline__ void mid(f32x4 (&)[2][2][4][2], const Unit&, int, int, int, int) const {}
    __device__ __forceinline__ void fused(f32x4 (&acc)[2][2][4][2], const Unit& u, int wr, int wc, int fr_, int fq_, PG8_LAS unsigned char* lds, int wid, int lane) const {
        int fr = fr_, fq = fq_; asm volatile("" : "+v"(fr), "+v"(fq));
        const int rl0 = wr * 64 + fr, row0 = u.pm * BM + rl0, col0 = u.pn * BM + wc * 32 + 8 * fq, b = u.pm >> 4;
        PG8_LAS float* P = (PG8_LAS float*)lds;
        { f32x4 g2[2][2];
#pragma unroll
          for (int bj = 0; bj < 2; ++bj)
#pragma unroll
            for (int n = 0; n < 2; ++n) g2[bj][n] = *(const f32x4*)(modf + b * 6144 + 5120 + col0 + bj * HALF + 4 * n);
#pragma unroll
          for (int ai = 0; ai < 2; ++ai)
#pragma unroll
            for (int m = 0; m < 4; ++m) { const size_t off = (size_t)(row0 + ai * HALF + m * 16) * 1024 + col0; float q = 0.f;
#pragma unroll
                for (int bj = 0; bj < 2; ++bj) { const f32x4 x0 = *(const f32x4*)(h1 + off + bj * HALF), x1 = *(const f32x4*)(h1 + off + bj * HALF + 4);
                    const f32x4 h0 = x0 + g2[bj][0] * acc[ai][bj][m][0], hb = x1 + g2[bj][1] * acc[ai][bj][m][1];
                    acc[ai][bj][m][0] = h0; acc[ai][bj][m][1] = hb;
                    q += (h0[0] * h0[0] + h0[1] * h0[1]) + (h0[2] * h0[2] + h0[3] * h0[3]) + (hb[0] * hb[0] + hb[1] * hb[1]) + (hb[2] * hb[2] + hb[3] * hb[3]); }
                q += __shfl_xor(q, 16); q += __shfl_xor(q, 32);
                if (fq == 0) P[(rl0 + ai * HALF + m * 16) * 4 + wc] = q; } }
        asm volatile("s_waitcnt lgkmcnt(0)" ::: "memory"); __builtin_amdgcn_s_barrier(); asm volatile("" ::: "memory");
        { const int t = wid * 64 + lane; if (t < 256) { const f32x4 p = *(const PG8_LAS f32x4*)(P + t * 4); ssq[(size_t)(u.pm * BM + t) * 4 + u.pn] = (p[0] + p[1]) + (p[2] + p[3]); } }
        group_sync(cnt, 4u, tmo, wid);
        f32x4 wv[2][2];
#pragma unroll
        for (int bj = 0; bj < 2; ++bj)
#pragma unroll
            for (int n = 0; n < 2; ++n) wv[bj][n] = *(const f32x4*)(wf + col0 + bj * HALF + 4 * n);
#pragma unroll
        for (int ai = 0; ai < 2; ++ai)
#pragma unroll
            for (int m = 0; m < 4; ++m) { const int row = row0 + ai * HALF + m * 16; const f32x4 p = *(const f32x4*)(ssq + (size_t)row * 4);
                const float rs = 1.0f / sqrtf(((p[0] + p[1]) + (p[2] + p[3])) * (1.0f / 1024.0f) + 1e-6f); const size_t off = (size_t)row * 1024 + col0;
#pragma unroll
                for (int bj = 0; bj < 2; ++bj) { *(f32x4*)(out + off + bj * HALF) = acc[ai][bj][m][0] * rs * wv[bj][0]; *(f32x4*)(out + off + bj * HALF + 4) = acc[ai][bj][m][1] * rs * wv[bj][1]; } }
    }
};
}

#ifndef FF1_ALIGN
#define FF1_ALIGN true
#endif
#ifndef G1_ALIGN
#define G1_ALIGN true
#endif
#ifndef G1_SP2
#define G1_SP2 true
#endif
constexpr int N_PHASES = 10;
struct Args { const void* in[16]; float* out; unsigned char* ws; int ph_lo, ph_hi, use_bar, pad; };
__global__ void __launch_bounds__(NWAVES * 64, 2) hyb_fwd(Args args) {
    extern __shared__ __attribute__((aligned(16))) unsigned char lds[];
    Frame F;
    F.lds = (LAS unsigned char*)lds; F.MISC = (volatile LAS unsigned*)(F.lds + MISC_OFF);
    F.wave = __builtin_amdgcn_readfirstlane((int)threadIdx.x >> 6);
    F.G = gridDim.x; { const int bx = blockIdx.x; F.vcu = (F.G % 8 == 0) ? (bx % 8) * (F.G / 8) + bx / 8 : bx; }
    F.ws = args.ws; F.out = args.out; F.ctl = (gu32*)(args.ws + WS_CTL);
    F.x = (const float*)args.in[0]; F.c = (const float*)args.in[1]; F.positions = (const int*)args.in[2]; F.w_ada = (const float*)args.in[3]; F.b_ada = (const float*)args.in[4];
    F.norm1_w = (const float*)args.in[5]; F.w_in = (const float*)args.in[6]; F.ret_gn_w = (const float*)args.in[7]; F.conv_w = (const float*)args.in[8]; F.w_ret_out = (const float*)args.in[9];
    F.w_conv_out = (const float*)args.in[10]; F.w_o = (const float*)args.in[11]; F.norm2_w = (const float*)args.in[12]; F.w_ff1 = (const float*)args.in[13]; F.w_ff2 = (const float*)args.in[14];
    F.final_norm_w = (const float*)args.in[15];
    for (int u = F.wave * 64 + pg8::lane_id_v(); u < (LDS_BYTES - LDSCTL_OFF) / 4; u += NWAVES * 64) ((LAS unsigned*)(F.lds + LDSCTL_OFF))[u] = 0u;
    __syncthreads();
    XcdBarrier bar; bar.bar = (unsigned*)(F.ctl + CW_BAR); bar.x = 0; bar.st = nullptr;
    if (args.use_bar) bar = xcd_barrier_post((unsigned*)(F.ctl + CW_BAR), F.MISC + 8, F.wave);
    const int lo = args.ph_lo, hi = args.ph_hi;
#ifndef PH_MASK
#define PH_MASK 0x7ff
#endif
#define IN(k) (((PH_MASK >> (k)) & 1) && lo <= (k) && (k) < hi)
#ifndef PH_TWICE
#define PH_TWICE 0
#endif
#define REP(k) for (int rep_ = 0; rep_ < (((PH_TWICE >> (k)) & 1) ? 2 : 1); ++rep_)
#ifdef PH_TA
    unsigned long long ta_ = __builtin_amdgcn_s_memrealtime(), tb_ = ta_;
#define STAMP(id) do { if ((id) == PH_TA) ta_ = __builtin_amdgcn_s_memrealtime(); if ((id) == PH_TB) tb_ = __builtin_amdgcn_s_memrealtime(); } while (0)
#else
#define STAMP(id) do { } while (0)
#endif
#define GSYNC(stage) group_sync((unsigned*)(F.ctl + CW_GRP + ((stage) * 64 + gpm_) * 64), 4u, (unsigned*)(F.ctl + CW_BAR + XB_TMO), F.wave)
#define SEAM(k) do { STAMP(2 * (k)); if (IN(k) && IN((k) + 1)) xcd_barrier(bar, F.wave); STAMP(2 * (k) + 1); } while (0)
    unsigned char* ws = args.ws;
    bf16* U = (bf16*)((unsigned char*)args.out + OUT_U);

#ifdef PH_MAXP0
    const unsigned long long tk0_ = __builtin_amdgcn_s_memrealtime();
    if (IN(0)) { p0_prologue(F); }
    if (F.wave == 0 && pg8::lane_id_v() == 0) __hip_atomic_store((unsigned*)(F.ctl + 16384 + blockIdx.x), (unsigned)(__builtin_amdgcn_s_memrealtime() - tk0_), __ATOMIC_RELAXED, __HIP_MEMORY_SCOPE_AGENT);
    SEAM(0);
    unsigned mx_ = 0, amx_ = 0;
    if (blockIdx.x == 0 && F.wave == 0) { for (int i = 0; i < (int)gridDim.x; ++i) { const unsigned v = __hip_atomic_load((unsigned*)(F.ctl + 16384 + i), __ATOMIC_RELAXED, __HIP_MEMORY_SCOPE_AGENT); if (v > mx_) { mx_ = v; amx_ = i; } } }
#else
    if (IN(0)) REP(0) { p0_prologue(F); } SEAM(0);
#endif
    if (IN(1)) REP(1) { p1_unorm(F); } SEAM(1);
    if (IN(2)) REP(2) {
        pg8::Gemm g{U, (const bf16*)(ws + WS_WIN), M, NPROJ, D, (size_t)256 * D * 2}; pg8::StaticOrder S; S.init(M, NPROJ, F.G, (int)blockIdx.x);
        pg8::EpiProj E{(bf16*)(ws + WS_QK), (bf16*)(ws + WS_V), (bf16*)(ws + WS_R), (bf16*)((unsigned char*)args.out + OUT_Z), F.positions};
        pg8::gemm_phase<pg8::EpiProj, pg8::StaticOrder, G1_ALIGN, G1_SP2>(F.lds + RING_OFF, g, S, E, F.wave);
    } SEAM(2);
    if (IN(3)) {
        const int bh_ = F.vcu >> 4; unsigned* tmo_ = (unsigned*)(F.ctl + CW_BAR + XB_TMO);
        REP(3) { p3a_kvsum(F, F.vcu); }
        p3a_conv(F, F.vcu); REP(11) { p3a_bias2(F); }
        STAMP(6); group_sync((unsigned*)(F.ctl + CW_GRP + (4 * 64 + bh_) * 64), 16u, tmo_, F.wave); STAMP(7);
        p3b_scan(F, bh_, F.vcu & 15);
        STAMP(8); group_sync((unsigned*)(F.ctl + CW_GRP + (5 * 64 + bh_) * 64), 16u, tmo_, F.wave); STAMP(9);
        REP(5) { const bool dummy = ((PH_TWICE >> 5) & 1) && rep_ == 0; p3c_retout(F, F.vcu, dummy ? (bf16*)((unsigned char*)args.out + OUT_Z) : (bf16*)(ws + WS_R), dummy); }
    } if (IN(3) && IN(6)) { STAMP(10); xcd_barrier(bar, F.wave); STAMP(11); }
    int gpm_ = 0; { pg8::StaticOrder S; S.init(M, D, F.G, (int)blockIdx.x); pg8::Unit u0; if (S.next(0, u0)) gpm_ = u0.pm; }
#ifdef PH_STAG
    if (IN(6)) { const unsigned long long t0s_ = __builtin_amdgcn_s_memrealtime(), ds_ = (unsigned long long)((gpm_ % PH_STAG_S) * PH_STAG); while (__builtin_amdgcn_s_memrealtime() - t0s_ < ds_) __builtin_amdgcn_s_sleep(4); }
#endif
    if (IN(6)) REP(6) {
        pg8::Gemm g{(const bf16*)(ws + WS_R), (const bf16*)(ws + WS_WRC), M, D, 2 * D, (size_t)2 * MiB}; pg8::StaticOrder S; S.init(M, D, F.G, (int)blockIdx.x);
        pg8::EpiMerge E{(const bf16*)(ws + WS_R), (bf16*)(ws + WS_MERGED)};
        pg8::gemm_phase<pg8::EpiMerge, pg8::StaticOrder, false, true>(F.lds + RING_OFF, g, S, E, F.wave);
    } if (IN(6) && IN(7)) { STAMP(12); GSYNC(0); STAMP(13); }
    if (IN(7)) REP(7) {
        pg8::Gemm g{(const bf16*)(ws + WS_MERGED), (const bf16*)(ws + WS_WO), M, D, D, (size_t)256 * D * 2}; pg8::StaticOrder S; S.init(M, D, F.G, (int)blockIdx.x);
        pg8::EpiRes1 E{F.x, args.out, (bf16*)(ws + WS_HHAT), (const float*)(ws + WS_MODF), F.norm2_w, (float*)(ws + WS_SSQ2)};
        pg8::gemm_phase<pg8::EpiRes1, pg8::StaticOrder, false, true>(F.lds + RING_OFF, g, S, E, F.wave);
    } if (IN(7) && IN(8)) { STAMP(14); GSYNC(1); STAMP(15); }
    if (IN(8)) REP(8) {
        pg8::Gemm g{(const bf16*)(ws + WS_HHAT), (const bf16*)(ws + WS_W1), M, FF, D, (size_t)256 * D * 2}; pg8::StaticOrder S; S.init(M, FF, F.G, (int)blockIdx.x);
        pg8::Unit u0; LAS float* tab = (LAS float*)(F.lds + TAB_OFF); const int tid_ = F.wave * 64 + pg8::lane_id_v();
        if (S.next(0, u0)) { if (tid_ < 256) { const float* sq = (const float*)(ws + WS_SSQ2) + (size_t)(u0.pm * 256 + tid_) * 16; const f32x4 a = *(const f32x4*)sq, b = *(const f32x4*)(sq + 4), c = *(const f32x4*)(sq + 8), d = *(const f32x4*)(sq + 12);
            const float s = ((a[0] + a[1]) + (a[2] + a[3])) + ((b[0] + b[1]) + (b[2] + b[3])) + ((c[0] + c[1]) + (c[2] + c[3])) + ((d[0] + d[1]) + (d[2] + d[3]));
            tab[tid_] = 1.0f / sqrtf(s * (1.0f / D) + EPS); } }
        __syncthreads();
        pg8::EpiFF1 E{(const float*)(ws + WS_BIAS2), (const LAS float*)tab, (bf16*)(ws + WS_HID)};
        pg8::gemm_phase<pg8::EpiFF1, pg8::StaticOrder, FF1_ALIGN, true>(F.lds + RING_OFF, g, S, E, F.wave);
    } if (IN(8) && IN(9)) { STAMP(16); GSYNC(2); STAMP(17); }
    if (IN(9)) {
        pg8::Gemm g{(const bf16*)(ws + WS_HID), (const bf16*)(ws + WS_W2), M, D, FF, (size_t)256 * FF * 2}; pg8::StaticOrder S; S.init(M, D, F.G, (int)blockIdx.x);
        pg8::EpiRes2Norm E{args.out, args.out, (const float*)(ws + WS_MODF), F.final_norm_w, (float*)(ws + WS_SSQ3), (unsigned*)(F.ctl + CW_GRP + (3 * 64 + gpm_) * 64), (unsigned*)(F.ctl + CW_BAR + XB_TMO)};
        pg8::gemm_phase<pg8::EpiRes2Norm, pg8::StaticOrder, false, true>(F.lds + RING_OFF, g, S, E, F.wave);
    }
    STAMP(18); STAMP(19);
#ifdef PH_MAXP0
    if (blockIdx.x == 0 && F.wave == 0) { const unsigned long long te = __builtin_amdgcn_s_memrealtime(), d = (PH_MAXP0 == 1) ? (unsigned long long)mx_ * 4ull : (unsigned long long)amx_ * 100ull; while (__builtin_amdgcn_s_memrealtime() - te < d) __builtin_amdgcn_s_sleep(8); }
#endif
#ifdef PH_TA
    STAMP(20); STAMP(21);
    if ((int)blockIdx.x == PH_BLK && F.wave == 0) { const unsigned long long te = __builtin_amdgcn_s_memrealtime(), d = (tb_ - ta_) * 4ull; while (__builtin_amdgcn_s_memrealtime() - te < d) __builtin_amdgcn_s_sleep(8); }
#endif
#undef IN
#undef SEAM
}

#ifndef HYB_N_LAUNCHES
#define HYB_N_LAUNCHES 1
#endif
extern "C" void kernel_launch(void* const* d_in, const int* in_sizes, int n_in, void* d_out, int out_size, void* d_ws, size_t ws_size, hipStream_t stream) {
    static int grid = 0;
    if (grid == 0) {
        if (n_in != 16 || in_sizes[0] != M * D || out_size != M * D || ws_size < WS_END) { fprintf(stderr, "kernel_launch: unexpected shapes (n_in %d, in0 %d, out %d, ws %zu); nothing launched\n", n_in, n_in > 0 ? in_sizes[0] : -1, out_size, ws_size); grid = -1; return; }
        int dev = 0, cus = 0, per_cu = 0;
        if (hipGetDevice(&dev) != hipSuccess || hipDeviceGetAttribute(&cus, hipDeviceAttributeMultiprocessorCount, dev) != hipSuccess) { grid = -1; return; }
        if (hipFuncSetAttribute((const void*)hyb_fwd, hipFuncAttributeMaxDynamicSharedMemorySize, LDS_BYTES) != hipSuccess) { fprintf(stderr, "kernel_launch: hipFuncSetAttribute failed\n"); grid = -1; return; }
        if (hipOccupancyMaxActiveBlocksPerMultiprocessor(&per_cu, (const void*)hyb_fwd, NWAVES * 64, LDS_BYTES) != hipSuccess || per_cu < 1) { fprintf(stderr, "kernel_launch: occupancy query says %d workgroups per CU; nothing launched\n", per_cu); (void)hipGetLastError(); grid = -1; return; }
        { bool okp = true; pg8::StaticOrder S; for (int c = 0; c < cus && okp; ++c) { S.init(M, FF, cus, c); pg8::Unit u0, u; if (!S.next(0, u0)) continue; for (int i = 1; S.next(i, u); ++i) okp = okp && (u.pm == u0.pm); }
          if (!okp) { fprintf(stderr, "kernel_launch: FF1's unit order does not keep a workgroup inside one row panel on %d CUs; nothing launched\n", cus); grid = -1; return; } }
        { bool okp = true; pg8::StaticOrder S1, S4; for (int c = 0; c < cus && okp; ++c) { S1.init(M, D, cus, c); S4.init(M, FF, cus, c); pg8::Unit a, b2; okp = S1.next(0, a) && S4.next(0, b2) && a.pm == b2.pm && !S1.next(1, b2); }
          if (!okp || cus != 256) { fprintf(stderr, "kernel_launch: the row-panel chain needs 256 CUs with one N=1024 unit each in the panel of their FF1 units; nothing launched\n"); grid = -1; return; } }
        grid = cus;
        if (grid != 256) fprintf(stderr, "kernel_launch: %d CUs (built for 256)\n", grid);
    }
    if (grid < 0) return;
    (void)hipMemsetAsync((char*)d_ws + WS_CTL, 0, CTL_ZERO_BYTES, stream);
    Args a{};
    for (int i = 0; i < 16; ++i) a.in[i] = d_in[i];
    a.out = (float*)d_out; a.ws = (unsigned char*)d_ws;
#if HYB_N_LAUNCHES == 1
    a.ph_lo = 0; a.ph_hi = N_PHASES; a.use_bar = 1;
    hipLaunchKernelGGL(hyb_fwd, dim3(grid), dim3(NWAVES * 64), LDS_BYTES, stream, a);
#ifdef PH_WHOLE2
    (void)hipMemsetAsync((char*)d_ws + WS_CTL, 0, CTL_ZERO_BYTES, stream);
    hipLaunchKernelGGL(hyb_fwd, dim3(grid), dim3(NWAVES * 64), LDS_BYTES, stream, a);
#endif
#else
    for (int p = 0; p < N_PHASES; ++p) { a.ph_lo = p; a.ph_hi = p + 1; a.use_bar = 0; hipLaunchKernelGGL(hyb_fwd, dim3(grid), dim3(NWAVES * 64), LDS_BYTES, stream, a); }
#endif
}
```

```cpp
#include <hip/hip_runtime.h>
#include <cstdio>
#include <cstdint>
namespace pg8 {
#define PG8_LAS __attribute__((address_space(3)))
typedef unsigned short bf16_t;
typedef short bf16x8 __attribute__((ext_vector_type(8)));
typedef float f32x4 __attribute__((ext_vector_type(4)));
typedef unsigned u32x4 __attribute__((ext_vector_type(4)));
constexpr int BM = 256, BK = 64, HALF = 128, HTB = HALF * BK * 2  , STAGE_BYTES = 8 * HTB, NXCD = 8, WGM = 8;

__host__ __device__ __forceinline__ int lds_byte(int r, int c) { const int st = (r >> 4) * 2 + (c >> 5), rr = r & 15, cc = c & 31, ob = rr * 64 + cc * 2; return st * 1024 + (ob ^ (((ob >> 9) & 1) << 5)); }
__host__ __device__ __forceinline__ void stage_rc(int b, int& R, int& C) { const int st = b / 1024, sb = b % 1024, swz = sb ^ (((sb >> 9) & 1) << 5); R = (st >> 1) * 16 + swz / 64; C = (st & 1) * 32 + (swz % 64) / 2; }
__host__ __device__ __forceinline__ int perm32(int rho) { const int n = rho >> 4, i = rho & 15; return 8 * (i >> 2) + 4 * n + (i & 3); }

struct Unit { int pm, pn; };
struct Gemm { const bf16_t* A; const bf16_t* Bt; int M, N, K; size_t a_pstride; };

struct StaticOrder {
    int nM, nN, nwg, G, c;
    __host__ __device__ void init(int M, int N, int G_, int c_) { nM = M / BM; nN = N / BM; nwg = nM * nN; G = G_; c = c_; }
    __host__ __device__ bool next(int i, Unit& u) const {
        const long L = (long)i * G + c; if (L >= nwg) return false;
        int wgid = (int)L; { const int q = nwg / NXCD, r = nwg % NXCD, xcd = wgid % NXCD, off = wgid / NXCD; wgid = (xcd < r ? xcd * (q + 1) : r * (q + 1) + (xcd - r) * q) + off; }
        const int nig = WGM * nN, gid = wgid / nig, fm = gid * WGM, gsz = (nM - fm) < WGM ? (nM - fm) : WGM;
        u.pm = fm + ((wgid % nig) % gsz); u.pn = (wgid % nig) / gsz; return true;
    }
    __device__ __forceinline__ void a_ready(const Unit&) const {}
    __device__ __forceinline__ void done(const Unit&) const {}
};

__device__ __forceinline__ unsigned cvt_pk_bf16(float lo, float hi) { unsigned r; asm volatile("v_cvt_pk_bf16_f32 %0, %1, %2" : "=v"(r) : "v"(lo), "v"(hi)); return r; }
typedef float f32x2 __attribute__((ext_vector_type(2)));
__device__ __forceinline__ int lane_id_v() { int l; asm volatile("v_mbcnt_lo_u32_b32 %0, -1, 0\n\tv_mbcnt_hi_u32_b32 %0, -1, %0" : "=v"(l)); return l; }
typedef unsigned u32x2 __attribute__((ext_vector_type(2)));
__device__ __forceinline__ unsigned cvtpk(float lo, float hi) { typedef float f2_t __attribute__((ext_vector_type(2))); typedef __bf16 b2_t __attribute__((ext_vector_type(2))); f2_t v = {lo, hi}; b2_t b = __builtin_convertvector(v, b2_t); return __builtin_bit_cast(unsigned, b); }
__device__ __forceinline__ float bflo(unsigned w) { return __builtin_bit_cast(float, w << 16); }
__device__ __forceinline__ float bfhi(unsigned w) { return __builtin_bit_cast(float, w & 0xffff0000u); }
__device__ __forceinline__ float fast_rcp(float x) { return __builtin_amdgcn_rcpf(x); }
__device__ __forceinline__ float sigmoidf_(float x) { return fast_rcp(1.0f + __expf(-x)); }
__device__ __forceinline__ void sincos_rev(float ang, float& s, float& c) {
    const float I2P = 0.15915493667125702f, I2P_LO = 6.420638326565253e-09f;
    const float r = ang * I2P; float e = __builtin_fmaf(ang, I2P, -r); e = __builtin_fmaf(ang, I2P_LO, e);
    const float k = __builtin_rintf(r); const float f = (r - k) + e;
    s = __builtin_amdgcn_sinf(f); c = __builtin_amdgcn_cosf(f);
}
__device__ __forceinline__ u32x4 pack8(const f32x4 a, const f32x4 b) { u32x4 w; w.x = cvtpk(a[0], a[1]); w.y = cvtpk(a[2], a[3]); w.z = cvtpk(b[0], b[1]); w.w = cvtpk(b[2], b[3]); return w; }

struct EpiProj {
    static constexpr int EPI_ID = 1;
    static constexpr bool PERM = true, AFTER_DRAIN = false, HAS_MID = false;
    bf16_t* QK; bf16_t* V; bf16_t* R; bf16_t* Z; const int* pos;
    __device__ __forceinline__ void mid(f32x4 (&)[2][2][4][2], const Unit&, int, int, int, int) const {}
    __device__ __forceinline__ void operator()(const f32x4 (&acc)[2][2][4][2], const Unit& u, int wr, int wc, int fr, int fq) const {
        const int row0 = u.pm * BM + wr * 64 + fr, cw = wc * 32 + 8 * fq, pn = u.pn;
        if (pn < 4) {
            const float ksc = pn >= 2 ? 0.08838834764831845f : 1.0f;
            const int g = 4 * wc + fq; float invf[4];
#pragma unroll
            for (int i = 0; i < 4; ++i) invf[i] = exp2f(-(float)(4 * g + i) * (13.287712379549449f / 64.0f));
#pragma unroll
            for (int ai = 0; ai < 2; ++ai)
#pragma unroll
                for (int m = 0; m < 4; ++m) { const int row = row0 + ai * HALF + m * 16; const float p = (float)pos[row];
                    f32x4 cs, sn;
#pragma unroll
                    for (int i = 0; i < 4; ++i) { float s_, c_; sincos_rev(p * invf[i], s_, c_); cs[i] = c_ * ksc; sn[i] = s_ * ksc; }
                    bf16_t* rowp = QK + (size_t)row * 1024 + pn * 256 + cw;
#pragma unroll
                    for (int bj = 0; bj < 2; ++bj) { const f32x4 x1 = acc[ai][bj][m][0], x2 = acc[ai][bj][m][1];
                        const f32x4 o1 = x1 * cs - x2 * sn, o2 = x1 * sn + x2 * cs;
                        *(u32x4*)(rowp + bj * HALF) = pack8(o1, o2); } }
        } else if (pn >= 16 && pn < 24) {
#pragma unroll
            for (int ai = 0; ai < 2; ++ai)
#pragma unroll
                for (int m = 0; m < 4; ++m) { const int row = row0 + ai * HALF + m * 16; bf16_t* rowp = Z + (size_t)row * 1024 + (((pn - 16) * 256 + cw) >> 1);
#pragma unroll
                    for (int bj = 0; bj < 2; ++bj) { const f32x4 z = acc[ai][bj][m][0] * acc[ai][bj][m][1]; u32x2 w; w.x = cvtpk(z[0], z[1]); w.y = cvtpk(z[2], z[3]);
                        *(u32x2*)(rowp + bj * (HALF / 2)) = w; } }
        } else {
            bf16_t* base; int ld, mode;
            if (pn < 8) { base = V + (size_t)u.pm * BM * 1024 + (pn - 4) * 256; ld = 1024; mode = 0; }
            else if (pn < 12) { base = R + (size_t)u.pm * 1048576 + (pn - 8) * 256; ld = 2048; mode = 1; }
            else if (pn < 16) { base = R + (size_t)u.pm * 1048576 + 1024 + (pn - 12) * 256; ld = 2048; mode = 0; }
            else { base = R + (size_t)u.pm * 1048576 + 524288 + (pn - 24) * 256; ld = 2048; mode = 2; }
            const int rl0 = wr * 64 + fr;
#pragma unroll
            for (int ai = 0; ai < 2; ++ai)
#pragma unroll
                for (int m = 0; m < 4; ++m) { const int rl = rl0 + ai * HALF + m * 16; bf16_t* rowp = base + (size_t)rl * ld + cw;
#pragma unroll
                    for (int bj = 0; bj < 2; ++bj) { f32x4 v0 = acc[ai][bj][m][0], v1 = acc[ai][bj][m][1];
                        if (mode != 0) {
#pragma unroll
                            for (int i = 0; i < 4; ++i) { const float s0 = sigmoidf_(v0[i]), s1 = sigmoidf_(v1[i]); v0[i] = mode == 1 ? v0[i] * s0 : s0; v1[i] = mode == 1 ? v1[i] * s1 : s1; } }
                        *(u32x4*)(rowp + bj * HALF) = pack8(v0, v1); } }
        }
    }
};

struct EpiMerge {
    static constexpr int EPI_ID = 2;
    static constexpr bool PERM = true, AFTER_DRAIN = false, HAS_MID = true;
    const bf16_t* R; bf16_t* MERGED;
    __device__ __forceinline__ void mid(f32x4 (&acc)[2][2][4][2], const Unit& u, int wr, int wc, int fr, int fq) const {
        const int rl0 = wr * 64 + fr, col0 = u.pn * BM + wc * 32 + 8 * fq; const bf16_t* G = R + (size_t)u.pm * 1048576 + 524288;
#pragma unroll
        for (int ai = 0; ai < 2; ++ai)
#pragma unroll
            for (int m = 0; m < 4; ++m) { const bf16_t* rowp = G + (size_t)(rl0 + ai * HALF + m * 16) * 2048 + col0;
#pragma unroll
                for (int bj = 0; bj < 2; ++bj) { const u32x4 ga = *(const u32x4*)(rowp + bj * HALF), gb = *(const u32x4*)(rowp + 1024 + bj * HALF);
#pragma unroll
                    for (int j = 0; j < 4; ++j) { const float a0 = bflo(ga[j]), a1 = bfhi(ga[j]); const float b0 = fmaxf(bflo(gb[j]), 1e-30f), b1 = fmaxf(bfhi(gb[j]), 1e-30f);
                        acc[ai][bj][m][j >> 1][2 * (j & 1)] *= a0 * fast_rcp(b0); acc[ai][bj][m][j >> 1][2 * (j & 1) + 1] *= a1 * fast_rcp(b1); } } }
    }
    __device__ __forceinline__ void operator()(const f32x4 (&acc)[2][2][4][2], const Unit& u, int wr, int wc, int fr, int fq) const {
        const int row0 = u.pm * BM + wr * 64 + fr, col0 = u.pn * BM + wc * 32 + 8 * fq;
#pragma unroll
        for (int ai = 0; ai < 2; ++ai)
#pragma unroll
            for (int m = 0; m < 4; ++m) { const int row = row0 + ai * HALF + m * 16; const bf16_t* gp = R + (size_t)u.pm * 1048576 + 524288 + (size_t)(row - u.pm * BM) * 2048 + 1024 + col0; bf16_t* op = MERGED + (size_t)row * 1024 + col0;
#pragma unroll
                for (int bj = 0; bj < 2; ++bj) { const u32x4 gb = *(const u32x4*)(gp + bj * HALF); f32x4 v0 = acc[ai][bj][m][0], v1 = acc[ai][bj][m][1];
                    v0[0] *= fmaxf(bflo(gb[0]), 1e-30f); v0[1] *= fmaxf(bfhi(gb[0]), 1e-30f); v0[2] *= fmaxf(bflo(gb[1]), 1e-30f); v0[3] *= fmaxf(bfhi(gb[1]), 1e-30f);
                    v1[0] *= fmaxf(bflo(gb[2]), 1e-30f); v1[1] *= fmaxf(bfhi(gb[2]), 1e-30f); v1[2] *= fmaxf(bflo(gb[3]), 1e-30f); v1[3] *= fmaxf(bfhi(gb[3]), 1e-30f);
                    *(u32x4*)(op + bj * HALF) = pack8(v0, v1); } }
    }
};

struct EpiRes1 {
    static constexpr int EPI_ID = 3;
    static constexpr bool PERM = true, AFTER_DRAIN = false, HAS_MID = false;
    const float* x; float* h1; bf16_t* hhat; const float* modf; const float* norm2w; float* ssq;
    __device__ __forceinline__ void mid(f32x4 (&)[2][2][4][2], const Unit&, int, int, int, int) const {}
    __device__ __forceinline__ void operator()(const f32x4 (&acc)[2][2][4][2], const Unit& u, int wr, int wc, int fr, int fq) const {
        const int row0 = u.pm * BM + wr * 64 + fr, col0 = u.pn * BM + wc * 32 + 8 * fq, b = u.pm >> 4;
        f32x4 g1[2][2], cs[2][2];
#pragma unroll
        for (int bj = 0; bj < 2; ++bj)
#pragma unroll
            for (int n = 0; n < 2; ++n) { const int c = col0 + bj * HALF + 4 * n; g1[bj][n] = *(const f32x4*)(modf + b * 6144 + 2048 + c);
                const f32x4 sc = *(const f32x4*)(modf + b * 6144 + 4096 + c), w = *(const f32x4*)(norm2w + c); cs[bj][n] = w * (sc + 1.0f); }
#pragma unroll
        for (int ai = 0; ai < 2; ++ai)
#pragma unroll
            for (int m = 0; m < 4; ++m) { const int row = row0 + ai * HALF + m * 16; const size_t off = (size_t)row * 1024 + col0; float q = 0.f;
#pragma unroll
                for (int bj = 0; bj < 2; ++bj) { const f32x4 x0 = *(const f32x4*)(x + off + bj * HALF), x1 = *(const f32x4*)(x + off + bj * HALF + 4);
                    const f32x4 h0 = x0 + g1[bj][0] * acc[ai][bj][m][0], hb = x1 + g1[bj][1] * acc[ai][bj][m][1];
                    *(f32x4*)(h1 + off + bj * HALF) = h0; *(f32x4*)(h1 + off + bj * HALF + 4) = hb;
                    q += (h0[0] * h0[0] + h0[1] * h0[1]) + (h0[2] * h0[2] + h0[3] * h0[3]) + (hb[0] * hb[0] + hb[1] * hb[1]) + (hb[2] * hb[2] + hb[3] * hb[3]);
                    *(u32x4*)(hhat + off + bj * HALF) = pack8(h0 * cs[bj][0], hb * cs[bj][1]); }
                q += __shfl_xor(q, 16); q += __shfl_xor(q, 32);
                if (fq == 0) ssq[(size_t)row * 16 + u.pn * 4 + wc] = q; }
    }
};

struct EpiFF1 {
    static constexpr int EPI_ID = 4;
    static constexpr bool PERM = true, AFTER_DRAIN = false, HAS_MID = false;
    const float* bias2; const PG8_LAS float* rstd; bf16_t* HID;
    __device__ __forceinline__ void mid(f32x4 (&)[2][2][4][2], const Unit&, int, int, int, int) const {}
    __device__ __forceinline__ void operator()(const f32x4 (&acc)[2][2][4][2], const Unit& u, int wr, int wc, int fr, int fq) const {
        const int rl0 = wr * 64 + fr, col0 = u.pn * BM + wc * 32 + 8 * fq, b = u.pm >> 4;
        f32x4 bv[2][2];
#pragma unroll
        for (int bj = 0; bj < 2; ++bj)
#pragma unroll
            for (int n = 0; n < 2; ++n) bv[bj][n] = *(const f32x4*)(bias2 + b * 4096 + col0 + bj * HALF + 4 * n);
#pragma unroll
        for (int ai = 0; ai < 2; ++ai)
#pragma unroll
            for (int m = 0; m < 4; ++m) { const int rl = rl0 + ai * HALF + m * 16; const float rs = rstd[rl]; bf16_t* op = HID + (size_t)(u.pm * BM + rl) * 4096 + col0;
#pragma unroll
                for (int bj = 0; bj < 2; ++bj) { f32x4 v0 = acc[ai][bj][m][0] * rs + bv[bj][0], v1 = acc[ai][bj][m][1] * rs + bv[bj][1];
#pragma unroll
                    for (int i = 0; i < 4; ++i) { const float a = fmaxf(v0[i], 0.f), c = fmaxf(v1[i], 0.f); v0[i] = a * a; v1[i] = c * c; }
                    *(u32x4*)(op + bj * HALF) = pack8(v0, v1); } }
    }
};

struct EpiRes2 {
    static constexpr int EPI_ID = 5;
    static constexpr bool PERM = true, AFTER_DRAIN = false, HAS_MID = false;
    const float* h; float* ho; const float* modf; float* ssq;
    __device__ __forceinline__ void mid(f32x4 (&)[2][2][4][2], const Unit&, int, int, int, int) const {}
    __device__ __forceinline__ void operator()(const f32x4 (&acc)[2][2][4][2], const Unit& u, int wr, int wc, int fr, int fq) const {
        const int row0 = u.pm * BM + wr * 64 + fr, col0 = u.pn * BM + wc * 32 + 8 * fq, b = u.pm >> 4;
        f32x4 g2[2][2];
#pragma unroll
        for (int bj = 0; bj < 2; ++bj)
#pragma unroll
            for (int n = 0; n < 2; ++n) g2[bj][n] = *(const f32x4*)(modf + b * 6144 + 5120 + col0 + bj * HALF + 4 * n);
#pragma unroll
        for (int ai = 0; ai < 2; ++ai)
#pragma unroll
            for (int m = 0; m < 4; ++m) { const int row = row0 + ai * HALF + m * 16; const size_t off = (size_t)row * 1024 + col0; float q = 0.f;
#pragma unroll
                for (int bj = 0; bj < 2; ++bj) { const f32x4 x0 = *(const f32x4*)(h + off + bj * HALF), x1 = *(const f32x4*)(h + off + bj * HALF + 4);
                    const f32x4 h0 = x0 + g2[bj][0] * acc[ai][bj][m][0], hb = x1 + g2[bj][1] * acc[ai][bj][m][1];
                    *(f32x4*)(ho + off + bj * HALF) = h0; *(f32x4*)(ho + off + bj * HALF + 4) = hb;
                    q += (h0[0] * h0[0] + h0[1] * h0[1]) + (h0[2] * h0[2] + h0[3] * h0[3]) + (hb[0] * hb[0] + hb[1] * hb[1]) + (hb[2] * hb[2] + hb[3] * hb[3]); }
                q += __shfl_xor(q, 16); q += __shfl_xor(q, 32);
                if (fq == 0) ssq[(size_t)row * 16 + u.pn * 4 + wc] = q; }
    }
};

template <class Epi, class Sched, bool ALIGN_EPI = false, bool SP2 = false>
__device__ __forceinline__ void gemm_phase(PG8_LAS unsigned char* lds, const Gemm g, const Sched& S, const Epi& E, const int wid) {
    const int lane = lane_id_v(), tid = wid * 64 + lane, wr = wid >> 2, wc = wid & 3, fr = lane & 15, fq = lane >> 4;
    const int K = g.K, nt = K / BK;
    unsigned voffA[2], voffB[2];
#pragma unroll
    for (int i = 0; i < 2; ++i) { int R, C; stage_rc(tid * 16 + i * 8192, R, C); const int Rb = Epi::PERM ? ((R & ~31) + perm32(R & 31)) : R;
        voffA[i] = (unsigned)(R * K + C) * 2u; voffB[i] = (unsigned)(Rb * K + C) * 2u; }
    const size_t kstep = (size_t)(BK * 2);
    const size_t hstep = (size_t)HALF * K * 2;
    const size_t tstep = 2 * hstep;
    const unsigned ldsw = (unsigned)wid * 1024u;
    const int aoff = lds_byte(wr * 64 + fr, fq * 8), boff = lds_byte(wc * 32 + fr, fq * 8);
#define PG8_SA(b, h) (((b) * 2 + (h)) * HTB)
#define PG8_SB(b, h) ((4 + (b) * 2 + (h)) * HTB)
#define PG8_STAGE(bufoff, gbase, voff) do { _Pragma("unroll") for (int _i = 0; _i < 2; ++_i) \
        __builtin_amdgcn_global_load_lds((const unsigned*)((const char*)(gbase) + (voff)[_i]), (PG8_LAS unsigned*)(lds + (bufoff) + ldsw + _i * 8192), 16, 0, 0); } while (0)
#define PG8_LDA(dst, b, h) do { _Pragma("unroll") for (int m = 0; m < 4; ++m) _Pragma("unroll") for (int k = 0; k < 2; ++k) dst[m][k] = *(const PG8_LAS bf16x8*)(lds + PG8_SA(b, h) + aoff + m * 2048 + k * 1024); } while (0)
#define PG8_LDB(dst, b, h) do { _Pragma("unroll") for (int n = 0; n < 2; ++n) _Pragma("unroll") for (int k = 0; k < 2; ++k) dst[n][k] = *(const PG8_LAS bf16x8*)(lds + PG8_SB(b, h) + boff + n * 2048 + k * 1024); } while (0)
#define PG8_MMA(ai, bj, At, Bt) do { __builtin_amdgcn_s_setprio(1); _Pragma("unroll") for (int m = 0; m < 4; ++m) _Pragma("unroll") for (int n = 0; n < 2; ++n) _Pragma("unroll") for (int k = 0; k < 2; ++k) \
        acc[ai][bj][m][n] = __builtin_amdgcn_mfma_f32_16x16x32_bf16(Bt[n][k], At[m][k], acc[ai][bj][m][n], 0, 0, 0); __builtin_amdgcn_s_setprio(0); } while (0)
#define PG8_WAIT_V(n) asm volatile("s_waitcnt vmcnt(" #n ")" ::: "memory")
#define PG8_WAIT_L(n) asm volatile("s_waitcnt lgkmcnt(" #n ")" ::: "memory")
#define PG8_BAR __builtin_amdgcn_s_barrier()
#define PG8_SCHED __builtin_amdgcn_sched_barrier(0)
    Unit cur, nxt; int ui = 0;
    if (!S.next(0, cur)) return;
    f32x4 acc[2][2][4][2];
#pragma unroll
    for (int a = 0; a < 2; ++a)
#pragma unroll
        for (int b = 0; b < 2; ++b)
#pragma unroll
            for (int m = 0; m < 4; ++m)
#pragma unroll
                for (int n = 0; n < 2; ++n) acc[a][b][m][n] = (f32x4){0.f, 0.f, 0.f, 0.f};
    bf16x8 At[4][2], B0[2][2], B1[2][2];
    const char* cA = (const char*)g.A + (size_t)cur.pm * g.a_pstride; const char* cB = (const char*)g.Bt + (size_t)cur.pn * tstep;
    S.a_ready(cur);
    if constexpr (SP2) {
        PG8_STAGE(PG8_SB(0, 0), cB, voffB); PG8_STAGE(PG8_SB(0, 1), cB + hstep, voffB); PG8_STAGE(PG8_SA(0, 0), cA, voffA); PG8_STAGE(PG8_SA(0, 1), cA + hstep, voffA);
        if (wr == 1) PG8_BAR;
        PG8_WAIT_V(2); PG8_BAR;
        PG8_STAGE(PG8_SB(1, 0), cB + kstep, voffB); PG8_STAGE(PG8_SA(1, 0), cA + kstep, voffA); PG8_STAGE(PG8_SB(1, 1), cB + hstep + kstep, voffB);
        PG8_WAIT_V(6); PG8_BAR;
    } else {
        PG8_STAGE(PG8_SB(0, 0), cB, voffB); PG8_STAGE(PG8_SA(0, 0), cA, voffA); PG8_STAGE(PG8_SB(0, 1), cB + hstep, voffB); PG8_STAGE(PG8_SA(0, 1), cA + hstep, voffA);
        if (wr == 1) PG8_BAR;
        PG8_WAIT_V(4); PG8_BAR;
        PG8_STAGE(PG8_SB(1, 0), cB + kstep, voffB); PG8_STAGE(PG8_SA(1, 0), cA + kstep, voffA); PG8_STAGE(PG8_SB(1, 1), cB + hstep + kstep, voffB);
        PG8_WAIT_V(6); PG8_BAR;
    }
    for (;;) {
        const bool has_next = S.next(ui + 1, nxt);
        const char* nA = has_next ? (const char*)g.A + (size_t)nxt.pm * g.a_pstride : cA; const char* nB = has_next ? (const char*)g.Bt + (size_t)nxt.pn * tstep : cB;
        for (int t = 0; t < nt; t += 2) {
            if constexpr (Epi::HAS_MID) { if (t == (nt >> 1)) { int fr_e = fr, fq_e = fq; asm volatile("" : "+v"(fr_e), "+v"(fq_e)); E.mid(acc, cur, wr, wc, fr_e, fq_e); } }
            const bool last = (t == nt - 2);
            const char* a1 = cA + (size_t)(t + 1) * kstep;
            const char* a2 = last ? nA : cA + (size_t)(t + 2) * kstep; const char* b2 = last ? nB : cB + (size_t)(t + 2) * kstep;
            const char* a3 = a2 + kstep; const char* b3 = b2 + kstep;
            if (last && has_next) S.a_ready(nxt);
            if constexpr (SP2) {
            PG8_LDB(B0, 0, 0); PG8_LDB(B1, 0, 1); PG8_SCHED; PG8_LDA(At, 0, 0); PG8_STAGE(PG8_SA(1, 1), a1 + hstep, voffA);
            PG8_WAIT_V(8); PG8_WAIT_L(0); PG8_BAR; PG8_MMA(0, 0, At, B0); PG8_MMA(0, 1, At, B1); PG8_BAR; PG8_SCHED;
            PG8_LDA(At, 0, 1); PG8_STAGE(PG8_SB(0, 0), b2, voffB); PG8_STAGE(PG8_SB(0, 1), b2 + hstep, voffB); PG8_STAGE(PG8_SA(0, 0), a2, voffA);
            PG8_WAIT_V(8); PG8_WAIT_L(0); PG8_BAR; PG8_MMA(1, 0, At, B0); PG8_MMA(1, 1, At, B1); PG8_BAR; PG8_SCHED;
            PG8_LDB(B0, 1, 0); PG8_LDB(B1, 1, 1); PG8_SCHED; PG8_LDA(At, 1, 0); PG8_STAGE(PG8_SA(0, 1), a2 + hstep, voffA);
            PG8_WAIT_V(8); PG8_WAIT_L(0); PG8_BAR; PG8_MMA(0, 0, At, B0); PG8_MMA(0, 1, At, B1); PG8_BAR; PG8_SCHED;
            PG8_LDA(At, 1, 1); PG8_STAGE(PG8_SB(1, 0), b3, voffB); PG8_STAGE(PG8_SB(1, 1), b3 + hstep, voffB); PG8_STAGE(PG8_SA(1, 0), a3, voffA);
            PG8_WAIT_V(8); PG8_WAIT_L(0); PG8_BAR; PG8_MMA(1, 0, At, B0); PG8_MMA(1, 1, At, B1); PG8_BAR; PG8_SCHED;
            } else {
            PG8_LDB(B0, 0, 0); PG8_SCHED; PG8_LDA(At, 0, 0); PG8_STAGE(PG8_SA(1, 1), a1 + hstep, voffA);
            PG8_WAIT_L(8); PG8_BAR; PG8_WAIT_L(0); PG8_MMA(0, 0, At, B0); PG8_BAR; PG8_SCHED;
            PG8_LDB(B1, 0, 1); PG8_STAGE(PG8_SB(0, 0), b2, voffB);
            PG8_BAR; PG8_WAIT_L(0); PG8_MMA(0, 1, At, B1); PG8_BAR;
            PG8_LDA(At, 0, 1); PG8_STAGE(PG8_SA(0, 0), a2, voffA);
            PG8_BAR; PG8_WAIT_L(0); PG8_MMA(1, 0, At, B0); PG8_BAR; PG8_SCHED;
            PG8_STAGE(PG8_SB(0, 1), b2 + hstep, voffB);
            PG8_WAIT_V(6); PG8_BAR; PG8_MMA(1, 1, At, B1); PG8_BAR;
            PG8_LDB(B0, 1, 0); PG8_SCHED; PG8_LDA(At, 1, 0); PG8_STAGE(PG8_SA(0, 1), a2 + hstep, voffA);
            PG8_WAIT_L(8); PG8_BAR; PG8_WAIT_L(0); PG8_MMA(0, 0, At, B0); PG8_BAR; PG8_SCHED;
            PG8_LDB(B1, 1, 1); PG8_STAGE(PG8_SB(1, 0), b3, voffB);
            PG8_BAR; PG8_WAIT_L(0); PG8_MMA(0, 1, At, B1); PG8_BAR;
            PG8_LDA(At, 1, 1); PG8_STAGE(PG8_SA(1, 0), a3, voffA);
            PG8_BAR; PG8_WAIT_L(0); PG8_MMA(1, 0, At, B0); PG8_BAR; PG8_SCHED;
            PG8_STAGE(PG8_SB(1, 1), b3 + hstep, voffB);
            PG8_WAIT_V(6); PG8_BAR; PG8_MMA(1, 1, At, B1); PG8_BAR;
            }
        }
        if constexpr (ALIGN_EPI) { if (wr == 0) PG8_BAR; }
        if constexpr (!Epi::AFTER_DRAIN) { int fr_e = fr, fq_e = fq; asm volatile("" : "+v"(fr_e), "+v"(fq_e));
            E(acc, cur, wr, wc, fr_e, fq_e);
#ifdef PH_EPI2
            if (Epi::EPI_ID == PH_EPI2) { asm volatile("" : "+v"(fr_e), "+v"(fq_e)); E(acc, cur, wr, wc, fr_e, fq_e); }
#endif
            S.done(cur); }
        if (!has_next) break;
#pragma unroll
        for (int a = 0; a < 2; ++a)
#pragma unroll
            for (int b = 0; b < 2; ++b)
#pragma unroll
                for (int m = 0; m < 4; ++m)
#pragma unroll
                    for (int n = 0; n < 2; ++n) acc[a][b][m][n] = (f32x4){0.f, 0.f, 0.f, 0.f};
        cur = nxt; cA = nA; cB = nB; ++ui;
        if constexpr (ALIGN_EPI) { if (wr == 1) PG8_BAR; }
    }
    PG8_WAIT_V(0);
    if constexpr (!ALIGN_EPI) { if (wr == 0) PG8_BAR; }
    PG8_BAR;
    if constexpr (Epi::AFTER_DRAIN) { E.fused(acc, cur, wr, wc, fr, fq, lds, wid, lane); S.done(cur); }
#undef PG8_SA
#undef PG8_SB
#undef PG8_STAGE
#undef PG8_LDA
#undef PG8_LDB
#undef PG8_MMA
#undef PG8_WAIT_V
#undef PG8_WAIT_L
#undef PG8_BAR
#undef PG8_SCHED
}
}

#define GAS __attribute__((address_space(1)))
#define LAS __attribute__((address_space(3)))
typedef unsigned short bf16;
typedef unsigned v4u __attribute__((ext_vector_type(4)));
typedef float f32x4 __attribute__((ext_vector_type(4)));
typedef short bf16x8 __attribute__((ext_vector_type(8)));
typedef GAS unsigned gu32;
typedef GAS unsigned long long gu64;
#define RLX_AGENT __ATOMIC_RELAXED, __HIP_MEMORY_SCOPE_AGENT
#define LDS_WAIT() asm volatile("s_waitcnt lgkmcnt(0)" ::: "memory")
#define VM_WAIT() asm volatile("s_waitcnt vmcnt(0)" ::: "memory")
__device__ __forceinline__ unsigned long long rt() { return __builtin_amdgcn_s_memrealtime(); }
__device__ __forceinline__ unsigned f2bf(float f) { unsigned u = __builtin_bit_cast(unsigned, f); return (u + 0x7fffu + ((u >> 16) & 1u)) >> 16; }
__device__ __forceinline__ unsigned pk2(float lo, float hi) { return f2bf(lo) | (f2bf(hi) << 16); }

#define XB_TMO      128
#define XB_XCNT(j)  (256  + 64 * (j))
#define XB_XSUB(j)  (1280 + 64 * (j))
#define XB_XGEN(j)  (2304 + 64 * (j))
#define XB_TOP      3328
#define XB_TOPGEN   3392
#define XCD_BAR_WORDS 3456
#define XB_SPIN_CAP (1u << 18)

__device__ __forceinline__ unsigned xb_ld(unsigned* p)              { return __hip_atomic_load(p, __ATOMIC_RELAXED, __HIP_MEMORY_SCOPE_AGENT); }
__device__ __forceinline__ unsigned xb_add(unsigned* p, unsigned v) { return __hip_atomic_fetch_add(p, v, __ATOMIC_RELAXED, __HIP_MEMORY_SCOPE_AGENT); }
__device__ __forceinline__ unsigned xb_xcc_id() { return (unsigned)__builtin_amdgcn_s_getreg((3 << 11) | 20) & 0xFu; }
#define XB_SPIN(cond, bar) do { unsigned _sp = 0; while (cond) { __builtin_amdgcn_s_sleep(1); \
    if ((++_sp & 255u) == 0u) { if (xb_ld(&(bar)[XB_TMO])) break; if (_sp > XB_SPIN_CAP) { atomicAdd(&(bar)[XB_TMO], 1u); break; } } } } while (0)

struct XcdBarrier {
    unsigned* bar; unsigned x;
    volatile LAS unsigned* st;
};

__device__ __forceinline__ XcdBarrier xcd_barrier_post(unsigned* bar, volatile LAS unsigned* st, const int wave) {
    XcdBarrier b; b.bar = bar; b.x = xb_xcc_id(); b.st = st;
    if (wave == 0 && pg8::lane_id_v() == 0) (void)xb_add(&bar[XB_XCNT(b.x)], 1u);
    return b;
}
__device__ __forceinline__ void xcd_barrier_complete(unsigned* bar, unsigned x, unsigned& nloc, unsigned& nx) {
    const unsigned G = gridDim.x * gridDim.y * gridDim.z;
    unsigned sum, cnt, mine, sp = 0u;
    for (;;) {
        sum = 0u; cnt = 0u; mine = 0u;
#pragma unroll
        for (unsigned j = 0; j < 16; ++j) { const unsigned c = xb_ld(&bar[XB_XCNT(j)]); sum += c; cnt += (c > 0u) ? 1u : 0u; mine = (j == x) ? c : mine; }
        if (sum == G) break;
        __builtin_amdgcn_s_sleep(1);
        if ((++sp & 255u) == 0u) { if (xb_ld(&bar[XB_TMO])) break; if (sp > XB_SPIN_CAP) { atomicAdd(&bar[XB_TMO], 1u); break; } }
    }
    nloc = mine > 0u ? mine : 1u; nx = cnt > 0u ? cnt : 1u;
}

__device__ __forceinline__ void xcd_barrier(const XcdBarrier& b, const int wave) {
    asm volatile("s_waitcnt vmcnt(0)" ::: "memory");
    __syncthreads();
    if (wave == 0 && pg8::lane_id_v() == 0) {
        unsigned* bar = b.bar;
        __builtin_amdgcn_s_waitcnt(0);
        unsigned nloc = b.st[0], nx = b.st[1];
        if (nloc == 0u) { xcd_barrier_complete(bar, b.x, nloc, nx); b.st[0] = nloc; b.st[1] = nx; }
        const unsigned old = xb_add(&bar[XB_XSUB(b.x)], 1u);
        const unsigned gen = old / nloc;
        if (old + 1u == (gen + 1u) * nloc) {
            __builtin_amdgcn_fence(__ATOMIC_RELEASE, "agent");
            asm volatile("s_waitcnt vmcnt(0)" ::: "memory");
            const unsigned og = xb_add(&bar[XB_TOP], 1u);
            const unsigned tg = og / nx;
            if (og + 1u == (tg + 1u) * nx) xb_add(&bar[XB_TOPGEN], 1u);
            else XB_SPIN(xb_ld(&bar[XB_TOPGEN]) == tg, bar);
            __builtin_amdgcn_fence(__ATOMIC_ACQUIRE, "agent");
            xb_add(&bar[XB_XGEN(b.x)], 1u);
            asm volatile("s_waitcnt vmcnt(0)" ::: "memory");
        } else {
            XB_SPIN(xb_ld(&bar[XB_XGEN(b.x)]) == gen, bar);
            __builtin_amdgcn_fence(__ATOMIC_ACQUIRE, "agent");
            asm volatile("s_waitcnt vmcnt(0)" ::: "memory");
        }
    }
    __syncthreads();
}


__device__ __forceinline__ void group_sync(unsigned* cnt, unsigned want, unsigned* tmo, const int wave) {
    asm volatile("s_waitcnt vmcnt(0)" ::: "memory");
    __syncthreads();
    if (wave == 0 && pg8::lane_id_v() == 0) {
        __builtin_amdgcn_fence(__ATOMIC_RELEASE, "agent");
        asm volatile("s_waitcnt vmcnt(0)" ::: "memory");
        (void)xb_add(cnt, 1u);
        unsigned sp = 0u;
        while (xb_ld(cnt) < want) { __builtin_amdgcn_s_sleep(1); if ((++sp & 255u) == 0u) { if (xb_ld(tmo)) break; if (sp > XB_SPIN_CAP) { atomicAdd(tmo, 1u); break; } } }
        __builtin_amdgcn_fence(__ATOMIC_ACQUIRE, "agent");
        asm volatile("s_waitcnt vmcnt(0)" ::: "memory");
    }
    __syncthreads();
}

constexpr int NWAVES = 8;
constexpr int BATCH = 4, SEQ = 4096, D = 1024, M = BATCH * SEQ, NPROJ = 8192, FF = 4096, NMOD = 6 * D;
constexpr int RH = 4, DK = 128, DV = 256, SCH = 256  , NJ = SEQ / SCH  ;
constexpr float EPS = 1e-6f;
constexpr int KS_MOD = 8;
constexpr size_t MiB = 1u << 20;
constexpr size_t WS_CTL = 0, CTL_ZERO_BYTES = 1 * MiB;
constexpr size_t WS_MODP = 1 * MiB;
constexpr size_t WS_MODF = 2 * MiB + 512 * 1024;
constexpr size_t WS_BIAS2 = WS_MODF + 128 * 1024;
constexpr size_t WS_SSQ2 = 3 * MiB, WS_SSQ3 = 4 * MiB;
constexpr size_t WS_WIN = 5 * MiB, WS_WRC = 21 * MiB, WS_WO = 25 * MiB, WS_W1 = 27 * MiB, WS_W2 = 35 * MiB;
constexpr size_t WS_ST = WS_WIN;
constexpr size_t WS_QK = 44 * MiB, WS_V = 76 * MiB, WS_R = 108 * MiB, WS_END = 236 * MiB;
constexpr size_t WS_MERGED = WS_QK, WS_HHAT = WS_V, WS_HID = WS_R;
constexpr size_t OUT_U = 0, OUT_Z = 32 * MiB, OUT_KV = 0;
static_assert(WS_W2 + (size_t)D * FF * 2 <= WS_QK && WS_HID + (size_t)M * FF * 2 <= WS_END, "d_ws map");
constexpr int CW_TMO = 0, CW_BAR = 4096, CW_GRP = 32768;
constexpr int RING_OFF = 0, PHASE_BYTES = 139264, LDSCTL_OFF = PHASE_BYTES, MISC_OFF = LDSCTL_OFF + 320, TAB_OFF = LDSCTL_OFF + 1024, LDS_BYTES = PHASE_BYTES + 4096;

struct Frame {
    LAS unsigned char* lds; volatile LAS unsigned* MISC; gu32* ctl;
    int wave, vcu, G;
    const float *x, *c, *w_ada, *b_ada, *norm1_w, *w_in, *ret_gn_w, *conv_w, *w_ret_out, *w_conv_out, *w_o, *norm2_w, *w_ff1, *w_ff2, *final_norm_w; const int* positions;
    float* out; unsigned char* ws;
};
__device__ __forceinline__ float wave_sum(float v) {
#pragma unroll
    for (int o = 1; o < 64; o <<= 1) v += __shfl_xor(v, o);
    return v;
}
__device__ __forceinline__ unsigned cvtpk2(float lo, float hi) { return pg8::cvtpk(lo, hi); }

__device__ __forceinline__ int vmap_in(int n) {
    if (n < 1024) { const int hb = n & ~127, d = n & 127; const int dd = d & 63; return hb + 8 * (dd >> 2) + (d >= 64 ? 4 : 0) + (dd & 3); }
    if (n >= 4096 && n < 6144) { const int j = (n - 4096) & 1023; return 4096 + 8 * (j >> 2) + (n >= 5120 ? 4 : 0) + (j & 3); }
    return n;
}
struct P0Tile { const float* W; bf16* WT; int N, ldt, kofs, k0, n0, vm; };
__device__ __forceinline__ P0Tile p0_tile(const Frame& F, int t) {
    P0Tile T; int r = t;
    if (r < 512) { T.W = F.w_in; T.WT = (bf16*)(F.ws + WS_WIN); T.N = NPROJ; T.ldt = D; T.kofs = 0; T.vm = 1; T.n0 = 512 * (r >> 5); T.k0 = 32 * (r & 31); return T; } r -= 512;
    if (r < 64) { T.W = F.w_ret_out; T.WT = (bf16*)(F.ws + WS_WRC); T.N = D; T.ldt = 2 * D; T.kofs = 0; T.vm = 0; T.n0 = 512 * (r >> 5); T.k0 = 32 * (r & 31); return T; } r -= 64;
    if (r < 64) { T.W = F.w_conv_out; T.WT = (bf16*)(F.ws + WS_WRC); T.N = D; T.ldt = 2 * D; T.kofs = D; T.vm = 0; T.n0 = 512 * (r >> 5); T.k0 = 32 * (r & 31); return T; } r -= 64;
    if (r < 64) { T.W = F.w_o; T.WT = (bf16*)(F.ws + WS_WO); T.N = D; T.ldt = D; T.kofs = 0; T.vm = 0; T.n0 = 512 * (r >> 5); T.k0 = 32 * (r & 31); return T; } r -= 64;
    if (r < 256) { T.W = F.w_ff1; T.WT = (bf16*)(F.ws + WS_W1); T.N = FF; T.ldt = D; T.kofs = 0; T.vm = 0; T.n0 = 512 * (r >> 5); T.k0 = 32 * (r & 31); return T; } r -= 256;
    T.W = F.w_ff2; T.WT = (bf16*)(F.ws + WS_W2); T.N = D; T.ldt = FF; T.kofs = 0; T.vm = 0; T.n0 = 512 * (r >> 7); T.k0 = 32 * (r & 127); return T;
}
constexpr int P0_NTILES = 512 + 3 * 64 + 256 + 256;
__device__ __forceinline__ void p0_dma(const P0Tile& T, LAS unsigned char* buf, int wave, int lane) {
#pragma unroll
    for (int i = 0; i < 8; ++i) { const int row = 4 * wave + (i >> 1), half = i & 1;
        __builtin_amdgcn_global_load_lds((const unsigned*)(T.W + (size_t)(T.k0 + row) * T.N + T.n0 + half * 256 + lane * 4), (LAS unsigned*)(buf + row * 2048 + half * 1024), 16, 0, 2  ); }
}
__device__ __forceinline__ float siluf_(float x) { return x / (1.0f + __expf(-x)); }
__device__ __forceinline__ void p0_prologue(Frame& F) {
    const int lane_ = pg8::lane_id_v(), tid_ = F.wave * 64 + lane_; (void)tid_;
    const int gw = F.vcu * NWAVES + F.wave, NGW = F.G * NWAVES;
    for (int vb = F.vcu; vb < 32 * KS_MOD; vb += F.G) {
        const int cb = vb & 31, ks = vb >> 5, k0 = ks * (D / KS_MOD) + 16 * F.wave; const int col = 192 * cb + 4 * (lane_ < 48 ? lane_ : 0);
        f32x4 a0 = {0.f, 0.f, 0.f, 0.f}, a1 = a0, a2 = a0, a3 = a0;
        const float* wp = F.w_ada + (size_t)k0 * NMOD + col;
        f32x4 wv[16];
#pragma unroll
        for (int kk = 0; kk < 16; ++kk) wv[kk] = __builtin_nontemporal_load((const GAS f32x4*)(wp + (size_t)kk * NMOD));
#pragma unroll
        for (int kk = 0; kk < 16; ++kk) { const int k = k0 + kk; const float s0 = siluf_(F.c[k]), s1 = siluf_(F.c[D + k]), s2 = siluf_(F.c[2 * D + k]), s3 = siluf_(F.c[3 * D + k]);
            a0 += wv[kk] * s0; a1 += wv[kk] * s1; a2 += wv[kk] * s2; a3 += wv[kk] * s3; }
        LAS f32x4* red = (LAS f32x4*)(F.lds + RING_OFF);
        if (lane_ < 48) { LAS f32x4* rp = red + (F.wave * 4) * 48 + lane_; rp[0] = a0; rp[48] = a1; rp[96] = a2; rp[144] = a3; }
        __syncthreads();
        if (tid_ < 192) { f32x4 sacc = {0.f, 0.f, 0.f, 0.f};
#pragma unroll
            for (int w = 0; w < NWAVES; ++w) sacc += red[w * 192 + tid_];
            *(f32x4*)((float*)(F.ws + WS_MODP) + (size_t)ks * 4 * NMOD + (size_t)(tid_ / 48) * NMOD + 192 * cb + 4 * (tid_ % 48)) = sacc; }
        __syncthreads();
    }
    const int t0 = (int)(((long)F.vcu * P0_NTILES) / F.G), t1 = (int)(((long)(F.vcu + 1) * P0_NTILES) / F.G);
    if (t0 < t1) { const P0Tile T0 = p0_tile(F, t0); p0_dma(T0, F.lds + RING_OFF, F.wave, lane_); }
    for (int t = t0; t < t1; ++t) {
        LAS unsigned char* buf = F.lds + RING_OFF + ((t - t0) & 1) * 65536;
        const P0Tile T = p0_tile(F, t);
        __syncthreads();
        if (t + 1 < t1) { const P0Tile Tn = p0_tile(F, t + 1); p0_dma(Tn, F.lds + RING_OFF + ((t + 1 - t0) & 1) * 65536, F.wave, lane_); }
        float v[32];
#pragma unroll
        for (int k = 0; k < 32; ++k) v[k] = *(const LAS float*)(buf + k * 2048 + tid_ * 4);
        const int n = T.n0 + tid_, vr = T.vm ? vmap_in(n) : n;
        GAS v4u* dst = (GAS v4u*)(T.WT + (size_t)vr * T.ldt + T.kofs + T.k0);
#pragma unroll
        for (int c = 0; c < 4; ++c) { v4u o; o.x = cvtpk2(v[8 * c], v[8 * c + 1]); o.y = cvtpk2(v[8 * c + 2], v[8 * c + 3]); o.z = cvtpk2(v[8 * c + 4], v[8 * c + 5]); o.w = cvtpk2(v[8 * c + 6], v[8 * c + 7]); dst[c] = o; }
    }
    __syncthreads();
}

__device__ __forceinline__ float modp_sum(const float* modp, int idx) { float s = 0.f;
#pragma unroll
    for (int ks = 0; ks < KS_MOD; ++ks) s += modp[(size_t)ks * 4 * NMOD + idx];
    return s; }
__device__ __forceinline__ void p1_unorm(Frame& F) {
    const int lane_ = pg8::lane_id_v(), tid_ = F.wave * 64 + lane_; (void)tid_;
    const float* modp = (const float*)(F.ws + WS_MODP); float* modf = (float*)(F.ws + WS_MODF);
    const int blk = F.vcu;
    const int b = blk >> 6;
    LAS float* cs1 = (LAS float*)(F.lds + RING_OFF); LAS float* sh1 = cs1 + D;
    for (int k = tid_; k < D; k += NWAVES * 64) {
        const float sh = modp_sum(modp, b * NMOD + k) + F.b_ada[k], sc = modp_sum(modp, b * NMOD + D + k) + F.b_ada[D + k];
        cs1[k] = F.norm1_w[k] * (1.0f + sc); sh1[k] = sh; }
    if (tid_ < 96) { const int idx = blk * 96 + tid_; if (idx < 4 * NMOD) modf[idx] = modp_sum(modp, idx) + F.b_ada[idx % NMOD]; }
    __syncthreads();
    bf16* U = (bf16*)((unsigned char*)F.out + OUT_U);
    for (int r0 = 0; r0 < 8; r0 += 4) {
        f32x4 v[4][4]; float ss[4];
#pragma unroll
        for (int q = 0; q < 4; ++q) { const int m = blk * 64 + F.wave * 8 + r0 + q; const GAS f32x4* xr = (const GAS f32x4*)(F.x + (size_t)m * D) + lane_;
#pragma unroll
            for (int j = 0; j < 4; ++j) v[q][j] = __builtin_nontemporal_load(xr + 64 * j); }
#pragma unroll
        for (int q = 0; q < 4; ++q) { float s = 0.f;
#pragma unroll
            for (int j = 0; j < 4; ++j) s += (v[q][j].x * v[q][j].x + v[q][j].y * v[q][j].y) + (v[q][j].z * v[q][j].z + v[q][j].w * v[q][j].w);
            ss[q] = 1.0f / sqrtf(wave_sum(s) * (1.0f / D) + EPS); }
#pragma unroll
        for (int q = 0; q < 4; ++q) { const int m = blk * 64 + F.wave * 8 + r0 + q; GAS unsigned long long* o8 = (GAS unsigned long long*)(U + (size_t)m * D) + lane_;
#pragma unroll
            for (int j = 0; j < 4; ++j) { const int k = 4 * lane_ + 256 * j; const f32x4 a = *(const LAS f32x4*)(cs1 + k), sh = *(const LAS f32x4*)(sh1 + k);
                const f32x4 u = v[q][j] * ss[q] * a + sh;
                o8[64 * j] = (unsigned long long)cvtpk2(u.x, u.y) | ((unsigned long long)cvtpk2(u.z, u.w) << 32); } }
    }
}

typedef short s16x4 __attribute__((ext_vector_type(4)));
typedef float f32x16 __attribute__((ext_vector_type(16)));
#define MFMA32(a, b, c) __builtin_amdgcn_mfma_f32_32x32x16_bf16((a), (b), (c), 0, 0, 0)
__device__ __forceinline__ int crow(int reg, int hh) { return (reg & 3) + 8 * (reg >> 2) + 4 * hh; }
__device__ __forceinline__ bf16x8 tr_frag(LAS unsigned char* p) {
    const s16x4 lo = __builtin_amdgcn_ds_read_tr16_b64_v4i16((LAS s16x4*)p), hi = __builtin_amdgcn_ds_read_tr16_b64_v4i16((LAS s16x4*)(p + 512));
    return __builtin_shufflevector(lo, hi, 0, 1, 2, 3, 4, 5, 6, 7);
}
__device__ __forceinline__ float log2_gamma(int hd) { return log2f(1.0f - exp2f(-5.0f - (float)hd)); }
constexpr int RT_K = 0, RT_V = 8192, RT_BLK = 24576;
__device__ __forceinline__ void rt_dma_block(const bf16* QK, const bf16* V, size_t mrow0, int hd, LAS unsigned char* slot, int wave, int lane) {
#pragma unroll
    for (int i = 0; i < 3; ++i) { const int idx = 3 * wave + i; const bool isk = idx >= 16; const int j = isk ? idx - 16 : idx, cb = j >> 1, half = j & 1;
        const size_t row = mrow0 + 16 * half + (lane >> 2); const int piece = (lane & 3) * 8;
        const bf16* src = isk ? QK + row * 1024 + 512 + hd * DK + cb * 32 + piece : V + row * 1024 + hd * DV + cb * 32 + piece;
        __builtin_amdgcn_global_load_lds((const unsigned*)src, (LAS unsigned*)(slot + (isk ? RT_K : RT_V) + cb * 2048 + half * 1024), 16, 0, 0); }
}
#define RT_WAITBAR(n) do { asm volatile("s_waitcnt vmcnt(" #n ")" ::: "memory"); __builtin_amdgcn_s_barrier(); asm volatile("" ::: "memory"); } while (0)
__device__ __forceinline__ void p3a_kvsum(Frame& F, int unit) {
    const int lane = pg8::lane_id_v();
    const int bh = unit >> 4, J = unit & 15, b = bh >> 2, hd = bh & 3;
    const bf16* QK = (const bf16*)(F.ws + WS_QK); const bf16* V = (const bf16*)(F.ws + WS_V);
    float* KV = (float*)((unsigned char*)F.out + OUT_KV) + (size_t)unit * (DV * DK);
    const int w = F.wave, r = lane & 31, hh = lane >> 5;
    const float l2g = log2_gamma(hd);
    const size_t mbase = (size_t)b * SEQ + (size_t)J * SCH;
    const int lane_off = (4 * hh + ((lane & 15) >> 2)) * 64 + ((lane >> 4) & 1) * 32 + (lane & 3) * 8;
    f32x16 acc[4];
#pragma unroll
    for (int d = 0; d < 4; ++d)
#pragma unroll
        for (int i = 0; i < 16; ++i) acc[d][i] = 0.f;
    float cj[8];
#pragma unroll
    for (int j = 0; j < 8; ++j) cj[j] = __builtin_amdgcn_exp2f(-(float)(8 * (j >> 2) + (j & 3)) * l2g);
#pragma unroll
    for (int p = 0; p < 3; ++p) rt_dma_block(QK, V, mbase + 32 * p, hd, F.lds + p * RT_BLK, w, lane);
#pragma unroll
    for (int sb = 0; sb < 8; ++sb) {
        if (sb <= 5) RT_WAITBAR(6); else if (sb == 6) RT_WAITBAR(3); else RT_WAITBAR(0);
        if (sb + 3 < 8) rt_dma_block(QK, V, mbase + 32 * (sb + 3), hd, F.lds + ((sb + 3) & 3) * RT_BLK, w, lane);
        LAS unsigned char* slot = F.lds + (sb & 3) * RT_BLK;
#pragma unroll
        for (int ks2 = 0; ks2 < 2; ++ks2) {
            const v4u bvr = __builtin_bit_cast(v4u, tr_frag(slot + RT_V + w * 2048 + ks2 * 1024 + lane_off));
            const float base = __builtin_amdgcn_exp2f((float)(255 - 32 * sb - 16 * ks2 - 4 * hh) * l2g); v4u bs;
#pragma unroll
            for (int q = 0; q < 4; ++q) bs[q] = cvtpk2(pg8::bflo(bvr[q]) * (base * cj[2 * q]), pg8::bfhi(bvr[q]) * (base * cj[2 * q + 1]));
            const bf16x8 bv = __builtin_bit_cast(bf16x8, bs);
#pragma unroll
            for (int d = 0; d < 4; ++d) { const bf16x8 ak = tr_frag(slot + RT_K + d * 2048 + ks2 * 1024 + lane_off); acc[d] = MFMA32(ak, bv, acc[d]); }
        }
    }
#pragma unroll
    for (int d = 0; d < 4; ++d)
#pragma unroll
        for (int g = 0; g < 4; ++g) { f32x4 o = {acc[d][4 * g], acc[d][4 * g + 1], acc[d][4 * g + 2], acc[d][4 * g + 3]};
            *(GAS f32x4*)(KV + (size_t)(32 * w + r) * DK + 32 * d + 8 * g + 4 * hh) = o; }
    __syncthreads();
}
__device__ __forceinline__ void p3a_conv(Frame& F, int blk) {
    const int lane_ = pg8::lane_id_v(), tid_ = F.wave * 64 + lane_; (void)tid_;
    bf16* Rb = (bf16*)(F.ws + WS_R); const bf16* Z = (const bf16*)((unsigned char*)F.out + OUT_Z);
    const int cc = tid_ & 127, rg = tid_ >> 7, m0 = blk * 64 + rg * 16, c0 = cc * 8;
    float w0[8], w1[8], w2[8];
#pragma unroll
    for (int e = 0; e < 8; ++e) { w0[e] = F.conv_w[c0 + e]; w1[e] = F.conv_w[D + c0 + e]; w2[e] = F.conv_w[2 * D + c0 + e]; }
    v4u zm2 = {0u, 0u, 0u, 0u}, zm1 = {0u, 0u, 0u, 0u};
    if ((m0 & (SEQ - 1)) != 0) { zm2 = __builtin_nontemporal_load((const GAS v4u*)(Z + (size_t)(m0 - 2) * 1024 + c0)); zm1 = __builtin_nontemporal_load((const GAS v4u*)(Z + (size_t)(m0 - 1) * 1024 + c0)); }
    bf16* cp0 = Rb + (size_t)(m0 >> 8) * 1048576 + (size_t)(m0 & 255) * 2048 + 1024 + c0;
#pragma unroll
    for (int i0 = 0; i0 < 16; i0 += 8) {
        v4u zz[8], cbv[8];
#pragma unroll
        for (int i = 0; i < 8; ++i) { zz[i] = __builtin_nontemporal_load((const GAS v4u*)(Z + (size_t)(m0 + i0 + i) * 1024 + c0)); cbv[i] = *(const GAS v4u*)(cp0 + (size_t)(i0 + i) * 2048); }
#pragma unroll
        for (int i = 0; i < 8; ++i) { const v4u z0 = zz[i], cb = cbv[i]; v4u o;
#pragma unroll
            for (int j = 0; j < 4; ++j) {
                const float lo = pg8::bflo(cb[j]) * (w0[2 * j] * pg8::bflo(zm2[j]) + w1[2 * j] * pg8::bflo(zm1[j]) + w2[2 * j] * pg8::bflo(z0[j]));
                const float hi = pg8::bfhi(cb[j]) * (w0[2 * j + 1] * pg8::bfhi(zm2[j]) + w1[2 * j + 1] * pg8::bfhi(zm1[j]) + w2[2 * j + 1] * pg8::bfhi(z0[j]));
                o[j] = cvtpk2(lo, hi); }
            *(GAS v4u*)(cp0 + (size_t)(i0 + i) * 2048) = o; zm2 = zm1; zm1 = z0; }
    }
}
__device__ __forceinline__ void p3a_bias2(Frame& F) {
    const int lane_ = pg8::lane_id_v();
    const float* modf = (const float*)(F.ws + WS_MODF); const bf16* W1_t = (const bf16*)(F.ws + WS_W1); float* bias2 = (float*)(F.ws + WS_BIAS2);
    const int gw = F.vcu * NWAVES + F.wave, NGW = F.G * NWAVES;
    if (gw >= FF) return;
    f32x4 sh[4][2][2];
#pragma unroll
    for (int bb = 0; bb < 4; ++bb)
#pragma unroll
        for (int i = 0; i < 2; ++i) { const float* p = modf + bb * NMOD + 3 * D + (lane_ + 64 * i) * 8; sh[bb][i][0] = *(const f32x4*)p; sh[bb][i][1] = *(const f32x4*)(p + 4); }
    for (int f0 = gw; f0 < FF; f0 += 2 * NGW) {
        const int f1 = f0 + NGW; const bool has1 = f1 < FF;
        v4u wv[2][2];
#pragma unroll
        for (int i = 0; i < 2; ++i) { wv[0][i] = *(const GAS v4u*)(W1_t + (size_t)f0 * D + (lane_ + 64 * i) * 8); wv[1][i] = *(const GAS v4u*)(W1_t + (size_t)(has1 ? f1 : f0) * D + (lane_ + 64 * i) * 8); }
        float a[2][4];
#pragma unroll
        for (int rr = 0; rr < 2; ++rr)
#pragma unroll
            for (int bb = 0; bb < 4; ++bb) { float t = 0.f;
#pragma unroll
                for (int i = 0; i < 2; ++i) { const v4u w = wv[rr][i]; const f32x4 s0 = sh[bb][i][0], s1 = sh[bb][i][1];
                    t += pg8::bflo(w[0]) * s0[0] + pg8::bfhi(w[0]) * s0[1] + pg8::bflo(w[1]) * s0[2] + pg8::bfhi(w[1]) * s0[3]
                       + pg8::bflo(w[2]) * s1[0] + pg8::bfhi(w[2]) * s1[1] + pg8::bflo(w[3]) * s1[2] + pg8::bfhi(w[3]) * s1[3]; }
                a[rr][bb] = wave_sum(t); }
        if (lane_ == 0) {
#pragma unroll
            for (int bb = 0; bb < 4; ++bb) { bias2[bb * FF + f0] = a[0][bb]; if (has1) bias2[bb * FF + f1] = a[1][bb]; } }
    }
}
__device__ __forceinline__ void p3b_scan(Frame& F, int bh, int j) {
    const int lane_ = pg8::lane_id_v(), tid_ = F.wave * 64 + lane_;
    const float* KV = (const float*)((unsigned char*)F.out + OUT_KV); bf16* ST = (bf16*)(F.ws + WS_ST);
    const int e = j * 2048 + tid_ * 4; const float g = exp2f(256.0f * log2_gamma(bh & 3));
    f32x4 kv[NJ];
#pragma unroll
    for (int J = 0; J < NJ; ++J) kv[J] = *(const GAS f32x4*)(KV + ((size_t)(bh * NJ + J)) * (DV * DK) + e);
    f32x4 S = {0.f, 0.f, 0.f, 0.f};
#pragma unroll
    for (int J = 0; J < NJ; ++J) { *(GAS unsigned long long*)(ST + ((size_t)(bh * NJ + J)) * (DV * DK) + e) = (unsigned long long)cvtpk2(S[0], S[1]) | ((unsigned long long)cvtpk2(S[2], S[3]) << 32);
        S = S * g + kv[J]; }
}
constexpr int RC_ST = 0, RC_STP = 272, RC_BLK0 = 69632, RC_STG = 528;
__device__ __forceinline__ void p3c_retout(Frame& F, int unit, bf16* OUTP, bool dummy_out) {
    const int lane_ = pg8::lane_id_v(), tid_ = F.wave * 64 + lane_; (void)tid_;
    const int bh = unit >> 4, J = unit & 15, b = bh >> 2, hd = bh & 3;
    const bf16* QK = (const bf16*)(F.ws + WS_QK); const bf16* V = (const bf16*)(F.ws + WS_V); const bf16* ST = (const bf16*)(F.ws + WS_ST) + (size_t)unit * (DV * DK);
    const bf16* Rb = (const bf16*)(F.ws + WS_R);
    const int tid = tid_, lane = lane_, w = F.wave, r = lane & 31, hh = lane >> 5;
    const float l2g = log2_gamma(hd);
    const size_t mbase = (size_t)b * SEQ + (size_t)J * SCH;
    const int krow_ = tid >> 4, kch = tid & 15;
    const bf16* kp = QK + (mbase + krow_) * 1024 + 512 + hd * DK + kch * 8;
    const bf16* vp0 = V + (mbase + (tid >> 5)) * 1024 + hd * DV + (tid & 31) * 8;
    const int kdst = RT_K + (kch >> 2) * 2048 + krow_ * 64 + (kch & 3) * 16;
    const int vdst0 = RT_V + ((tid & 31) >> 2) * 2048 + (tid >> 5) * 64 + (tid & 3) * 16;
    const int lane_off = (4 * hh + ((lane & 15) >> 2)) * 64 + ((lane >> 4) & 1) * 32 + (lane & 3) * 8;
    v4u kreg = *(const GAS v4u*)kp, vreg0 = *(const GAS v4u*)vp0, vreg1 = *(const GAS v4u*)(vp0 + 16 * 1024);
#pragma unroll
    for (int i = 0; i < 8; ++i) { const int idx = tid + 512 * i, row = idx >> 4, ch = idx & 15; *(LAS v4u*)(F.lds + RC_ST + row * RC_STP + ch * 16) = *(const GAS v4u*)(ST + (size_t)row * DK + ch * 8); }
    bf16x8 qf[8];
    { const bf16* qp = QK + (mbase + 32 * w + r) * 1024 + hd * DK + 8 * hh;
#pragma unroll
      for (int ks = 0; ks < 8; ++ks) qf[ks] = *(const GAS bf16x8*)(qp + 16 * ks); }
    f32x16 acc[8];
#pragma unroll
    for (int c8 = 0; c8 < 8; ++c8)
#pragma unroll
        for (int i = 0; i < 16; ++i) acc[c8][i] = 0.f;
    __syncthreads();
#pragma unroll
    for (int c8 = 0; c8 < 8; ++c8)
        {
#pragma unroll
          for (int ks = 0; ks < 8; ++ks) { const bf16x8 sf = *(const LAS bf16x8*)(F.lds + RC_ST + (32 * c8 + r) * RC_STP + (16 * ks + 8 * hh) * 2); acc[c8] = MFMA32(qf[ks], sf, acc[c8]); } __builtin_amdgcn_sched_barrier(0); }
    int t1v = 32 * w + 4 * hh + 1; asm volatile("" : "+v"(t1v));
#pragma unroll
    for (int i = 0; i < 16; ++i) { const float sc = __builtin_amdgcn_exp2f((float)(t1v + (i & 3) + 8 * (i >> 2)) * l2g);
#pragma unroll
        for (int c8 = 0; c8 < 8; ++c8) acc[c8][i] *= sc; }
    const int sbmax = w | 1;
    __syncthreads();
    LAS unsigned char* qsl = F.lds + RC_ST + w * 8192 + lane * 16;
#pragma unroll
    for (int ks = 0; ks < 8; ++ks) *(LAS bf16x8*)(qsl + ks * 1024) = qf[ks];
    for (int sb = 0; sb < 8; ++sb) {
        LAS unsigned char* buf = F.lds + RC_BLK0 + (sb & 1) * RT_BLK;
        *(LAS v4u*)(buf + kdst) = kreg; *(LAS v4u*)(buf + vdst0) = vreg0; *(LAS v4u*)(buf + vdst0 + 16 * 64) = vreg1;
        __syncthreads();
        if (sb < 7) { const size_t o = (size_t)(sb + 1) * 32 * 1024; kreg = *(const GAS v4u*)(kp + o); vreg0 = *(const GAS v4u*)(vp0 + o); vreg1 = *(const GAS v4u*)(vp0 + o + 16 * 1024); }
        if (sb <= sbmax) {
            f32x16 X;
#pragma unroll
            for (int i = 0; i < 16; ++i) X[i] = 0.f;
#pragma unroll
            for (int ks = 0; ks < 8; ++ks) { const bf16x8 kf = *(const LAS bf16x8*)(buf + RT_K + (ks >> 1) * 2048 + r * 64 + (ks & 1) * 32 + hh * 16); const bf16x8 qv = *(const LAS bf16x8*)(qsl + ks * 1024); X = MFMA32(kf, qv, X); }
            int tcv = 32 * w + r - 32 * sb - 4 * hh; asm volatile("" : "+v"(tcv));
#pragma unroll
            for (int i = 0; i < 16; ++i) { const int dt = tcv - ((i & 3) + 8 * (i >> 2)); X[i] *= __builtin_amdgcn_exp2f((float)(dt < 0 ? -dt : dt) * l2g); }
            bf16x8 pa[2];
#pragma unroll
            for (int s2 = 0; s2 < 2; ++s2) { v4u p; p[0] = cvtpk2(X[8 * s2], X[8 * s2 + 1]); p[1] = cvtpk2(X[8 * s2 + 2], X[8 * s2 + 3]); p[2] = cvtpk2(X[8 * s2 + 4], X[8 * s2 + 5]); p[3] = cvtpk2(X[8 * s2 + 6], X[8 * s2 + 7]);
                pa[s2] = __builtin_bit_cast(bf16x8, p); }
#pragma unroll
            for (int c8 = 0; c8 < 8; ++c8)
                {
#pragma unroll
                  for (int s2 = 0; s2 < 2; ++s2) { const bf16x8 bv = tr_frag(buf + RT_V + c8 * 2048 + s2 * 1024 + lane_off); acc[c8] = MFMA32(pa[s2], bv, acc[c8]); } if (c8 & 1) __builtin_amdgcn_sched_barrier(0); }
        }
    }
    __syncthreads();
    LAS unsigned char* stg = F.lds + w * (32 * RC_STG);
    LAS unsigned char* stgl = stg + 4 * hh * RC_STG + 2 * r;
#pragma unroll
    for (int i = 0; i < 16; ++i) {
        float s = 0.f;
#pragma unroll
        for (int c8 = 0; c8 < 8; ++c8) s += acc[c8][i];
        s += __shfl_xor(s, 1); s += __shfl_xor(s, 2); s += __shfl_xor(s, 4); s += __shfl_xor(s, 8); s += __shfl_xor(s, 16);
        const float mu = s * (1.0f / DV); float q = 0.f;
#pragma unroll
        for (int c8 = 0; c8 < 8; ++c8) { const float d = acc[c8][i] - mu; q += d * d; }
        q += __shfl_xor(q, 1); q += __shfl_xor(q, 2); q += __shfl_xor(q, 4); q += __shfl_xor(q, 8); q += __shfl_xor(q, 16);
        const float rs = 1.0f / sqrtf(q * (1.0f / DV) + EPS);
        LAS unsigned short* srow = (LAS unsigned short*)(stgl + ((i & 3) + 8 * (i >> 2)) * RC_STG);
#pragma unroll
        for (int c8 = 0; c8 < 8; ++c8) srow[32 * c8] = (unsigned short)(cvtpk2((acc[c8][i] - mu) * rs, 0.f) & 0xffffu);
    }
    LDS_WAIT(); asm volatile("" ::: "memory");
#pragma unroll 4
    for (int i = 0; i < 16; ++i) { const int idx = lane + 64 * i, row = idx >> 5, ch = idx & 31;
        const v4u y = *(const LAS v4u*)(stg + row * RC_STG + ch * 16);
        const size_t mrow = mbase + 32 * w + row; const bf16* ogp = Rb + (mrow >> 8) * 1048576 + (mrow & 255) * 2048 + hd * DV + ch * 8; const v4u og = *(const GAS v4u*)ogp; bf16* op = OUTP + (dummy_out ? mrow * 1024 : (mrow >> 8) * 1048576 + (mrow & 255) * 2048) + hd * DV + ch * 8;
        const float* gw = F.ret_gn_w + hd * DV + ch * 8; const f32x4 g0 = *(const f32x4*)gw, g1 = *(const f32x4*)(gw + 4); v4u o;
        o[0] = cvtpk2(pg8::bflo(y[0]) * g0[0] * pg8::bflo(og[0]), pg8::bfhi(y[0]) * g0[1] * pg8::bfhi(og[0]));
        o[1] = cvtpk2(pg8::bflo(y[1]) * g0[2] * pg8::bflo(og[1]), pg8::bfhi(y[1]) * g0[3] * pg8::bfhi(og[1]));
        o[2] = cvtpk2(pg8::bflo(y[2]) * g1[0] * pg8::bflo(og[2]), pg8::bfhi(y[2]) * g1[1] * pg8::bfhi(og[2]));
        o[3] = cvtpk2(pg8::bflo(y[3]) * g1[2] * pg8::bflo(og[3]), pg8::bfhi(y[3]) * g1[3] * pg8::bfhi(og[3]));
        *(GAS v4u*)op = o; }
    __syncthreads();
}
__device__ __forceinline__ void p8_final(Frame& F, float* outp) {
    const int lane_ = pg8::lane_id_v(), tid_ = F.wave * 64 + lane_; (void)tid_;
    const float* ssq = (const float*)(F.ws + WS_SSQ3);
    const int gw = F.vcu * NWAVES + F.wave, NGW = F.G * NWAVES;
    f32x4 wv[4];
#pragma unroll
    for (int j = 0; j < 4; ++j) wv[j] = *(const f32x4*)(F.final_norm_w + 4 * lane_ + 256 * j);
    for (int m = gw; m < M; m += NGW) {
        float s = (lane_ < 16) ? ssq[(size_t)m * 16 + lane_] : 0.f; s = wave_sum(s);
        const float rstd = 1.0f / sqrtf(s * (1.0f / D) + EPS);
        const GAS f32x4* xr = (const GAS f32x4*)(F.out + (size_t)m * D) + lane_; GAS f32x4* xo = (GAS f32x4*)(outp + (size_t)m * D) + lane_;
#pragma unroll
        for (int j = 0; j < 4; ++j) { const f32x4 v = xr[64 * j]; xo[64 * j] = v * rstd * wv[j]; }
    }
}

namespace pg8 {
struct EpiRes2Norm {
    static constexpr int EPI_ID = 6;
    static constexpr bool PERM = true, AFTER_DRAIN = true, HAS_MID = false;
    const float* h1; float* out; const float* modf; const float* wf; float* ssq; unsigned* cnt; unsigned* tmo;
    __device__ __forceinline__ void mid(f32x4 (&)[2][2][4][2], const Unit&, int, int, int, int) const {}
    __device__ __forceinline__ void fused(f32x4 (&acc)[2][2][4][2], const Unit& u, int wr, int wc, int fr_, int fq_, PG8_LAS unsigned char* lds, int wid, int lane) const {
        int fr = fr_, fq = fq_; asm volatile("" : "+v"(fr), "+v"(fq));
        const int rl0 = wr * 64 + fr, row0 = u.pm * BM + rl0, col0 = u.pn * BM + wc * 32 + 8 * fq, b = u.pm >> 4;
        PG8_LAS float* P = (PG8_LAS float*)lds;
        { f32x4 g2[2][2];
#pragma unroll
          for (int bj = 0; bj < 2; ++bj)
#pragma unroll
            for (int n = 0; n < 2; ++n) g2[bj][n] = *(const f32x4*)(modf + b * 6144 + 5120 + col0 + bj * HALF + 4 * n);
#pragma unroll
          for (int ai = 0; ai < 2; ++ai)
#pragma unroll
            for (int m = 0; m < 4; ++m) { const size_t off = (size_t)(row0 + ai * HALF + m * 16) * 1024 + col0; float q = 0.f;
#pragma unroll
                for (int bj = 0; bj < 2; ++bj) { const f32x4 x0 = *(const f32x4*)(h1 + off + bj * HALF), x1 = *(const f32x4*)(h1 + off + bj * HALF + 4);
                    const f32x4 h0 = x0 + g2[bj][0] * acc[ai][bj][m][0], hb = x1 + g2[bj][1] * acc[ai][bj][m][1];
                    acc[ai][bj][m][0] = h0; acc[ai][bj][m][1] = hb;
                    q += (h0[0] * h0[0] + h0[1] * h0[1]) + (h0[2] * h0[2] + h0[3] * h0[3]) + (hb[0] * hb[0] + hb[1] * hb[1]) + (hb[2] * hb[2] + hb[3] * hb[3]); }
                q += __shfl_xor(q, 16); q += __shfl_xor(q, 32);
                if (fq == 0) P[(rl0 + ai * HALF + m * 16) * 4 + wc] = q; } }
        asm volatile("s_waitcnt lgkmcnt(0)" ::: "memory"); __builtin_amdgcn_s_barrier(); asm volatile("" ::: "memory");
        { const int t = wid * 64 + lane; if (t < 256) { const f32x4 p = *(const PG8_LAS f32x4*)(P + t * 4); ssq[(size_t)(u.pm * BM + t) * 4 + u.pn] = (p[0] + p[1]) + (p[2] + p[3]); } }
        group_sync(cnt, 4u, tmo, wid);
        f32x4 wv[2][2];
#pragma unroll
        for (int bj = 0; bj < 2; ++bj)
#pragma unroll
            for (int n = 0; n < 2; ++n) wv[bj][n] = *(const f32x4*)(wf + col0 + bj * HALF + 4 * n);
#pragma unroll
        for (int ai = 0; ai < 2; ++ai)
#pragma unroll
            for (int m = 0; m < 4; ++m) { const int row = row0 + ai * HALF + m * 16; const f32x4 p = *(const f32x4*)(ssq + (size_t)row * 4);
                const float rs = 1.0f / sqrtf(((p[0] + p[1]) + (p[2] + p[3])) * (1.0f / 1024.0f) + 1e-6f); const size_t off = (size_t)row * 1024 + col0;
#pragma unroll
                for (int bj = 0; bj < 2; ++bj) { *(f32x4*)(out + off + bj * HALF) = acc[ai][bj][m][0] * rs * wv[bj][0]; *(f32x4*)(out + off + bj * HALF + 4) = acc[ai][bj][m][1] * rs * wv[bj][1]; } }
    }
};
}

#ifndef FF1_ALIGN
#define FF1_ALIGN true
#endif
#ifndef G1_ALIGN
#define G1_ALIGN true
#endif
#ifndef G1_SP2
#define G1_SP2 true
#endif
constexpr int N_PHASES = 10;
struct Args { const void* in[16]; float* out; unsigned char* ws; int ph_lo, ph_hi, use_bar, pad; };
__global__ void __launch_bounds__(NWAVES * 64, 2) hyb_fwd(Args args) {
    extern __shared__ __attribute__((aligned(16))) unsigned char lds[];
    Frame F;
    F.lds = (LAS unsigned char*)lds; F.MISC = (volatile LAS unsigned*)(F.lds + MISC_OFF);
    F.wave = __builtin_amdgcn_readfirstlane((int)threadIdx.x >> 6);
    F.G = gridDim.x; { const int bx = blockIdx.x; F.vcu = (F.G % 8 == 0) ? (bx % 8) * (F.G / 8) + bx / 8 : bx; }
    F.ws = args.ws; F.out = args.out; F.ctl = (gu32*)(args.ws + WS_CTL);
    F.x = (const float*)args.in[0]; F.c = (const float*)args.in[1]; F.positions = (const int*)args.in[2]; F.w_ada = (const float*)args.in[3]; F.b_ada = (const float*)args.in[4];
    F.norm1_w = (const float*)args.in[5]; F.w_in = (const float*)args.in[6]; F.ret_gn_w = (const float*)args.in[7]; F.conv_w = (const float*)args.in[8]; F.w_ret_out = (const float*)args.in[9];
    F.w_conv_out = (const float*)args.in[10]; F.w_o = (const float*)args.in[11]; F.norm2_w = (const float*)args.in[12]; F.w_ff1 = (const float*)args.in[13]; F.w_ff2 = (const float*)args.in[14];
    F.final_norm_w = (const float*)args.in[15];
    for (int u = F.wave * 64 + pg8::lane_id_v(); u < (LDS_BYTES - LDSCTL_OFF) / 4; u += NWAVES * 64) ((LAS unsigned*)(F.lds + LDSCTL_OFF))[u] = 0u;
    __syncthreads();
    XcdBarrier bar; bar.bar = (unsigned*)(F.ctl + CW_BAR); bar.x = 0; bar.st = nullptr;
    if (args.use_bar) bar = xcd_barrier_post((unsigned*)(F.ctl + CW_BAR), F.MISC + 8, F.wave);
    const int lo = args.ph_lo, hi = args.ph_hi;
#ifndef PH_MASK
#define PH_MASK 0x7ff
#endif
#define IN(k) (((PH_MASK >> (k)) & 1) && lo <= (k) && (k) < hi)
#ifndef PH_TWICE
#define PH_TWICE 0
#endif
#define REP(k) for (int rep_ = 0; rep_ < (((PH_TWICE >> (k)) & 1) ? 2 : 1); ++rep_)
#ifdef PH_TA
    unsigned long long ta_ = __builtin_amdgcn_s_memrealtime(), tb_ = ta_;
#define STAMP(id) do { if ((id) == PH_TA) ta_ = __builtin_amdgcn_s_memrealtime(); if ((id) == PH_TB) tb_ = __builtin_amdgcn_s_memrealtime(); } while (0)
#else
#define STAMP(id) do { } while (0)
#endif
#define GSYNC(stage) group_sync((unsigned*)(F.ctl + CW_GRP + ((stage) * 64 + gpm_) * 64), 4u, (unsigned*)(F.ctl + CW_BAR + XB_TMO), F.wave)
#define SEAM(k) do { STAMP(2 * (k)); if (IN(k) && IN((k) + 1)) xcd_barrier(bar, F.wave); STAMP(2 * (k) + 1); } while (0)
    unsigned char* ws = args.ws;
    bf16* U = (bf16*)((unsigned char*)args.out + OUT_U);

#ifdef PH_MAXP0
    const unsigned long long tk0_ = __builtin_amdgcn_s_memrealtime();
    if (IN(0)) { p0_prologue(F); }
    if (F.wave == 0 && pg8::lane_id_v() == 0) __hip_atomic_store((unsigned*)(F.ctl + 16384 + blockIdx.x), (unsigned)(__builtin_amdgcn_s_memrealtime() - tk0_), __ATOMIC_RELAXED, __HIP_MEMORY_SCOPE_AGENT);
    SEAM(0);
    unsigned mx_ = 0, amx_ = 0;
    if (blockIdx.x == 0 && F.wave == 0) { for (int i = 0; i < (int)gridDim.x; ++i) { const unsigned v = __hip_atomic_load((unsigned*)(F.ctl + 16384 + i), __ATOMIC_RELAXED, __HIP_MEMORY_SCOPE_AGENT); if (v > mx_) { mx_ = v; amx_ = i; } } }
#else
    if (IN(0)) REP(0) { p0_prologue(F); } SEAM(0);
#endif
    if (IN(1)) REP(1) { p1_unorm(F); } SEAM(1);
    if (IN(2)) REP(2) {
        pg8::Gemm g{U, (const bf16*)(ws + WS_WIN), M, NPROJ, D, (size_t)256 * D * 2}; pg8::StaticOrder S; S.init(M, NPROJ, F.G, (int)blockIdx.x);
        pg8::EpiProj E{(bf16*)(ws + WS_QK), (bf16*)(ws + WS_V), (bf16*)(ws + WS_R), (bf16*)((unsigned char*)args.out + OUT_Z), F.positions};
        pg8::gemm_phase<pg8::EpiProj, pg8::StaticOrder, G1_ALIGN, G1_SP2>(F.lds + RING_OFF, g, S, E, F.wave);
    } SEAM(2);
    if (IN(3)) {
        const int bh_ = F.vcu >> 4; unsigned* tmo_ = (unsigned*)(F.ctl + CW_BAR + XB_TMO);
        REP(3) { p3a_kvsum(F, F.vcu); } STAMP(30);
        p3a_conv(F, F.vcu); STAMP(31); REP(11) { p3a_bias2(F); }
        STAMP(6); group_sync((unsigned*)(F.ctl + CW_GRP + (4 * 64 + bh_) * 64), 16u, tmo_, F.wave); STAMP(7);
        p3b_scan(F, bh_, F.vcu & 15);
        STAMP(8); group_sync((unsigned*)(F.ctl + CW_GRP + (5 * 64 + bh_) * 64), 16u, tmo_, F.wave); STAMP(9);
        REP(5) { const bool dummy = ((PH_TWICE >> 5) & 1) && rep_ == 0; p3c_retout(F, F.vcu, dummy ? (bf16*)((unsigned char*)args.out + OUT_Z) : (bf16*)(ws + WS_R), dummy); }
    } if (IN(3) && IN(6)) { STAMP(10); xcd_barrier(bar, F.wave); STAMP(11); }
    int gpm_ = 0; { pg8::StaticOrder S; S.init(M, D, F.G, (int)blockIdx.x); pg8::Unit u0; if (S.next(0, u0)) gpm_ = u0.pm; }
#ifdef PH_STAG
    if (IN(6)) { const unsigned long long t0s_ = __builtin_amdgcn_s_memrealtime(), ds_ = (unsigned long long)((gpm_ % PH_STAG_S) * PH_STAG); while (__builtin_amdgcn_s_memrealtime() - t0s_ < ds_) __builtin_amdgcn_s_sleep(4); }
#endif
    if (IN(6)) REP(6) {
        pg8::Gemm g{(const bf16*)(ws + WS_R), (const bf16*)(ws + WS_WRC), M, D, 2 * D, (size_t)2 * MiB}; pg8::StaticOrder S; S.init(M, D, F.G, (int)blockIdx.x);
        pg8::EpiMerge E{(const bf16*)(ws + WS_R), (bf16*)(ws + WS_MERGED)};
        pg8::gemm_phase<pg8::EpiMerge, pg8::StaticOrder, false, true>(F.lds + RING_OFF, g, S, E, F.wave);
    } if (IN(6) && IN(7)) { STAMP(12); GSYNC(0); STAMP(13); }
    if (IN(7)) REP(7) {
        pg8::Gemm g{(const bf16*)(ws + WS_MERGED), (const bf16*)(ws + WS_WO), M, D, D, (size_t)256 * D * 2}; pg8::StaticOrder S; S.init(M, D, F.G, (int)blockIdx.x);
        pg8::EpiRes1 E{F.x, args.out, (bf16*)(ws + WS_HHAT), (const float*)(ws + WS_MODF), F.norm2_w, (float*)(ws + WS_SSQ2)};
        pg8::gemm_phase<pg8::EpiRes1, pg8::StaticOrder, false, true>(F.lds + RING_OFF, g, S, E, F.wave);
    } if (IN(7) && IN(8)) { STAMP(14); GSYNC(1); STAMP(15); }
    if (IN(8)) REP(8) {
        pg8::Gemm g{(const bf16*)(ws + WS_HHAT), (const bf16*)(ws + WS_W1), M, FF, D, (size_t)256 * D * 2}; pg8::StaticOrder S; S.init(M, FF, F.G, (int)blockIdx.x);
        pg8::Unit u0; LAS float* tab = (LAS float*)(F.lds + TAB_OFF); const int tid_ = F.wave * 64 + pg8::lane_id_v();
        if (S.next(0, u0)) { if (tid_ < 256) { const float* sq = (const float*)(ws + WS_SSQ2) + (size_t)(u0.pm * 256 + tid_) * 16; const f32x4 a = *(const f32x4*)sq, b = *(const f32x4*)(sq + 4), c = *(const f32x4*)(sq + 8), d = *(const f32x4*)(sq + 12);
            const float s = ((a[0] + a[1]) + (a[2] + a[3])) + ((b[0] + b[1]) + (b[2] + b[3])) + ((c[0] + c[1]) + (c[2] + c[3])) + ((d[0] + d[1]) + (d[2] + d[3]));
            tab[tid_] = 1.0f / sqrtf(s * (1.0f / D) + EPS); } }
        __syncthreads();
        pg8::EpiFF1 E{(const float*)(ws + WS_BIAS2), (const LAS float*)tab, (bf16*)(ws + WS_HID)};
        pg8::gemm_phase<pg8::EpiFF1, pg8::StaticOrder, FF1_ALIGN, true>(F.lds + RING_OFF, g, S, E, F.wave);
    } if (IN(8) && IN(9)) { STAMP(16); GSYNC(2); STAMP(17); }
    if (IN(9)) {
        pg8::Gemm g{(const bf16*)(ws + WS_HID), (const bf16*)(ws + WS_W2), M, D, FF, (size_t)256 * FF * 2}; pg8::StaticOrder S; S.init(M, D, F.G, (int)blockIdx.x);
        pg8::EpiRes2Norm E{args.out, args.out, (const float*)(ws + WS_MODF), F.final_norm_w, (float*)(ws + WS_SSQ3), (unsigned*)(F.ctl + CW_GRP + (3 * 64 + gpm_) * 64), (unsigned*)(F.ctl + CW_BAR + XB_TMO)};
        pg8::gemm_phase<pg8::EpiRes2Norm, pg8::StaticOrder, false, true>(F.lds + RING_OFF, g, S, E, F.wave);
    }
    STAMP(18); STAMP(19);
#ifdef PH_MAXP0
    if (blockIdx.x == 0 && F.wave == 0) { const unsigned long long te = __builtin_amdgcn_s_memrealtime(), d = (PH_MAXP0 == 1) ? (unsigned long long)mx_ * 4ull : (unsigned long long)amx_ * 100ull; while (__builtin_amdgcn_s_memrealtime() - te < d) __builtin_amdgcn_s_sleep(8); }
#endif
#ifdef PH_TA
    STAMP(20); STAMP(21);
    if ((int)blockIdx.x == PH_BLK && F.wave == 0) { const unsigned long long te = __builtin_amdgcn_s_memrealtime(), d = (tb_ - ta_) * 4ull; while (__builtin_amdgcn_s_memrealtime() - te < d) __builtin_amdgcn_s_sleep(8); }
#endif
#undef IN
#undef SEAM
}

#ifndef HYB_N_LAUNCHES
#define HYB_N_LAUNCHES 1
#endif
extern "C" void kernel_launch(void* const* d_in, const int* in_sizes, int n_in, void* d_out, int out_size, void* d_ws, size_t ws_size, hipStream_t stream) {
    static int grid = 0;
    if (grid == 0) {
        if (n_in != 16 || in_sizes[0] != M * D || out_size != M * D || ws_size < WS_END) { fprintf(stderr, "kernel_launch: unexpected shapes (n_in %d, in0 %d, out %d, ws %zu); nothing launched\n", n_in, n_in > 0 ? in_sizes[0] : -1, out_size, ws_size); grid = -1; return; }
        int dev = 0, cus = 0, per_cu = 0;
        if (hipGetDevice(&dev) != hipSuccess || hipDeviceGetAttribute(&cus, hipDeviceAttributeMultiprocessorCount, dev) != hipSuccess) { grid = -1; return; }
        if (hipFuncSetAttribute((const void*)hyb_fwd, hipFuncAttributeMaxDynamicSharedMemorySize, LDS_BYTES) != hipSuccess) { fprintf(stderr, "kernel_launch: hipFuncSetAttribute failed\n"); grid = -1; return; }
        if (hipOccupancyMaxActiveBlocksPerMultiprocessor(&per_cu, (const void*)hyb_fwd, NWAVES * 64, LDS_BYTES) != hipSuccess || per_cu < 1) { fprintf(stderr, "kernel_launch: occupancy query says %d workgroups per CU; nothing launched\n", per_cu); (void)hipGetLastError(); grid = -1; return; }
        { bool okp = true; pg8::StaticOrder S; for (int c = 0; c < cus && okp; ++c) { S.init(M, FF, cus, c); pg8::Unit u0, u; if (!S.next(0, u0)) continue; for (int i = 1; S.next(i, u); ++i) okp = okp && (u.pm == u0.pm); }
          if (!okp) { fprintf(stderr, "kernel_launch: FF1's unit order does not keep a workgroup inside one row panel on %d CUs; nothing launched\n", cus); grid = -1; return; } }
        { bool okp = true; pg8::StaticOrder S1, S4; for (int c = 0; c < cus && okp; ++c) { S1.init(M, D, cus, c); S4.init(M, FF, cus, c); pg8::Unit a, b2; okp = S1.next(0, a) && S4.next(0, b2) && a.pm == b2.pm && !S1.next(1, b2); }
          if (!okp || cus != 256) { fprintf(stderr, "kernel_launch: the row-panel chain needs 256 CUs with one N=1024 unit each in the panel of their FF1 units; nothing launched\n"); grid = -1; return; } }
        grid = cus;
        if (grid != 256) fprintf(stderr, "kernel_launch: %d CUs (built for 256)\n", grid);
    }
    if (grid < 0) return;
    (void)hipMemsetAsync((char*)d_ws + WS_CTL, 0, CTL_ZERO_BYTES, stream);
    Args a{};
    for (int i = 0; i < 16; ++i) a.in[i] = d_in[i];
    a.out = (float*)d_out; a.ws = (unsigned char*)d_ws;
#if HYB_N_LAUNCHES == 1
    a.ph_lo = 0; a.ph_hi = N_PHASES; a.use_bar = 1;
    hipLaunchKernelGGL(hyb_fwd, dim3(grid), dim3(NWAVES * 64), LDS_BYTES, stream, a);
#ifdef PH_WHOLE2
    (void)hipMemsetAsync((char*)d_ws + WS_CTL, 0, CTL_ZERO_BYTES, stream);
    hipLaunchKernelGGL(hyb_fwd, dim3(grid), dim3(NWAVES * 64), LDS_BYTES, stream, a);
#endif
#else
    for (int p = 0; p < N_PHASES; ++p) { a.ph_lo = p; a.ph_hi = p + 1; a.use_bar = 0; hipLaunchKernelGGL(hyb_fwd, dim3(grid), dim3(NWAVES * 64), LDS_BYTES, stream, a); }
#endif
}
```

```cpp
#include <hip/hip_runtime.h>
#include <cstdio>
#include <cstdint>
namespace pg8 {
#define PG8_LAS __attribute__((address_space(3)))
typedef unsigned short bf16_t;
typedef short bf16x8 __attribute__((ext_vector_type(8)));
typedef float f32x4 __attribute__((ext_vector_type(4)));
typedef unsigned u32x4 __attribute__((ext_vector_type(4)));
constexpr int BM = 256, BK = 64, HALF = 128, HTB = HALF * BK * 2  , STAGE_BYTES = 8 * HTB, NXCD = 8, WGM = 8;

__host__ __device__ __forceinline__ int lds_byte(int r, int c) { const int st = (r >> 4) * 2 + (c >> 5), rr = r & 15, cc = c & 31, ob = rr * 64 + cc * 2; return st * 1024 + (ob ^ (((ob >> 9) & 1) << 5)); }
__host__ __device__ __forceinline__ void stage_rc(int b, int& R, int& C) { const int st = b / 1024, sb = b % 1024, swz = sb ^ (((sb >> 9) & 1) << 5); R = (st >> 1) * 16 + swz / 64; C = (st & 1) * 32 + (swz % 64) / 2; }
__host__ __device__ __forceinline__ int perm32(int rho) { const int n = rho >> 4, i = rho & 15; return 8 * (i >> 2) + 4 * n + (i & 3); }

struct Unit { int pm, pn; };
struct Gemm { const bf16_t* A; const bf16_t* Bt; int M, N, K; size_t a_pstride; };

struct StaticOrder {
    int nM, nN, nwg, G, c;
    __host__ __device__ void init(int M, int N, int G_, int c_) { nM = M / BM; nN = N / BM; nwg = nM * nN; G = G_; c = c_; }
    __host__ __device__ bool next(int i, Unit& u) const {
        const long L = (long)i * G + c; if (L >= nwg) return false;
        int wgid = (int)L; { const int q = nwg / NXCD, r = nwg % NXCD, xcd = wgid % NXCD, off = wgid / NXCD; wgid = (xcd < r ? xcd * (q + 1) : r * (q + 1) + (xcd - r) * q) + off; }
        const int nig = WGM * nN, gid = wgid / nig, fm = gid * WGM, gsz = (nM - fm) < WGM ? (nM - fm) : WGM;
        u.pm = fm + ((wgid % nig) % gsz); u.pn = (wgid % nig) / gsz; return true;
    }
    __device__ __forceinline__ void a_ready(const Unit&) const {}
    __device__ __forceinline__ void done(const Unit&) const {}
};

__device__ __forceinline__ unsigned cvt_pk_bf16(float lo, float hi) { unsigned r; asm volatile("v_cvt_pk_bf16_f32 %0, %1, %2" : "=v"(r) : "v"(lo), "v"(hi)); return r; }
typedef float f32x2 __attribute__((ext_vector_type(2)));
__device__ __forceinline__ int lane_id_v() { int l; asm volatile("v_mbcnt_lo_u32_b32 %0, -1, 0\n\tv_mbcnt_hi_u32_b32 %0, -1, %0" : "=v"(l)); return l; }
typedef unsigned u32x2 __attribute__((ext_vector_type(2)));
__device__ __forceinline__ unsigned cvtpk(float lo, float hi) { typedef float f2_t __attribute__((ext_vector_type(2))); typedef __bf16 b2_t __attribute__((ext_vector_type(2))); f2_t v = {lo, hi}; b2_t b = __builtin_convertvector(v, b2_t); return __builtin_bit_cast(unsigned, b); }
__device__ __forceinline__ float bflo(unsigned w) { return __builtin_bit_cast(float, w << 16); }
__device__ __forceinline__ float bfhi(unsigned w) { return __builtin_bit_cast(float, w & 0xffff0000u); }
__device__ __forceinline__ float fast_rcp(float x) { return __builtin_amdgcn_rcpf(x); }
__device__ __forceinline__ float sigmoidf_(float x) { return fast_rcp(1.0f + __expf(-x)); }
__device__ __forceinline__ void sincos_rev(float ang, float& s, float& c) {
    const float I2P = 0.15915493667125702f, I2P_LO = 6.420638326565253e-09f;
    const float r = ang * I2P; float e = __builtin_fmaf(ang, I2P, -r); e = __builtin_fmaf(ang, I2P_LO, e);
    const float k = __builtin_rintf(r); const float f = (r - k) + e;
    s = __builtin_amdgcn_sinf(f); c = __builtin_amdgcn_cosf(f);
}
__device__ __forceinline__ u32x4 pack8(const f32x4 a, const f32x4 b) { u32x4 w; w.x = cvtpk(a[0], a[1]); w.y = cvtpk(a[2], a[3]); w.z = cvtpk(b[0], b[1]); w.w = cvtpk(b[2], b[3]); return w; }

struct EpiProj {
    static constexpr int EPI_ID = 1;
    static constexpr bool PERM = true, AFTER_DRAIN = false, HAS_MID = false;
    bf16_t* QK; bf16_t* V; bf16_t* R; bf16_t* Z; const int* pos;
    __device__ __forceinline__ void mid(f32x4 (&)[2][2][4][2], const Unit&, int, int, int, int) const {}
    __device__ __forceinline__ void operator()(const f32x4 (&acc)[2][2][4][2], const Unit& u, int wr, int wc, int fr, int fq) const {
        const int row0 = u.pm * BM + wr * 64 + fr, cw = wc * 32 + 8 * fq, pn = u.pn;
        if (pn < 4) {
            const float ksc = pn >= 2 ? 0.08838834764831845f : 1.0f;
            const int g = 4 * wc + fq; float invf[4];
#pragma unroll
            for (int i = 0; i < 4; ++i) invf[i] = exp2f(-(float)(4 * g + i) * (13.287712379549449f / 64.0f));
#pragma unroll
            for (int ai = 0; ai < 2; ++ai)
#pragma unroll
                for (int m = 0; m < 4; ++m) { const int row = row0 + ai * HALF + m * 16; const float p = (float)pos[row];
                    f32x4 cs, sn;
#pragma unroll
                    for (int i = 0; i < 4; ++i) { float s_, c_; sincos_rev(p * invf[i], s_, c_); cs[i] = c_ * ksc; sn[i] = s_ * ksc; }
                    bf16_t* rowp = QK + (size_t)row * 1024 + pn * 256 + cw;
#pragma unroll
                    for (int bj = 0; bj < 2; ++bj) { const f32x4 x1 = acc[ai][bj][m][0], x2 = acc[ai][bj][m][1];
                        const f32x4 o1 = x1 * cs - x2 * sn, o2 = x1 * sn + x2 * cs;
                        *(u32x4*)(rowp + bj * HALF) = pack8(o1, o2); } }
        } else if (pn >= 16 && pn < 24) {
#pragma unroll
            for (int ai = 0; ai < 2; ++ai)
#pragma unroll
                for (int m = 0; m < 4; ++m) { const int row = row0 + ai * HALF + m * 16; bf16_t* rowp = Z + (size_t)row * 1024 + (((pn - 16) * 256 + cw) >> 1);
#pragma unroll
                    for (int bj = 0; bj < 2; ++bj) { const f32x4 z = acc[ai][bj][m][0] * acc[ai][bj][m][1]; u32x2 w; w.x = cvtpk(z[0], z[1]); w.y = cvtpk(z[2], z[3]);
                        *(u32x2*)(rowp + bj * (HALF / 2)) = w; } }
        } else {
            bf16_t* base; int ld, mode;
            if (pn < 8) { base = V + (size_t)u.pm * BM * 1024 + (pn - 4) * 256; ld = 1024; mode = 0; }
            else if (pn < 12) { base = R + (size_t)u.pm * 1048576 + (pn - 8) * 256; ld = 2048; mode = 1; }
            else if (pn < 16) { base = R + (size_t)u.pm * 1048576 + 1024 + (pn - 12) * 256; ld = 2048; mode = 0; }
            else { base = R + (size_t)u.pm * 1048576 + 524288 + (pn - 24) * 256; ld = 2048; mode = 2; }
            const int rl0 = wr * 64 + fr;
#pragma unroll
            for (int ai = 0; ai < 2; ++ai)
#pragma unroll
                for (int m = 0; m < 4; ++m) { const int rl = rl0 + ai * HALF + m * 16; bf16_t* rowp = base + (size_t)rl * ld + cw;
#pragma unroll
                    for (int bj = 0; bj < 2; ++bj) { f32x4 v0 = acc[ai][bj][m][0], v1 = acc[ai][bj][m][1];
                        if (mode != 0) {
#pragma unroll
                            for (int i = 0; i < 4; ++i) { const float s0 = sigmoidf_(v0[i]), s1 = sigmoidf_(v1[i]); v0[i] = mode == 1 ? v0[i] * s0 : s0; v1[i] = mode == 1 ? v1[i] * s1 : s1; } }
                        *(u32x4*)(rowp + bj * HALF) = pack8(v0, v1); } }
        }
    }
};

struct EpiMerge {
    static constexpr int EPI_ID = 2;
    static constexpr bool PERM = true, AFTER_DRAIN = false, HAS_MID = true;
    const bf16_t* R; bf16_t* MERGED;
    __device__ __forceinline__ void mid(f32x4 (&acc)[2][2][4][2], const Unit& u, int wr, int wc, int fr, int fq) const {
        const int rl0 = wr * 64 + fr, col0 = u.pn * BM + wc * 32 + 8 * fq; const bf16_t* G = R + (size_t)u.pm * 1048576 + 524288;
#pragma unroll
        for (int ai = 0; ai < 2; ++ai)
#pragma unroll
            for (int m = 0; m < 4; ++m) { const bf16_t* rowp = G + (size_t)(rl0 + ai * HALF + m * 16) * 2048 + col0;
#pragma unroll
                for (int bj = 0; bj < 2; ++bj) { const u32x4 ga = *(const u32x4*)(rowp + bj * HALF), gb = *(const u32x4*)(rowp + 1024 + bj * HALF);
#pragma unroll
                    for (int j = 0; j < 4; ++j) { const float a0 = bflo(ga[j]), a1 = bfhi(ga[j]); const float b0 = fmaxf(bflo(gb[j]), 1e-30f), b1 = fmaxf(bfhi(gb[j]), 1e-30f);
                        acc[ai][bj][m][j >> 1][2 * (j & 1)] *= a0 * fast_rcp(b0); acc[ai][bj][m][j >> 1][2 * (j & 1) + 1] *= a1 * fast_rcp(b1); } } }
    }
    __device__ __forceinline__ void operator()(const f32x4 (&acc)[2][2][4][2], const Unit& u, int wr, int wc, int fr, int fq) const {
        const int row0 = u.pm * BM + wr * 64 + fr, col0 = u.pn * BM + wc * 32 + 8 * fq;
#pragma unroll
        for (int ai = 0; ai < 2; ++ai)
#pragma unroll
            for (int m = 0; m < 4; ++m) { const int row = row0 + ai * HALF + m * 16; const bf16_t* gp = R + (size_t)u.pm * 1048576 + 524288 + (size_t)(row - u.pm * BM) * 2048 + 1024 + col0; bf16_t* op = MERGED + (size_t)row * 1024 + col0;
#pragma unroll
                for (int bj = 0; bj < 2; ++bj) { const u32x4 gb = *(const u32x4*)(gp + bj * HALF); f32x4 v0 = acc[ai][bj][m][0], v1 = acc[ai][bj][m][1];
                    v0[0] *= fmaxf(bflo(gb[0]), 1e-30f); v0[1] *= fmaxf(bfhi(gb[0]), 1e-30f); v0[2] *= fmaxf(bflo(gb[1]), 1e-30f); v0[3] *= fmaxf(bfhi(gb[1]), 1e-30f);
                    v1[0] *= fmaxf(bflo(gb[2]), 1e-30f); v1[1] *= fmaxf(bfhi(gb[2]), 1e-30f); v1[2] *= fmaxf(bflo(gb[3]), 1e-30f); v1[3] *= fmaxf(bfhi(gb[3]), 1e-30f);
                    *(u32x4*)(op + bj * HALF) = pack8(v0, v1); } }
    }
};

struct EpiRes1 {
    static constexpr int EPI_ID = 3;
    static constexpr bool PERM = true, AFTER_DRAIN = false, HAS_MID = false;
    const float* x; float* h1; bf16_t* hhat; const float* modf; const float* norm2w; float* ssq;
    __device__ __forceinline__ void mid(f32x4 (&)[2][2][4][2], const Unit&, int, int, int, int) const {}
    __device__ __forceinline__ void operator()(const f32x4 (&acc)[2][2][4][2], const Unit& u, int wr, int wc, int fr, int fq) const {
        const int row0 = u.pm * BM + wr * 64 + fr, col0 = u.pn * BM + wc * 32 + 8 * fq, b = u.pm >> 4;
        f32x4 g1[2][2], cs[2][2];
#pragma unroll
        for (int bj = 0; bj < 2; ++bj)
#pragma unroll
            for (int n = 0; n < 2; ++n) { const int c = col0 + bj * HALF + 4 * n; g1[bj][n] = *(const f32x4*)(modf + b * 6144 + 2048 + c);
                const f32x4 sc = *(const f32x4*)(modf + b * 6144 + 4096 + c), w = *(const f32x4*)(norm2w + c); cs[bj][n] = w * (sc + 1.0f); }
#pragma unroll
        for (int ai = 0; ai < 2; ++ai)
#pragma unroll
            for (int m = 0; m < 4; ++m) { const int row = row0 + ai * HALF + m * 16; const size_t off = (size_t)row * 1024 + col0; float q = 0.f;
#pragma unroll
                for (int bj = 0; bj < 2; ++bj) { const f32x4 x0 = *(const f32x4*)(x + off + bj * HALF), x1 = *(const f32x4*)(x + off + bj * HALF + 4);
                    const f32x4 h0 = x0 + g1[bj][0] * acc[ai][bj][m][0], hb = x1 + g1[bj][1] * acc[ai][bj][m][1];
                    *(f32x4*)(h1 + off + bj * HALF) = h0; *(f32x4*)(h1 + off + bj * HALF + 4) = hb;
                    q += (h0[0] * h0[0] + h0[1] * h0[1]) + (h0[2] * h0[2] + h0[3] * h0[3]) + (hb[0] * hb[0] + hb[1] * hb[1]) + (hb[2] * hb[2] + hb[3] * hb[3]);
                    *(u32x4*)(hhat + off + bj * HALF) = pack8(h0 * cs[bj][0], hb * cs[bj][1]); }
                q += __shfl_xor(q, 16); q += __shfl_xor(q, 32);
                if (fq == 0) ssq[(size_t)row * 16 + u.pn * 4 + wc] = q; }
    }
};

struct EpiFF1 {
    static constexpr int EPI_ID = 4;
    static constexpr bool PERM = true, AFTER_DRAIN = false, HAS_MID = false;
    const float* bias2; const PG8_LAS float* rstd; bf16_t* HID;
    __device__ __forceinline__ void mid(f32x4 (&)[2][2][4][2], const Unit&, int, int, int, int) const {}
    __device__ __forceinline__ void operator()(const f32x4 (&acc)[2][2][4][2], const Unit& u, int wr, int wc, int fr, int fq) const {
        const int rl0 = wr * 64 + fr, col0 = u.pn * BM + wc * 32 + 8 * fq, b = u.pm >> 4;
        f32x4 bv[2][2];
#pragma unroll
        for (int bj = 0; bj < 2; ++bj)
#pragma unroll
            for (int n = 0; n < 2; ++n) bv[bj][n] = *(const f32x4*)(bias2 + b * 4096 + col0 + bj * HALF + 4 * n);
#pragma unroll
        for (int ai = 0; ai < 2; ++ai)
#pragma unroll
            for (int m = 0; m < 4; ++m) { const int rl = rl0 + ai * HALF + m * 16; const float rs = rstd[rl]; bf16_t* op = HID + (size_t)(u.pm * BM + rl) * 4096 + col0;
#pragma unroll
                for (int bj = 0; bj < 2; ++bj) { f32x4 v0 = acc[ai][bj][m][0] * rs + bv[bj][0], v1 = acc[ai][bj][m][1] * rs + bv[bj][1];
#pragma unroll
                    for (int i = 0; i < 4; ++i) { const float a = fmaxf(v0[i], 0.f), c = fmaxf(v1[i], 0.f); v0[i] = a * a; v1[i] = c * c; }
                    *(u32x4*)(op + bj * HALF) = pack8(v0, v1); } }
    }
};

struct EpiRes2 {
    static constexpr int EPI_ID = 5;
    static constexpr bool PERM = true, AFTER_DRAIN = false, HAS_MID = false;
    const float* h; float* ho; const float* modf; float* ssq;
    __device__ __forceinline__ void mid(f32x4 (&)[2][2][4][2], const Unit&, int, int, int, int) const {}
    __device__ __forceinline__ void operator()(const f32x4 (&acc)[2][2][4][2], const Unit& u, int wr, int wc, int fr, int fq) const {
        const int row0 = u.pm * BM + wr * 64 + fr, col0 = u.pn * BM + wc * 32 + 8 * fq, b = u.pm >> 4;
        f32x4 g2[2][2];
#pragma unroll
        for (int bj = 0; bj < 2; ++bj)
#pragma unroll
            for (int n = 0; n < 2; ++n) g2[bj][n] = *(const f32x4*)(modf + b * 6144 + 5120 + col0 + bj * HALF + 4 * n);
#pragma unroll
        for (int ai = 0; ai < 2; ++ai)
#pragma unroll
            for (int m = 0; m < 4; ++m) { const int row = row0 + ai * HALF + m * 16; const size_t off = (size_t)row * 1024 + col0; float q = 0.f;
#pragma unroll
                for (int bj = 0; bj < 2; ++bj) { const f32x4 x0 = *(const f32x4*)(h + off + bj * HALF), x1 = *(const f32x4*)(h + off + bj * HALF + 4);
                    const f32x4 h0 = x0 + g2[bj][0] * acc[ai][bj][m][0], hb = x1 + g2[bj][1] * acc[ai][bj][m][1];
                    *(f32x4*)(ho + off + bj * HALF) = h0; *(f32x4*)(ho + off + bj * HALF + 4) = hb;
                    q += (h0[0] * h0[0] + h0[1] * h0[1]) + (h0[2] * h0[2] + h0[3] * h0[3]) + (hb[0] * hb[0] + hb[1] * hb[1]) + (hb[2] * hb[2] + hb[3] * hb[3]); }
                q += __shfl_xor(q, 16); q += __shfl_xor(q, 32);
                if (fq == 0) ssq[(size_t)row * 16 + u.pn * 4 + wc] = q; }
    }
};

template <class Epi, class Sched, bool ALIGN_EPI = false, bool SP2 = false>
__device__ __forceinline__ void gemm_phase(PG8_LAS unsigned char* lds, const Gemm g, const Sched& S, const Epi& E, const int wid) {
    const int lane = lane_id_v(), tid = wid * 64 + lane, wr = wid >> 2, wc = wid & 3, fr = lane & 15, fq = lane >> 4;
    const int K = g.K, nt = K / BK;
    unsigned voffA[2], voffB[2];
#pragma unroll
    for (int i = 0; i < 2; ++i) { int R, C; stage_rc(tid * 16 + i * 8192, R, C); const int Rb = Epi::PERM ? ((R & ~31) + perm32(R & 31)) : R;
        voffA[i] = (unsigned)(R * K + C) * 2u; voffB[i] = (unsigned)(Rb * K + C) * 2u; }
    const size_t kstep = (size_t)(BK * 2);
    const size_t hstep = (size_t)HALF * K * 2;
    const size_t tstep = 2 * hstep;
    const unsigned ldsw = (unsigned)wid * 1024u;
    const int aoff = lds_byte(wr * 64 + fr, fq * 8), boff = lds_byte(wc * 32 + fr, fq * 8);
#define PG8_SA(b, h) (((b) * 2 + (h)) * HTB)
#define PG8_SB(b, h) ((4 + (b) * 2 + (h)) * HTB)
#define PG8_STAGE(bufoff, gbase, voff) do { _Pragma("unroll") for (int _i = 0; _i < 2; ++_i) \
        __builtin_amdgcn_global_load_lds((const unsigned*)((const char*)(gbase) + (voff)[_i]), (PG8_LAS unsigned*)(lds + (bufoff) + ldsw + _i * 8192), 16, 0, 0); } while (0)
#define PG8_LDA(dst, b, h) do { _Pragma("unroll") for (int m = 0; m < 4; ++m) _Pragma("unroll") for (int k = 0; k < 2; ++k) dst[m][k] = *(const PG8_LAS bf16x8*)(lds + PG8_SA(b, h) + aoff + m * 2048 + k * 1024); } while (0)
#define PG8_LDB(dst, b, h) do { _Pragma("unroll") for (int n = 0; n < 2; ++n) _Pragma("unroll") for (int k = 0; k < 2; ++k) dst[n][k] = *(const PG8_LAS bf16x8*)(lds + PG8_SB(b, h) + boff + n * 2048 + k * 1024); } while (0)
#define PG8_MMA(ai, bj, At, Bt) do { __builtin_amdgcn_s_setprio(1); _Pragma("unroll") for (int m = 0; m < 4; ++m) _Pragma("unroll") for (int n = 0; n < 2; ++n) _Pragma("unroll") for (int k = 0; k < 2; ++k) \
        acc[ai][bj][m][n] = __builtin_amdgcn_mfma_f32_16x16x32_bf16(Bt[n][k], At[m][k], acc[ai][bj][m][n], 0, 0, 0); __builtin_amdgcn_s_setprio(0); } while (0)
#define PG8_WAIT_V(n) asm volatile("s_waitcnt vmcnt(" #n ")" ::: "memory")
#define PG8_WAIT_L(n) asm volatile("s_waitcnt lgkmcnt(" #n ")" ::: "memory")
#define PG8_BAR __builtin_amdgcn_s_barrier()
#define PG8_SCHED __builtin_amdgcn_sched_barrier(0)
    Unit cur, nxt; int ui = 0;
    if (!S.next(0, cur)) return;
    f32x4 acc[2][2][4][2];
#pragma unroll
    for (int a = 0; a < 2; ++a)
#pragma unroll
        for (int b = 0; b < 2; ++b)
#pragma unroll
            for (int m = 0; m < 4; ++m)
#pragma unroll
                for (int n = 0; n < 2; ++n) acc[a][b][m][n] = (f32x4){0.f, 0.f, 0.f, 0.f};
    bf16x8 At[4][2], B0[2][2], B1[2][2];
    const char* cA = (const char*)g.A + (size_t)cur.pm * g.a_pstride; const char* cB = (const char*)g.Bt + (size_t)cur.pn * tstep;
    S.a_ready(cur);
    if constexpr (SP2) {
        PG8_STAGE(PG8_SB(0, 0), cB, voffB); PG8_STAGE(PG8_SB(0, 1), cB + hstep, voffB); PG8_STAGE(PG8_SA(0, 0), cA, voffA); PG8_STAGE(PG8_SA(0, 1), cA + hstep, voffA);
        if (wr == 1) PG8_BAR;
        PG8_WAIT_V(2); PG8_BAR;
        PG8_STAGE(PG8_SB(1, 0), cB + kstep, voffB); PG8_STAGE(PG8_SA(1, 0), cA + kstep, voffA); PG8_STAGE(PG8_SB(1, 1), cB + hstep + kstep, voffB);
        PG8_WAIT_V(6); PG8_BAR;
    } else {
        PG8_STAGE(PG8_SB(0, 0), cB, voffB); PG8_STAGE(PG8_SA(0, 0), cA, voffA); PG8_STAGE(PG8_SB(0, 1), cB + hstep, voffB); PG8_STAGE(PG8_SA(0, 1), cA + hstep, voffA);
        if (wr == 1) PG8_BAR;
        PG8_WAIT_V(4); PG8_BAR;
        PG8_STAGE(PG8_SB(1, 0), cB + kstep, voffB); PG8_STAGE(PG8_SA(1, 0), cA + kstep, voffA); PG8_STAGE(PG8_SB(1, 1), cB + hstep + kstep, voffB);
        PG8_WAIT_V(6); PG8_BAR;
    }
    for (;;) {
        const bool has_next = S.next(ui + 1, nxt);
        const char* nA = has_next ? (const char*)g.A + (size_t)nxt.pm * g.a_pstride : cA; const char* nB = has_next ? (const char*)g.Bt + (size_t)nxt.pn * tstep : cB;
        for (int t = 0; t < nt; t += 2) {
            if constexpr (Epi::HAS_MID) { if (t == (nt >> 1)) { int fr_e = fr, fq_e = fq; asm volatile("" : "+v"(fr_e), "+v"(fq_e)); E.mid(acc, cur, wr, wc, fr_e, fq_e); } }
            const bool last = (t == nt - 2);
            const char* a1 = cA + (size_t)(t + 1) * kstep;
            const char* a2 = last ? nA : cA + (size_t)(t + 2) * kstep; const char* b2 = last ? nB : cB + (size_t)(t + 2) * kstep;
            const char* a3 = a2 + kstep; const char* b3 = b2 + kstep;
            if (last && has_next) S.a_ready(nxt);
            if constexpr (SP2) {
            PG8_LDB(B0, 0, 0); PG8_LDB(B1, 0, 1); PG8_SCHED; PG8_LDA(At, 0, 0); PG8_STAGE(PG8_SA(1, 1), a1 + hstep, voffA);
            PG8_WAIT_V(8); PG8_WAIT_L(0); PG8_BAR; PG8_MMA(0, 0, At, B0); PG8_MMA(0, 1, At, B1); PG8_BAR; PG8_SCHED;
            PG8_LDA(At, 0, 1); PG8_STAGE(PG8_SB(0, 0), b2, voffB); PG8_STAGE(PG8_SB(0, 1), b2 + hstep, voffB); PG8_STAGE(PG8_SA(0, 0), a2, voffA);
            PG8_WAIT_V(8); PG8_WAIT_L(0); PG8_BAR; PG8_MMA(1, 0, At, B0); PG8_MMA(1, 1, At, B1); PG8_BAR; PG8_SCHED;
            PG8_LDB(B0, 1, 0); PG8_LDB(B1, 1, 1); PG8_SCHED; PG8_LDA(At, 1, 0); PG8_STAGE(PG8_SA(0, 1), a2 + hstep, voffA);
            PG8_WAIT_V(8); PG8_WAIT_L(0); PG8_BAR; PG8_MMA(0, 0, At, B0); PG8_MMA(0, 1, At, B1); PG8_BAR; PG8_SCHED;
            PG8_LDA(At, 1, 1); PG8_STAGE(PG8_SB(1, 0), b3, voffB); PG8_STAGE(PG8_SB(1, 1), b3 + hstep, voffB); PG8_STAGE(PG8_SA(1, 0), a3, voffA);
            PG8_WAIT_V(8); PG8_WAIT_L(0); PG8_BAR; PG8_MMA(1, 0, At, B0); PG8_MMA(1, 1, At, B1); PG8_BAR; PG8_SCHED;
            } else {
            PG8_LDB(B0, 0, 0); PG8_SCHED; PG8_LDA(At, 0, 0); PG8_STAGE(PG8_SA(1, 1), a1 + hstep, voffA);
            PG8_WAIT_L(8); PG8_BAR; PG8_WAIT_L(0); PG8_MMA(0, 0, At, B0); PG8_BAR; PG8_SCHED;
            PG8_LDB(B1, 0, 1); PG8_STAGE(PG8_SB(0, 0), b2, voffB);
            PG8_BAR; PG8_WAIT_L(0); PG8_MMA(0, 1, At, B1); PG8_BAR;
            PG8_LDA(At, 0, 1); PG8_STAGE(PG8_SA(0, 0), a2, voffA);
            PG8_BAR; PG8_WAIT_L(0); PG8_MMA(1, 0, At, B0); PG8_BAR; PG8_SCHED;
            PG8_STAGE(PG8_SB(0, 1), b2 + hstep, voffB);
            PG8_WAIT_V(6); PG8_BAR; PG8_MMA(1, 1, At, B1); PG8_BAR;
            PG8_LDB(B0, 1, 0); PG8_SCHED; PG8_LDA(At, 1, 0); PG8_STAGE(PG8_SA(0, 1), a2 + hstep, voffA);
            PG8_WAIT_L(8); PG8_BAR; PG8_WAIT_L(0); PG8_MMA(0, 0, At, B0); PG8_BAR; PG8_SCHED;
            PG8_LDB(B1, 1, 1); PG8_STAGE(PG8_SB(1, 0), b3, voffB);
            PG8_BAR; PG8_WAIT_L(0); PG8_MMA(0, 1, At, B1); PG8_BAR;
            PG8_LDA(At, 1, 1); PG8_STAGE(PG8_SA(1, 0), a3, voffA);
            PG8_BAR; PG8_WAIT_L(0); PG8_MMA(1, 0, At, B0); PG8_BAR; PG8_SCHED;
            PG8_STAGE(PG8_SB(1, 1), b3 + hstep, voffB);
            PG8_WAIT_V(6); PG8_BAR; PG8_MMA(1, 1, At, B1); PG8_BAR;
            }
        }
        if constexpr (ALIGN_EPI) { if (wr == 0) PG8_BAR; }
        if constexpr (!Epi::AFTER_DRAIN) { int fr_e = fr, fq_e = fq; asm volatile("" : "+v"(fr_e), "+v"(fq_e));
            E(acc, cur, wr, wc, fr_e, fq_e);
#ifdef PH_EPI2
            if (Epi::EPI_ID == PH_EPI2) { asm volatile("" : "+v"(fr_e), "+v"(fq_e)); E(acc, cur, wr, wc, fr_e, fq_e); }
#endif
            S.done(cur); }
        if (!has_next) break;
#pragma unroll
        for (int a = 0; a < 2; ++a)
#pragma unroll
            for (int b = 0; b < 2; ++b)
#pragma unroll
                for (int m = 0; m < 4; ++m)
#pragma unroll
                    for (int n = 0; n < 2; ++n) acc[a][b][m][n] = (f32x4){0.f, 0.f, 0.f, 0.f};
        cur = nxt; cA = nA; cB = nB; ++ui;
        if constexpr (ALIGN_EPI) { if (wr == 1) PG8_BAR; }
    }
    PG8_WAIT_V(0);
    if constexpr (!ALIGN_EPI) { if (wr == 0) PG8_BAR; }
    PG8_BAR;
    if constexpr (Epi::AFTER_DRAIN) { E.fused(acc, cur, wr, wc, fr, fq, lds, wid, lane); S.done(cur); }
#undef PG8_SA
#undef PG8_SB
#undef PG8_STAGE
#undef PG8_LDA
#undef PG8_LDB
#undef PG8_MMA
#undef PG8_WAIT_V
#undef PG8_WAIT_L
#undef PG8_BAR
#undef PG8_SCHED
}
}

#define GAS __attribute__((address_space(1)))
#define LAS __attribute__((address_space(3)))
typedef unsigned short bf16;
typedef unsigned v4u __attribute__((ext_vector_type(4)));
typedef float f32x4 __attribute__((ext_vector_type(4)));
typedef short bf16x8 __attribute__((ext_vector_type(8)));
typedef GAS unsigned gu32;
typedef GAS unsigned long long gu64;
#define RLX_AGENT __ATOMIC_RELAXED, __HIP_MEMORY_SCOPE_AGENT
#define LDS_WAIT() asm volatile("s_waitcnt lgkmcnt(0)" ::: "memory")
#define VM_WAIT() asm volatile("s_waitcnt vmcnt(0)" ::: "memory")
__device__ __forceinline__ unsigned long long rt() { return __builtin_amdgcn_s_memrealtime(); }
__device__ __forceinline__ unsigned f2bf(float f) { unsigned u = __builtin_bit_cast(unsigned, f); return (u + 0x7fffu + ((u >> 16) & 1u)) >> 16; }
__device__ __forceinline__ unsigned pk2(float lo, float hi) { return f2bf(lo) | (f2bf(hi) << 16); }

#define XB_TMO      128
#define XB_XCNT(j)  (256  + 64 * (j))
#define XB_XSUB(j)  (1280 + 64 * (j))
#define XB_XGEN(j)  (2304 + 64 * (j))
#define XB_TOP      3328
#define XB_TOPGEN   3392
#define XCD_BAR_WORDS 3456
#define XB_SPIN_CAP (1u << 18)

__device__ __forceinline__ unsigned xb_ld(unsigned* p)              { return __hip_atomic_load(p, __ATOMIC_RELAXED, __HIP_MEMORY_SCOPE_AGENT); }
__device__ __forceinline__ unsigned xb_add(unsigned* p, unsigned v) { return __hip_atomic_fetch_add(p, v, __ATOMIC_RELAXED, __HIP_MEMORY_SCOPE_AGENT); }
__device__ __forceinline__ unsigned xb_xcc_id() { return (unsigned)__builtin_amdgcn_s_getreg((3 << 11) | 20) & 0xFu; }
#define XB_SPIN(cond, bar) do { unsigned _sp = 0; while (cond) { __builtin_amdgcn_s_sleep(1); \
    if ((++_sp & 255u) == 0u) { if (xb_ld(&(bar)[XB_TMO])) break; if (_sp > XB_SPIN_CAP) { atomicAdd(&(bar)[XB_TMO], 1u); break; } } } } while (0)

struct XcdBarrier {
    unsigned* bar; unsigned x;
    volatile LAS unsigned* st;
};

__device__ __forceinline__ XcdBarrier xcd_barrier_post(unsigned* bar, volatile LAS unsigned* st, const int wave) {
    XcdBarrier b; b.bar = bar; b.x = xb_xcc_id(); b.st = st;
    if (wave == 0 && pg8::lane_id_v() == 0) (void)xb_add(&bar[XB_XCNT(b.x)], 1u);
    return b;
}
__device__ __forceinline__ void xcd_barrier_complete(unsigned* bar, unsigned x, unsigned& nloc, unsigned& nx) {
    const unsigned G = gridDim.x * gridDim.y * gridDim.z;
    unsigned sum, cnt, mine, sp = 0u;
    for (;;) {
        sum = 0u; cnt = 0u; mine = 0u;
#pragma unroll
        for (unsigned j = 0; j < 16; ++j) { const unsigned c = xb_ld(&bar[XB_XCNT(j)]); sum += c; cnt += (c > 0u) ? 1u : 0u; mine = (j == x) ? c : mine; }
        if (sum == G) break;
        __builtin_amdgcn_s_sleep(1);
        if ((++sp & 255u) == 0u) { if (xb_ld(&bar[XB_TMO])) break; if (sp > XB_SPIN_CAP) { atomicAdd(&bar[XB_TMO], 1u); break; } }
    }
    nloc = mine > 0u ? mine : 1u; nx = cnt > 0u ? cnt : 1u;
}

__device__ __forceinline__ void xcd_barrier(const XcdBarrier& b, const int wave) {
    asm volatile("s_waitcnt vmcnt(0)" ::: "memory");
    __syncthreads();
    if (wave == 0 && pg8::lane_id_v() == 0) {
        unsigned* bar = b.bar;
        __builtin_amdgcn_s_waitcnt(0);
        unsigned nloc = b.st[0], nx = b.st[1];
        if (nloc == 0u) { xcd_barrier_complete(bar, b.x, nloc, nx); b.st[0] = nloc; b.st[1] = nx; }
        const unsigned old = xb_add(&bar[XB_XSUB(b.x)], 1u);
        const unsigned gen = old / nloc;
        if (old + 1u == (gen + 1u) * nloc) {
            __builtin_amdgcn_fence(__ATOMIC_RELEASE, "agent");
            asm volatile("s_waitcnt vmcnt(0)" ::: "memory");
            const unsigned og = xb_add(&bar[XB_TOP], 1u);
            const unsigned tg = og / nx;
            if (og + 1u == (tg + 1u) * nx) xb_add(&bar[XB_TOPGEN], 1u);
            else XB_SPIN(xb_ld(&bar[XB_TOPGEN]) == tg, bar);
            __builtin_amdgcn_fence(__ATOMIC_ACQUIRE, "agent");
            xb_add(&bar[XB_XGEN(b.x)], 1u);
            asm volatile("s_waitcnt vmcnt(0)" ::: "memory");
        } else {
            XB_SPIN(xb_ld(&bar[XB_XGEN(b.x)]) == gen, bar);
            __builtin_amdgcn_fence(__ATOMIC_ACQUIRE, "agent");
            asm volatile("s_waitcnt vmcnt(0)" ::: "memory");
        }
    }
    __syncthreads();
}


__device__ __forceinline__ void group_sync(unsigned* cnt, unsigned want, unsigned* tmo, const int wave) {
    asm volatile("s_waitcnt vmcnt(0)" ::: "memory");
    __syncthreads();
    if (wave == 0 && pg8::lane_id_v() == 0) {
        __builtin_amdgcn_fence(__ATOMIC_RELEASE, "agent");
        asm volatile("s_waitcnt vmcnt(0)" ::: "memory");
        (void)xb_add(cnt, 1u);
        unsigned sp = 0u;
        while (xb_ld(cnt) < want) { __builtin_amdgcn_s_sleep(1); if ((++sp & 255u) == 0u) { if (xb_ld(tmo)) break; if (sp > XB_SPIN_CAP) { atomicAdd(tmo, 1u); break; } } }
        __builtin_amdgcn_fence(__ATOMIC_ACQUIRE, "agent");
        asm volatile("s_waitcnt vmcnt(0)" ::: "memory");
    }
    __syncthreads();
}

constexpr int NWAVES = 8;
constexpr int BATCH = 4, SEQ = 4096, D = 1024, M = BATCH * SEQ, NPROJ = 8192, FF = 4096, NMOD = 6 * D;
constexpr int RH = 4, DK = 128, DV = 256, SCH = 256  , NJ = SEQ / SCH  ;
constexpr float EPS = 1e-6f;
constexpr int KS_MOD = 8;
constexpr size_t MiB = 1u << 20;
constexpr size_t WS_CTL = 0, CTL_ZERO_BYTES = 1 * MiB;
constexpr size_t WS_MODP = 1 * MiB;
constexpr size_t WS_MODF = 2 * MiB + 512 * 1024;
constexpr size_t WS_BIAS2 = WS_MODF + 128 * 1024;
constexpr size_t WS_SSQ2 = 3 * MiB, WS_SSQ3 = 4 * MiB;
constexpr size_t WS_WIN = 5 * MiB, WS_WRC = 21 * MiB, WS_WO = 25 * MiB, WS_W1 = 27 * MiB, WS_W2 = 35 * MiB;
constexpr size_t WS_ST = WS_WIN;
constexpr size_t WS_QK = 44 * MiB, WS_V = 76 * MiB, WS_R = 108 * MiB, WS_END = 236 * MiB;
constexpr size_t WS_MERGED = WS_QK, WS_HHAT = WS_V, WS_HID = WS_R;
constexpr size_t OUT_U = 0, OUT_Z = 32 * MiB, OUT_KV = 0;
static_assert(WS_W2 + (size_t)D * FF * 2 <= WS_QK && WS_HID + (size_t)M * FF * 2 <= WS_END, "d_ws map");
constexpr int CW_TMO = 0, CW_BAR = 4096, CW_GRP = 32768;
constexpr int RING_OFF = 0, PHASE_BYTES = 139264, LDSCTL_OFF = PHASE_BYTES, MISC_OFF = LDSCTL_OFF + 320, TAB_OFF = LDSCTL_OFF + 1024, LDS_BYTES = PHASE_BYTES + 4096;

struct Frame {
    LAS unsigned char* lds; volatile LAS unsigned* MISC; gu32* ctl;
    int wave, vcu, G;
    const float *x, *c, *w_ada, *b_ada, *norm1_w, *w_in, *ret_gn_w, *conv_w, *w_ret_out, *w_conv_out, *w_o, *norm2_w, *w_ff1, *w_ff2, *final_norm_w; const int* positions;
    float* out; unsigned char* ws;
};
__device__ __forceinline__ float wave_sum(float v) {
#pragma unroll
    for (int o = 1; o < 64; o <<= 1) v += __shfl_xor(v, o);
    return v;
}
__device__ __forceinline__ unsigned cvtpk2(float lo, float hi) { return pg8::cvtpk(lo, hi); }

__device__ __forceinline__ int vmap_in(int n) {
    if (n < 1024) { const int hb = n & ~127, d = n & 127; const int dd = d & 63; return hb + 8 * (dd >> 2) + (d >= 64 ? 4 : 0) + (dd & 3); }
    if (n >= 4096 && n < 6144) { const int j = (n - 4096) & 1023; return 4096 + 8 * (j >> 2) + (n >= 5120 ? 4 : 0) + (j & 3); }
    return n;
}
struct P0Tile { const float* W; bf16* WT; int N, ldt, kofs, k0, n0, vm; };
__device__ __forceinline__ P0Tile p0_tile(const Frame& F, int t) {
    P0Tile T; int r = t;
    if (r < 512) { T.W = F.w_in; T.WT = (bf16*)(F.ws + WS_WIN); T.N = NPROJ; T.ldt = D; T.kofs = 0; T.vm = 1; T.n0 = 512 * (r >> 5); T.k0 = 32 * (r & 31); return T; } r -= 512;
    if (r < 64) { T.W = F.w_ret_out; T.WT = (bf16*)(F.ws + WS_WRC); T.N = D; T.ldt = 2 * D; T.kofs = 0; T.vm = 0; T.n0 = 512 * (r >> 5); T.k0 = 32 * (r & 31); return T; } r -= 64;
    if (r < 64) { T.W = F.w_conv_out; T.WT = (bf16*)(F.ws + WS_WRC); T.N = D; T.ldt = 2 * D; T.kofs = D; T.vm = 0; T.n0 = 512 * (r >> 5); T.k0 = 32 * (r & 31); return T; } r -= 64;
    if (r < 64) { T.W = F.w_o; T.WT = (bf16*)(F.ws + WS_WO); T.N = D; T.ldt = D; T.kofs = 0; T.vm = 0; T.n0 = 512 * (r >> 5); T.k0 = 32 * (r & 31); return T; } r -= 64;
    if (r < 256) { T.W = F.w_ff1; T.WT = (bf16*)(F.ws + WS_W1); T.N = FF; T.ldt = D; T.kofs = 0; T.vm = 0; T.n0 = 512 * (r >> 5); T.k0 = 32 * (r & 31); return T; } r -= 256;
    T.W = F.w_ff2; T.WT = (bf16*)(F.ws + WS_W2); T.N = D; T.ldt = FF; T.kofs = 0; T.vm = 0; T.n0 = 512 * (r >> 7); T.k0 = 32 * (r & 127); return T;
}
constexpr int P0_NTILES = 512 + 3 * 64 + 256 + 256;
__device__ __forceinline__ void p0_dma(const P0Tile& T, LAS unsigned char* buf, int wave, int lane) {
#pragma unroll
    for (int i = 0; i < 8; ++i) { const int row = 4 * wave + (i >> 1), half = i & 1;
        __builtin_amdgcn_global_load_lds((const unsigned*)(T.W + (size_t)(T.k0 + row) * T.N + T.n0 + half * 256 + lane * 4), (LAS unsigned*)(buf + row * 2048 + half * 1024), 16, 0, 2  ); }
}
__device__ __forceinline__ float siluf_(float x) { return x / (1.0f + __expf(-x)); }
__device__ __forceinline__ void p0_prologue(Frame& F) {
    const int lane_ = pg8::lane_id_v(), tid_ = F.wave * 64 + lane_; (void)tid_;
    const int gw = F.vcu * NWAVES + F.wave, NGW = F.G * NWAVES;
    for (int vb = F.vcu; vb < 32 * KS_MOD; vb += F.G) {
        const int cb = vb & 31, ks = vb >> 5, k0 = ks * (D / KS_MOD) + 16 * F.wave; const int col = 192 * cb + 4 * (lane_ < 48 ? lane_ : 0);
        f32x4 a0 = {0.f, 0.f, 0.f, 0.f}, a1 = a0, a2 = a0, a3 = a0;
        const float* wp = F.w_ada + (size_t)k0 * NMOD + col;
        f32x4 wv[16];
#pragma unroll
        for (int kk = 0; kk < 16; ++kk) wv[kk] = __builtin_nontemporal_load((const GAS f32x4*)(wp + (size_t)kk * NMOD));
#pragma unroll
        for (int kk = 0; kk < 16; ++kk) { const int k = k0 + kk; const float s0 = siluf_(F.c[k]), s1 = siluf_(F.c[D + k]), s2 = siluf_(F.c[2 * D + k]), s3 = siluf_(F.c[3 * D + k]);
            a0 += wv[kk] * s0; a1 += wv[kk] * s1; a2 += wv[kk] * s2; a3 += wv[kk] * s3; }
        LAS f32x4* red = (LAS f32x4*)(F.lds + RING_OFF);
        if (lane_ < 48) { LAS f32x4* rp = red + (F.wave * 4) * 48 + lane_; rp[0] = a0; rp[48] = a1; rp[96] = a2; rp[144] = a3; }
        __syncthreads();
        if (tid_ < 192) { f32x4 sacc = {0.f, 0.f, 0.f, 0.f};
#pragma unroll
            for (int w = 0; w < NWAVES; ++w) sacc += red[w * 192 + tid_];
            *(f32x4*)((float*)(F.ws + WS_MODP) + (size_t)ks * 4 * NMOD + (size_t)(tid_ / 48) * NMOD + 192 * cb + 4 * (tid_ % 48)) = sacc; }
        __syncthreads();
    }
    const int t0 = (int)(((long)F.vcu * P0_NTILES) / F.G), t1 = (int)(((long)(F.vcu + 1) * P0_NTILES) / F.G);
    if (t0 < t1) { const P0Tile T0 = p0_tile(F, t0); p0_dma(T0, F.lds + RING_OFF, F.wave, lane_); }
    for (int t = t0; t < t1; ++t) {
        LAS unsigned char* buf = F.lds + RING_OFF + ((t - t0) & 1) * 65536;
        const P0Tile T = p0_tile(F, t);
        __syncthreads();
        if (t + 1 < t1) { const P0Tile Tn = p0_tile(F, t + 1); p0_dma(Tn, F.lds + RING_OFF + ((t + 1 - t0) & 1) * 65536, F.wave, lane_); }
        float v[32];
#pragma unroll
        for (int k = 0; k < 32; ++k) v[k] = *(const LAS float*)(buf + k * 2048 + tid_ * 4);
        const int n = T.n0 + tid_, vr = T.vm ? vmap_in(n) : n;
        GAS v4u* dst = (GAS v4u*)(T.WT + (size_t)vr * T.ldt + T.kofs + T.k0);
#pragma unroll
        for (int c = 0; c < 4; ++c) { v4u o; o.x = cvtpk2(v[8 * c], v[8 * c + 1]); o.y = cvtpk2(v[8 * c + 2], v[8 * c + 3]); o.z = cvtpk2(v[8 * c + 4], v[8 * c + 5]); o.w = cvtpk2(v[8 * c + 6], v[8 * c + 7]); dst[c] = o; }
    }
    __syncthreads();
}

__device__ __forceinline__ float modp_sum(const float* modp, int idx) { float s = 0.f;
#pragma unroll
    for (int ks = 0; ks < KS_MOD; ++ks) s += modp[(size_t)ks * 4 * NMOD + idx];
    return s; }
__device__ __forceinline__ void p1_unorm(Frame& F) {
    const int lane_ = pg8::lane_id_v(), tid_ = F.wave * 64 + lane_; (void)tid_;
    const float* modp = (const float*)(F.ws + WS_MODP); float* modf = (float*)(F.ws + WS_MODF);
    const int blk = F.vcu;
    const int b = blk >> 6;
    LAS float* cs1 = (LAS float*)(F.lds + RING_OFF); LAS float* sh1 = cs1 + D;
    for (int k = tid_; k < D; k += NWAVES * 64) {
        const float sh = modp_sum(modp, b * NMOD + k) + F.b_ada[k], sc = modp_sum(modp, b * NMOD + D + k) + F.b_ada[D + k];
        cs1[k] = F.norm1_w[k] * (1.0f + sc); sh1[k] = sh; }
    if (tid_ < 96) { const int idx = blk * 96 + tid_; if (idx < 4 * NMOD) modf[idx] = modp_sum(modp, idx) + F.b_ada[idx % NMOD]; }
    __syncthreads();
    bf16* U = (bf16*)((unsigned char*)F.out + OUT_U);
    for (int r0 = 0; r0 < 8; r0 += 4) {
        f32x4 v[4][4]; float ss[4];
#pragma unroll
        for (int q = 0; q < 4; ++q) { const int m = blk * 64 + F.wave * 8 + r0 + q; const GAS f32x4* xr = (const GAS f32x4*)(F.x + (size_t)m * D) + lane_;
#pragma unroll
            for (int j = 0; j < 4; ++j) v[q][j] = __builtin_nontemporal_load(xr + 64 * j); }
#pragma unroll
        for (int q = 0; q < 4; ++q) { float s = 0.f;
#pragma unroll
            for (int j = 0; j < 4; ++j) s += (v[q][j].x * v[q][j].x + v[q][j].y * v[q][j].y) + (v[q][j].z * v[q][j].z + v[q][j].w * v[q][j].w);
            ss[q] = 1.0f / sqrtf(wave_sum(s) * (1.0f / D) + EPS); }
#pragma unroll
        for (int q = 0; q < 4; ++q) { const int m = blk * 64 + F.wave * 8 + r0 + q; GAS unsigned long long* o8 = (GAS unsigned long long*)(U + (size_t)m * D) + lane_;
#pragma unroll
            for (int j = 0; j < 4; ++j) { const int k = 4 * lane_ + 256 * j; const f32x4 a = *(const LAS f32x4*)(cs1 + k), sh = *(const LAS f32x4*)(sh1 + k);
                const f32x4 u = v[q][j] * ss[q] * a + sh;
                o8[64 * j] = (unsigned long long)cvtpk2(u.x, u.y) | ((unsigned long long)cvtpk2(u.z, u.w) << 32); } }
    }
}

typedef short s16x4 __attribute__((ext_vector_type(4)));
typedef float f32x16 __attribute__((ext_vector_type(16)));
#define MFMA32(a, b, c) __builtin_amdgcn_mfma_f32_32x32x16_bf16((a), (b), (c), 0, 0, 0)
__device__ __forceinline__ int crow(int reg, int hh) { return (reg & 3) + 8 * (reg >> 2) + 4 * hh; }
__device__ __forceinline__ bf16x8 tr_frag(LAS unsigned char* p) {
    const s16x4 lo = __builtin_amdgcn_ds_read_tr16_b64_v4i16((LAS s16x4*)p), hi = __builtin_amdgcn_ds_read_tr16_b64_v4i16((LAS s16x4*)(p + 512));
    return __builtin_shufflevector(lo, hi, 0, 1, 2, 3, 4, 5, 6, 7);
}
__device__ __forceinline__ void tr_issue(s16x4& lo, s16x4& hi, LAS unsigned char* p) {
    asm volatile("ds_read_b64_tr_b16 %0, %2\n\tds_read_b64_tr_b16 %1, %2 offset:512" : "=&v"(lo), "=&v"(hi) : "v"((unsigned)(uintptr_t)p) : "memory");
}
#define TR_WAIT() asm volatile("s_waitcnt lgkmcnt(0)" ::: "memory")
#define TR_JOIN(lo, hi) __builtin_shufflevector((lo), (hi), 0, 1, 2, 3, 4, 5, 6, 7)
__device__ __forceinline__ float log2_gamma(int hd) { return log2f(1.0f - exp2f(-5.0f - (float)hd)); }
constexpr int RT_K = 0, RT_V = 8192, RT_BLK = 24576;
__device__ __forceinline__ void rt_dma_block(const bf16* QK, const bf16* V, size_t mrow0, int hd, LAS unsigned char* slot, int wave, int lane) {
#pragma unroll
    for (int i = 0; i < 3; ++i) { const int idx = 3 * wave + i; const bool isk = idx >= 16; const int j = isk ? idx - 16 : idx, cb = j >> 1, half = j & 1;
        const size_t row = mrow0 + 16 * half + (lane >> 2); const int piece = (lane & 3) * 8;
        const bf16* src = isk ? QK + row * 1024 + 512 + hd * DK + cb * 32 + piece : V + row * 1024 + hd * DV + cb * 32 + piece;
        __builtin_amdgcn_global_load_lds((const unsigned*)src, (LAS unsigned*)(slot + (isk ? RT_K : RT_V) + cb * 2048 + half * 1024), 16, 0, 0); }
}
#define RT_WAITBAR(n) do { asm volatile("s_waitcnt vmcnt(" #n ")" ::: "memory"); __builtin_amdgcn_s_barrier(); asm volatile("" ::: "memory"); } while (0)
__device__ __forceinline__ void p3a_kvsum(Frame& F, int unit) {
    const int lane = pg8::lane_id_v();
    const int bh = unit >> 4, J = unit & 15, b = bh >> 2, hd = bh & 3;
    const bf16* QK = (const bf16*)(F.ws + WS_QK); const bf16* V = (const bf16*)(F.ws + WS_V);
    float* KV = (float*)((unsigned char*)F.out + OUT_KV) + (size_t)unit * (DV * DK);
    const int w = F.wave, r = lane & 31, hh = lane >> 5;
    const float l2g = log2_gamma(hd);
    const size_t mbase = (size_t)b * SEQ + (size_t)J * SCH;
    const int lane_off = (4 * hh + ((lane & 15) >> 2)) * 64 + ((lane >> 4) & 1) * 32 + (lane & 3) * 8;
    f32x16 acc[4];
#pragma unroll
    for (int d = 0; d < 4; ++d)
#pragma unroll
        for (int i = 0; i < 16; ++i) acc[d][i] = 0.f;
    float cj[8];
#pragma unroll
    for (int j = 0; j < 8; ++j) cj[j] = __builtin_amdgcn_exp2f(-(float)(8 * (j >> 2) + (j & 3)) * l2g);
#pragma unroll
    for (int p = 0; p < 3; ++p) rt_dma_block(QK, V, mbase + 32 * p, hd, F.lds + p * RT_BLK, w, lane);
#pragma unroll
    for (int sb = 0; sb < 8; ++sb) {
        if (sb <= 5) RT_WAITBAR(6); else if (sb == 6) RT_WAITBAR(3); else RT_WAITBAR(0);
        if (sb + 3 < 8) rt_dma_block(QK, V, mbase + 32 * (sb + 3), hd, F.lds + ((sb + 3) & 3) * RT_BLK, w, lane);
        LAS unsigned char* slot = F.lds + (sb & 3) * RT_BLK;
        s16x4 vlo[2], vhi[2], klo[2][4], khi[2][4];
#pragma unroll
        for (int ks2 = 0; ks2 < 2; ++ks2) { tr_issue(vlo[ks2], vhi[ks2], slot + RT_V + w * 2048 + ks2 * 1024 + lane_off);
#pragma unroll
            for (int d = 0; d < 4; ++d) tr_issue(klo[ks2][d], khi[ks2][d], slot + RT_K + d * 2048 + ks2 * 1024 + lane_off); }
        asm volatile("s_waitcnt lgkmcnt(0)" : "+v"(vlo[0]), "+v"(vhi[0]), "+v"(vlo[1]), "+v"(vhi[1]), "+v"(klo[0][0]), "+v"(khi[0][0]), "+v"(klo[0][1]), "+v"(khi[0][1]), "+v"(klo[0][2]), "+v"(khi[0][2]), "+v"(klo[0][3]), "+v"(khi[0][3]),
                     "+v"(klo[1][0]), "+v"(khi[1][0]), "+v"(klo[1][1]), "+v"(khi[1][1]), "+v"(klo[1][2]), "+v"(khi[1][2]), "+v"(klo[1][3]), "+v"(khi[1][3]) :: "memory");
#pragma unroll
        for (int ks2 = 0; ks2 < 2; ++ks2) {
            const v4u bvr = __builtin_bit_cast(v4u, TR_JOIN(vlo[ks2], vhi[ks2]));
            const float base = __builtin_amdgcn_exp2f((float)(255 - 32 * sb - 16 * ks2 - 4 * hh) * l2g); v4u bs;
#pragma unroll
            for (int q = 0; q < 4; ++q) bs[q] = cvtpk2(pg8::bflo(bvr[q]) * (base * cj[2 * q]), pg8::bfhi(bvr[q]) * (base * cj[2 * q + 1]));
            const bf16x8 bv = __builtin_bit_cast(bf16x8, bs);
#pragma unroll
            for (int d = 0; d < 4; ++d) { const bf16x8 ak = TR_JOIN(klo[ks2][d], khi[ks2][d]); acc[d] = MFMA32(ak, bv, acc[d]); }
        }
    }
#pragma unroll
    for (int d = 0; d < 4; ++d)
#pragma unroll
        for (int g = 0; g < 4; ++g) { f32x4 o = {acc[d][4 * g], acc[d][4 * g + 1], acc[d][4 * g + 2], acc[d][4 * g + 3]};
            *(GAS f32x4*)(KV + (size_t)(32 * w + r) * DK + 32 * d + 8 * g + 4 * hh) = o; }
    __syncthreads();
}
__device__ __forceinline__ void p3a_conv(Frame& F, int blk) {
    const int lane_ = pg8::lane_id_v(), tid_ = F.wave * 64 + lane_; (void)tid_;
    bf16* Rb = (bf16*)(F.ws + WS_R); const bf16* Z = (const bf16*)((unsigned char*)F.out + OUT_Z);
    const int cc = tid_ & 127, rg = tid_ >> 7, m0 = blk * 64 + rg * 16, c0 = cc * 8;
    float w0[8], w1[8], w2[8];
#pragma unroll
    for (int e = 0; e < 8; ++e) { w0[e] = F.conv_w[c0 + e]; w1[e] = F.conv_w[D + c0 + e]; w2[e] = F.conv_w[2 * D + c0 + e]; }
    v4u zm2 = {0u, 0u, 0u, 0u}, zm1 = {0u, 0u, 0u, 0u};
    if ((m0 & (SEQ - 1)) != 0) { zm2 = __builtin_nontemporal_load((const GAS v4u*)(Z + (size_t)(m0 - 2) * 1024 + c0)); zm1 = __builtin_nontemporal_load((const GAS v4u*)(Z + (size_t)(m0 - 1) * 1024 + c0)); }
    bf16* cp0 = Rb + (size_t)(m0 >> 8) * 1048576 + (size_t)(m0 & 255) * 2048 + 1024 + c0;
#pragma unroll
    for (int i0 = 0; i0 < 16; i0 += 8) {
        v4u zz[8], cbv[8];
#pragma unroll
        for (int i = 0; i < 8; ++i) { zz[i] = __builtin_nontemporal_load((const GAS v4u*)(Z + (size_t)(m0 + i0 + i) * 1024 + c0)); cbv[i] = *(const GAS v4u*)(cp0 + (size_t)(i0 + i) * 2048); }
#pragma unroll
        for (int i = 0; i < 8; ++i) { const v4u z0 = zz[i], cb = cbv[i]; v4u o;
#pragma unroll
            for (int j = 0; j < 4; ++j) {
                const float lo = pg8::bflo(cb[j]) * (w0[2 * j] * pg8::bflo(zm2[j]) + w1[2 * j] * pg8::bflo(zm1[j]) + w2[2 * j] * pg8::bflo(z0[j]));
                const float hi = pg8::bfhi(cb[j]) * (w0[2 * j + 1] * pg8::bfhi(zm2[j]) + w1[2 * j + 1] * pg8::bfhi(zm1[j]) + w2[2 * j + 1] * pg8::bfhi(z0[j]));
                o[j] = cvtpk2(lo, hi); }
            *(GAS v4u*)(cp0 + (size_t)(i0 + i) * 2048) = o; zm2 = zm1; zm1 = z0; }
    }
}
__device__ __forceinline__ void p3a_bias2(Frame& F) {
    const int lane_ = pg8::lane_id_v();
    const float* modf = (const float*)(F.ws + WS_MODF); const bf16* W1_t = (const bf16*)(F.ws + WS_W1); float* bias2 = (float*)(F.ws + WS_BIAS2);
    const int gw = F.vcu * NWAVES + F.wave, NGW = F.G * NWAVES;
    if (gw >= FF) return;
    f32x4 sh[4][2][2];
#pragma unroll
    for (int bb = 0; bb < 4; ++bb)
#pragma unroll
        for (int i = 0; i < 2; ++i) { const float* p = modf + bb * NMOD + 3 * D + (lane_ + 64 * i) * 8; sh[bb][i][0] = *(const f32x4*)p; sh[bb][i][1] = *(const f32x4*)(p + 4); }
    for (int f0 = gw; f0 < FF; f0 += 2 * NGW) {
        const int f1 = f0 + NGW; const bool has1 = f1 < FF;
        v4u wv[2][2];
#pragma unroll
        for (int i = 0; i < 2; ++i) { wv[0][i] = *(const GAS v4u*)(W1_t + (size_t)f0 * D + (lane_ + 64 * i) * 8); wv[1][i] = *(const GAS v4u*)(W1_t + (size_t)(has1 ? f1 : f0) * D + (lane_ + 64 * i) * 8); }
        float a[2][4];
#pragma unroll
        for (int rr = 0; rr < 2; ++rr)
#pragma unroll
            for (int bb = 0; bb < 4; ++bb) { float t = 0.f;
#pragma unroll
                for (int i = 0; i < 2; ++i) { const v4u w = wv[rr][i]; const f32x4 s0 = sh[bb][i][0], s1 = sh[bb][i][1];
                    t += pg8::bflo(w[0]) * s0[0] + pg8::bfhi(w[0]) * s0[1] + pg8::bflo(w[1]) * s0[2] + pg8::bfhi(w[1]) * s0[3]
                       + pg8::bflo(w[2]) * s1[0] + pg8::bfhi(w[2]) * s1[1] + pg8::bflo(w[3]) * s1[2] + pg8::bfhi(w[3]) * s1[3]; }
                a[rr][bb] = wave_sum(t); }
        if (lane_ == 0) {
#pragma unroll
            for (int bb = 0; bb < 4; ++bb) { bias2[bb * FF + f0] = a[0][bb]; if (has1) bias2[bb * FF + f1] = a[1][bb]; } }
    }
}
__device__ __forceinline__ void p3b_scan(Frame& F, int bh, int j) {
    const int lane_ = pg8::lane_id_v(), tid_ = F.wave * 64 + lane_;
    const float* KV = (const float*)((unsigned char*)F.out + OUT_KV); bf16* ST = (bf16*)(F.ws + WS_ST);
    const int e = j * 2048 + tid_ * 4; const float g = exp2f(256.0f * log2_gamma(bh & 3));
    f32x4 kv[NJ];
#pragma unroll
    for (int J = 0; J < NJ; ++J) kv[J] = *(const GAS f32x4*)(KV + ((size_t)(bh * NJ + J)) * (DV * DK) + e);
    f32x4 S = {0.f, 0.f, 0.f, 0.f};
#pragma unroll
    for (int J = 0; J < NJ; ++J) { *(GAS unsigned long long*)(ST + ((size_t)(bh * NJ + J)) * (DV * DK) + e) = (unsigned long long)cvtpk2(S[0], S[1]) | ((unsigned long long)cvtpk2(S[2], S[3]) << 32);
        S = S * g + kv[J]; }
}
constexpr int RC_ST = 0, RC_RING = 65536, RC_STG = 528;
__device__ __forceinline__ void p3c_retout(Frame& F, int unit, bf16* OUTP, bool dummy_out) {
    const int lane = pg8::lane_id_v();
    const int bh = unit >> 4, J = unit & 15, b = bh >> 2, hd = bh & 3;
    const bf16* QK = (const bf16*)(F.ws + WS_QK); const bf16* V = (const bf16*)(F.ws + WS_V); const bf16* ST = (const bf16*)(F.ws + WS_ST) + (size_t)unit * (DV * DK);
    const bf16* Rb = (const bf16*)(F.ws + WS_R);
    const int w = F.wave, r = lane & 31, hh = lane >> 5;
    const float l2g = log2_gamma(hd);
    const size_t mbase = (size_t)b * SEQ + (size_t)J * SCH;
    const int lane_off = (4 * hh + ((lane & 15) >> 2)) * 64 + ((lane >> 4) & 1) * 32 + (lane & 3) * 8;
    LAS unsigned char* ring = F.lds + RC_RING;
    rt_dma_block(QK, V, mbase, hd, ring, w, lane); rt_dma_block(QK, V, mbase + 32, hd, ring + RT_BLK, w, lane);
#pragma unroll
    for (int i = 0; i < 8; ++i) { const int p = 8 * w + i, row = 4 * p + (lane >> 4), cp = lane & 15;
        __builtin_amdgcn_global_load_lds((const unsigned*)(ST + (size_t)row * DK + ((cp ^ (row & 15)) * 8)), (LAS unsigned*)(F.lds + RC_ST + p * 1024), 16, 0, 0); }
    bf16x8 qf[8];
    { const bf16* qp = QK + (mbase + 32 * w + r) * 1024 + hd * DK + 8 * hh;
#pragma unroll
      for (int ks = 0; ks < 8; ++ks) qf[ks] = *(const GAS bf16x8*)(qp + 16 * ks); }
    f32x16 acc[8];
#pragma unroll
    for (int c8 = 0; c8 < 8; ++c8)
#pragma unroll
        for (int i = 0; i < 16; ++i) acc[c8][i] = 0.f;
    RT_WAITBAR(0);
#pragma unroll
    for (int c8 = 0; c8 < 8; ++c8)
        {
#pragma unroll
          for (int ks = 0; ks < 8; ++ks) { const int row = 32 * c8 + r; const bf16x8 sf = *(const LAS bf16x8*)(F.lds + RC_ST + row * 256 + (((2 * ks + hh) ^ (row & 15)) * 16)); acc[c8] = MFMA32(qf[ks], sf, acc[c8]); } __builtin_amdgcn_sched_barrier(0); }
    int t1v = 32 * w + 4 * hh + 1; asm volatile("" : "+v"(t1v));
#pragma unroll
    for (int i = 0; i < 16; ++i) { const float sc = __builtin_amdgcn_exp2f((float)(t1v + (i & 3) + 8 * (i >> 2)) * l2g);
#pragma unroll
        for (int c8 = 0; c8 < 8; ++c8) acc[c8][i] *= sc; }
    const int sbmax = w | 1;
    __syncthreads();
    LAS unsigned char* qsl = F.lds + RC_ST + w * 8192 + lane * 16;
#pragma unroll
    for (int ks = 0; ks < 8; ++ks) *(LAS bf16x8*)(qsl + ks * 1024) = qf[ks];
    rt_dma_block(QK, V, mbase + 64, hd, ring + 2 * RT_BLK, w, lane);
#pragma unroll
    for (int sb = 0; sb < 8; ++sb) {
        LAS unsigned char* buf = ring + (sb % 3) * RT_BLK;
        if (sb == 0) RT_WAITBAR(3); else if (sb < 7) RT_WAITBAR(3); else RT_WAITBAR(0);
        if (sb >= 1 && sb + 2 < 8) rt_dma_block(QK, V, mbase + 32 * (sb + 2), hd, ring + ((sb + 2) % 3) * RT_BLK, w, lane);
        if (sb <= sbmax) {
            f32x16 X;
#pragma unroll
            for (int i = 0; i < 16; ++i) X[i] = 0.f;
#pragma unroll
            for (int ks = 0; ks < 8; ++ks) { const bf16x8 kf = *(const LAS bf16x8*)(buf + RT_K + (ks >> 1) * 2048 + r * 64 + (ks & 1) * 32 + hh * 16); const bf16x8 qv = *(const LAS bf16x8*)(qsl + ks * 1024); X = MFMA32(kf, qv, X); }
            int tcv = 32 * w + r - 32 * sb - 4 * hh; asm volatile("" : "+v"(tcv));
#pragma unroll
            for (int i = 0; i < 16; ++i) { const int dt = tcv - ((i & 3) + 8 * (i >> 2)); X[i] *= __builtin_amdgcn_exp2f((float)(dt < 0 ? -dt : dt) * l2g); }
            bf16x8 pa[2];
#pragma unroll
            for (int s2 = 0; s2 < 2; ++s2) { v4u p; p[0] = cvtpk2(X[8 * s2], X[8 * s2 + 1]); p[1] = cvtpk2(X[8 * s2 + 2], X[8 * s2 + 3]); p[2] = cvtpk2(X[8 * s2 + 4], X[8 * s2 + 5]); p[3] = cvtpk2(X[8 * s2 + 6], X[8 * s2 + 7]);
                pa[s2] = __builtin_bit_cast(bf16x8, p); }
#pragma unroll
            for (int c4 = 0; c4 < 4; ++c4) {
                s16x4 lo[2][2], hi[2][2];
#pragma unroll
                for (int q = 0; q < 2; ++q)
#pragma unroll
                    for (int s2 = 0; s2 < 2; ++s2) tr_issue(lo[q][s2], hi[q][s2], buf + RT_V + (2 * c4 + q) * 2048 + s2 * 1024 + lane_off);
                asm volatile("s_waitcnt lgkmcnt(0)" : "+v"(lo[0][0]), "+v"(hi[0][0]), "+v"(lo[0][1]), "+v"(hi[0][1]), "+v"(lo[1][0]), "+v"(hi[1][0]), "+v"(lo[1][1]), "+v"(hi[1][1]) :: "memory");
#pragma unroll
                for (int q = 0; q < 2; ++q)
#pragma unroll
                    for (int s2 = 0; s2 < 2; ++s2) acc[2 * c4 + q] = MFMA32(pa[s2], TR_JOIN(lo[q][s2], hi[q][s2]), acc[2 * c4 + q]);
            }
        }
    }
    __syncthreads();
    LAS unsigned char* stg = F.lds + w * (32 * RC_STG);
    LAS unsigned char* stgl = stg + 4 * hh * RC_STG + 2 * r;
#pragma unroll
    for (int i = 0; i < 16; ++i) {
        float s = 0.f;
#pragma unroll
        for (int c8 = 0; c8 < 8; ++c8) s += acc[c8][i];
        s += __shfl_xor(s, 1); s += __shfl_xor(s, 2); s += __shfl_xor(s, 4); s += __shfl_xor(s, 8); s += __shfl_xor(s, 16);
        const float mu = s * (1.0f / DV); float q = 0.f;
#pragma unroll
        for (int c8 = 0; c8 < 8; ++c8) { const float d = acc[c8][i] - mu; q += d * d; }
        q += __shfl_xor(q, 1); q += __shfl_xor(q, 2); q += __shfl_xor(q, 4); q += __shfl_xor(q, 8); q += __shfl_xor(q, 16);
        const float rs = 1.0f / sqrtf(q * (1.0f / DV) + EPS);
        LAS unsigned short* srow = (LAS unsigned short*)(stgl + ((i & 3) + 8 * (i >> 2)) * RC_STG);
#pragma unroll
        for (int c8 = 0; c8 < 8; ++c8) srow[32 * c8] = (unsigned short)(cvtpk2((acc[c8][i] - mu) * rs, 0.f) & 0xffffu);
    }
    v4u ogv[16];
#pragma unroll
    for (int i = 0; i < 16; ++i) { const int idx = lane + 64 * i, row = idx >> 5, ch = idx & 31; const size_t mrow = mbase + 32 * w + row;
        ogv[i] = *(const GAS v4u*)(Rb + (mrow >> 8) * 1048576 + (mrow & 255) * 2048 + hd * DV + ch * 8); }
    LDS_WAIT(); asm volatile("" ::: "memory");
#pragma unroll
    for (int i = 0; i < 16; ++i) { const int idx = lane + 64 * i, row = idx >> 5, ch = idx & 31;
        const v4u y = *(const LAS v4u*)(stg + row * RC_STG + ch * 16);
        const size_t mrow = mbase + 32 * w + row; const v4u og = ogv[i]; bf16* op = OUTP + (dummy_out ? mrow * 1024 : (mrow >> 8) * 1048576 + (mrow & 255) * 2048) + hd * DV + ch * 8;
        const float* gw = F.ret_gn_w + hd * DV + ch * 8; const f32x4 g0 = *(const f32x4*)gw, g1 = *(const f32x4*)(gw + 4); v4u o;
        o[0] = cvtpk2(pg8::bflo(y[0]) * g0[0] * pg8::bflo(og[0]), pg8::bfhi(y[0]) * g0[1] * pg8::bfhi(og[0]));
        o[1] = cvtpk2(pg8::bflo(y[1]) * g0[2] * pg8::bflo(og[1]), pg8::bfhi(y[1]) * g0[3] * pg8::bfhi(og[1]));
        o[2] = cvtpk2(pg8::bflo(y[2]) * g1[0] * pg8::bflo(og[2]), pg8::bfhi(y[2]) * g1[1] * pg8::bfhi(og[2]));
        o[3] = cvtpk2(pg8::bflo(y[3]) * g1[2] * pg8::bflo(og[3]), pg8::bfhi(y[3]) * g1[3] * pg8::bfhi(og[3]));
        *(GAS v4u*)op = o; }
    __syncthreads();
}
__device__ __forceinline__ void p8_final(Frame& F, float* outp) {
    const int lane_ = pg8::lane_id_v(), tid_ = F.wave * 64 + lane_; (void)tid_;
    const float* ssq = (const float*)(F.ws + WS_SSQ3);
    const int gw = F.vcu * NWAVES + F.wave, NGW = F.G * NWAVES;
    f32x4 wv[4];
#pragma unroll
    for (int j = 0; j < 4; ++j) wv[j] = *(const f32x4*)(F.final_norm_w + 4 * lane_ + 256 * j);
    for (int m = gw; m < M; m += NGW) {
        float s = (lane_ < 16) ? ssq[(size_t)m * 16 + lane_] : 0.f; s = wave_sum(s);
        const float rstd = 1.0f / sqrtf(s * (1.0f / D) + EPS);
        const GAS f32x4* xr = (const GAS f32x4*)(F.out + (size_t)m * D) + lane_; GAS f32x4* xo = (GAS f32x4*)(outp + (size_t)m * D) + lane_;
#pragma unroll
        for (int j = 0; j < 4; ++j) { const f32x4 v = xr[64 * j]; xo[64 * j] = v * rstd * wv[j]; }
    }
}

namespace pg8 {
struct EpiRes2Norm {
    static constexpr int EPI_ID = 6;
    static constexpr bool PERM = true, AFTER_DRAIN = true, HAS_MID = false;
    const float* h1; float* out; const float* modf; const float* wf; float* ssq; unsigned* cnt; unsigned* tmo;
    __device__ __forceinline__ void mid(f32x4 (&)[2][2][4][2], const Unit&, int, int, int, int) const {}
    __device__ __forceinline__ void fused(f32x4 (&acc)[2][2][4][2], const Unit& u, int wr, int wc, int fr_, int fq_, PG8_LAS unsigned char* lds, int wid, int lane) const {
        int fr = fr_, fq = fq_; asm volatile("" : "+v"(fr), "+v"(fq));
        const int rl0 = wr * 64 + fr, row0 = u.pm * BM + rl0, col0 = u.pn * BM + wc * 32 + 8 * fq, b = u.pm >> 4;
        PG8_LAS float* P = (PG8_LAS float*)lds;
        { f32x4 g2[2][2];
#pragma unroll
          for (int bj = 0; bj < 2; ++bj)
#pragma unroll
            for (int n = 0; n < 2; ++n) g2[bj][n] = *(const f32x4*)(modf + b * 6144 + 5120 + col0 + bj * HALF + 4 * n);
#pragma unroll
          for (int ai = 0; ai < 2; ++ai)
#pragma unroll
            for (int m = 0; m < 4; ++m) { const size_t off = (size_t)(row0 + ai * HALF + m * 16) * 1024 + col0; float q = 0.f;
#pragma unroll
                for (int bj = 0; bj < 2; ++bj) { const f32x4 x0 = *(const f32x4*)(h1 + off + bj * HALF), x1 = *(const f32x4*)(h1 + off + bj * HALF + 4);
                    const f32x4 h0 = x0 + g2[bj][0] * acc[ai][bj][m][0], hb = x1 + g2[bj][1] * acc[ai][bj][m][1];
                    acc[ai][bj][m][0] = h0; acc[ai][bj][m][1] = hb;
                    q += (h0[0] * h0[0] + h0[1] * h0[1]) + (h0[2] * h0[2] + h0[3] * h0[3]) + (hb[0] * hb[0] + hb[1] * hb[1]) + (hb[2] * hb[2] + hb[3] * hb[3]); }
                q += __shfl_xor(q, 16); q += __shfl_xor(q, 32);
                if (fq == 0) P[(rl0 + ai * HALF + m * 16) * 4 + wc] = q; } }
        asm volatile("s_waitcnt lgkmcnt(0)" ::: "memory"); __builtin_amdgcn_s_barrier(); asm volatile("" ::: "memory");
        { const int t = wid * 64 + lane; if (t < 256) { const f32x4 p = *(const PG8_LAS f32x4*)(P + t * 4); ssq[(size_t)(u.pm * BM + t) * 4 + u.pn] = (p[0] + p[1]) + (p[2] + p[3]); } }
        group_sync(cnt, 4u, tmo, wid);
        f32x4 wv[2][2];
#pragma unroll
        for (int bj = 0; bj < 2; ++bj)
#pragma unroll
            for (int n = 0; n < 2; ++n) wv[bj][n] = *(const f32x4*)(wf + col0 + bj * HALF + 4 * n);
#pragma unroll
        for (int ai = 0; ai < 2; ++ai)
#pragma unroll
            for (int m = 0; m < 4; ++m) { const int row = row0 + ai * HALF + m * 16; const f32x4 p = *(const f32x4*)(ssq + (size_t)row * 4);
                const float rs = 1.0f / sqrtf(((p[0] + p[1]) + (p[2] + p[3])) * (1.0f / 1024.0f) + 1e-6f); const size_t off = (size_t)row * 1024 + col0;
#pragma unroll
                for (int bj = 0; bj < 2; ++bj) { *(f32x4*)(out + off + bj * HALF) = acc[ai][bj][m][0] * rs * wv[bj][0]; *(f32x4*)(out + off + bj * HALF + 4) = acc[ai][bj][m][1] * rs * wv[bj][1]; } }
    }
};
}

#ifndef FF1_ALIGN
#define FF1_ALIGN true
#endif
#ifndef G1_ALIGN
#define G1_ALIGN true
#endif
#ifndef G1_SP2
#define G1_SP2 true
#endif
constexpr int N_PHASES = 10;
struct Args { const void* in[16]; float* out; unsigned char* ws; int ph_lo, ph_hi, use_bar, pad; };
__global__ void __launch_bounds__(NWAVES * 64, 2) hyb_fwd(Args args) {
    extern __shared__ __attribute__((aligned(16))) unsigned char lds[];
    Frame F;
    F.lds = (LAS unsigned char*)lds; F.MISC = (volatile LAS unsigned*)(F.lds + MISC_OFF);
    F.wave = __builtin_amdgcn_readfirstlane((int)threadIdx.x >> 6);
    F.G = gridDim.x; { const int bx = blockIdx.x; F.vcu = (F.G % 8 == 0) ? (bx % 8) * (F.G / 8) + bx / 8 : bx; }
    F.ws = args.ws; F.out = args.out; F.ctl = (gu32*)(args.ws + WS_CTL);
    F.x = (const float*)args.in[0]; F.c = (const float*)args.in[1]; F.positions = (const int*)args.in[2]; F.w_ada = (const float*)args.in[3]; F.b_ada = (const float*)args.in[4];
    F.norm1_w = (const float*)args.in[5]; F.w_in = (const float*)args.in[6]; F.ret_gn_w = (const float*)args.in[7]; F.conv_w = (const float*)args.in[8]; F.w_ret_out = (const float*)args.in[9];
    F.w_conv_out = (const float*)args.in[10]; F.w_o = (const float*)args.in[11]; F.norm2_w = (const float*)args.in[12]; F.w_ff1 = (const float*)args.in[13]; F.w_ff2 = (const float*)args.in[14];
    F.final_norm_w = (const float*)args.in[15];
    for (int u = F.wave * 64 + pg8::lane_id_v(); u < (LDS_BYTES - LDSCTL_OFF) / 4; u += NWAVES * 64) ((LAS unsigned*)(F.lds + LDSCTL_OFF))[u] = 0u;
    __syncthreads();
    XcdBarrier bar; bar.bar = (unsigned*)(F.ctl + CW_BAR); bar.x = 0; bar.st = nullptr;
    if (args.use_bar) bar = xcd_barrier_post((unsigned*)(F.ctl + CW_BAR), F.MISC + 8, F.wave);
    const int lo = args.ph_lo, hi = args.ph_hi;
#ifndef PH_MASK
#define PH_MASK 0x7ff
#endif
#define IN(k) (((PH_MASK >> (k)) & 1) && lo <= (k) && (k) < hi)
#ifndef PH_TWICE
#define PH_TWICE 0
#endif
#define REP(k) for (int rep_ = 0; rep_ < (((PH_TWICE >> (k)) & 1) ? 2 : 1); ++rep_)
#ifdef PH_TA
    unsigned long long ta_ = __builtin_amdgcn_s_memrealtime(), tb_ = ta_;
#define STAMP(id) do { if ((id) == PH_TA) ta_ = __builtin_amdgcn_s_memrealtime(); if ((id) == PH_TB) tb_ = __builtin_amdgcn_s_memrealtime(); } while (0)
#else
#define STAMP(id) do { } while (0)
#endif
#ifdef PH_XSYNC
#define GSYNC(stage) group_sync((unsigned*)(F.ctl + CW_GRP + ((stage) * 64 + 32 + (int)(blockIdx.x & 7)) * 64), 32u, (unsigned*)(F.ctl + CW_BAR + XB_TMO), F.wave)
#else
#define GSYNC(stage) group_sync((unsigned*)(F.ctl + CW_GRP + ((stage) * 64 + gpm_) * 64), 4u, (unsigned*)(F.ctl + CW_BAR + XB_TMO), F.wave)
#endif
#define SEAM(k) do { STAMP(2 * (k)); if (IN(k) && IN((k) + 1)) xcd_barrier(bar, F.wave); STAMP(2 * (k) + 1); } while (0)
    unsigned char* ws = args.ws;
    bf16* U = (bf16*)((unsigned char*)args.out + OUT_U);

#ifdef PH_MAXP0
    const unsigned long long tk0_ = __builtin_amdgcn_s_memrealtime();
    if (IN(0)) { p0_prologue(F); }
    if (F.wave == 0 && pg8::lane_id_v() == 0) __hip_atomic_store((unsigned*)(F.ctl + 16384 + blockIdx.x), (unsigned)(__builtin_amdgcn_s_memrealtime() - tk0_), __ATOMIC_RELAXED, __HIP_MEMORY_SCOPE_AGENT);
    SEAM(0);
    unsigned mx_ = 0, amx_ = 0;
    if (blockIdx.x == 0 && F.wave == 0) { for (int i = 0; i < (int)gridDim.x; ++i) { const unsigned v = __hip_atomic_load((unsigned*)(F.ctl + 16384 + i), __ATOMIC_RELAXED, __HIP_MEMORY_SCOPE_AGENT); if (v > mx_) { mx_ = v; amx_ = i; } } }
#else
    if (IN(0)) REP(0) { p0_prologue(F); } SEAM(0);
#endif
    if (IN(1)) REP(1) { p1_unorm(F); } SEAM(1);
    if (IN(2)) REP(2) {
        pg8::Gemm g{U, (const bf16*)(ws + WS_WIN), M, NPROJ, D, (size_t)256 * D * 2}; pg8::StaticOrder S; S.init(M, NPROJ, F.G, (int)blockIdx.x);
        pg8::EpiProj E{(bf16*)(ws + WS_QK), (bf16*)(ws + WS_V), (bf16*)(ws + WS_R), (bf16*)((unsigned char*)args.out + OUT_Z), F.positions};
        pg8::gemm_phase<pg8::EpiProj, pg8::StaticOrder, G1_ALIGN, G1_SP2>(F.lds + RING_OFF, g, S, E, F.wave);
    } SEAM(2);
    if (IN(3)) {
        const int bh_ = F.vcu >> 4; unsigned* tmo_ = (unsigned*)(F.ctl + CW_BAR + XB_TMO);
        REP(3) { p3a_kvsum(F, F.vcu); } STAMP(30);
        p3a_conv(F, F.vcu); STAMP(31); REP(11) { p3a_bias2(F); }
        STAMP(6); group_sync((unsigned*)(F.ctl + CW_GRP + (4 * 64 + bh_) * 64), 16u, tmo_, F.wave); STAMP(7);
        p3b_scan(F, bh_, F.vcu & 15);
        STAMP(8); group_sync((unsigned*)(F.ctl + CW_GRP + (5 * 64 + bh_) * 64), 16u, tmo_, F.wave); STAMP(9);
        REP(5) { const bool dummy = ((PH_TWICE >> 5) & 1) && rep_ == 0; p3c_retout(F, F.vcu, dummy ? (bf16*)((unsigned char*)args.out + OUT_Z) : (bf16*)(ws + WS_R), dummy); }
    } if (IN(3) && IN(6)) { STAMP(10); xcd_barrier(bar, F.wave); STAMP(11); }
    int gpm_ = 0; { pg8::StaticOrder S; S.init(M, D, F.G, (int)blockIdx.x); pg8::Unit u0; if (S.next(0, u0)) gpm_ = u0.pm; }
#ifdef PH_STAG
    if (IN(6)) { const unsigned long long t0s_ = __builtin_amdgcn_s_memrealtime(), ds_ = (unsigned long long)((gpm_ % PH_STAG_S) * PH_STAG); while (__builtin_amdgcn_s_memrealtime() - t0s_ < ds_) __builtin_amdgcn_s_sleep(4); }
#endif
    if (IN(6)) REP(6) {
        pg8::Gemm g{(const bf16*)(ws + WS_R), (const bf16*)(ws + WS_WRC), M, D, 2 * D, (size_t)2 * MiB}; pg8::StaticOrder S; S.init(M, D, F.G, (int)blockIdx.x);
        pg8::EpiMerge E{(const bf16*)(ws + WS_R), (bf16*)(ws + WS_MERGED)};
        pg8::gemm_phase<pg8::EpiMerge, pg8::StaticOrder, false, true>(F.lds + RING_OFF, g, S, E, F.wave);
    } if (IN(6) && IN(7)) { STAMP(12); GSYNC(0); STAMP(13); }
    if (IN(7)) REP(7) {
        pg8::Gemm g{(const bf16*)(ws + WS_MERGED), (const bf16*)(ws + WS_WO), M, D, D, (size_t)256 * D * 2}; pg8::StaticOrder S; S.init(M, D, F.G, (int)blockIdx.x);
        pg8::EpiRes1 E{F.x, args.out, (bf16*)(ws + WS_HHAT), (const float*)(ws + WS_MODF), F.norm2_w, (float*)(ws + WS_SSQ2)};
        pg8::gemm_phase<pg8::EpiRes1, pg8::StaticOrder, false, true>(F.lds + RING_OFF, g, S, E, F.wave);
    } if (IN(7) && IN(8)) { STAMP(14); GSYNC(1); STAMP(15); }
    if (IN(8)) REP(8) {
        pg8::Gemm g{(const bf16*)(ws + WS_HHAT), (const bf16*)(ws + WS_W1), M, FF, D, (size_t)256 * D * 2}; pg8::StaticOrder S; S.init(M, FF, F.G, (int)blockIdx.x);
        pg8::Unit u0; LAS float* tab = (LAS float*)(F.lds + TAB_OFF); const int tid_ = F.wave * 64 + pg8::lane_id_v();
        if (S.next(0, u0)) { if (tid_ < 256) { const float* sq = (const float*)(ws + WS_SSQ2) + (size_t)(u0.pm * 256 + tid_) * 16; const f32x4 a = *(const f32x4*)sq, b = *(const f32x4*)(sq + 4), c = *(const f32x4*)(sq + 8), d = *(const f32x4*)(sq + 12);
            const float s = ((a[0] + a[1]) + (a[2] + a[3])) + ((b[0] + b[1]) + (b[2] + b[3])) + ((c[0] + c[1]) + (c[2] + c[3])) + ((d[0] + d[1]) + (d[2] + d[3]));
            tab[tid_] = 1.0f / sqrtf(s * (1.0f / D) + EPS); } }
        __syncthreads();
        pg8::EpiFF1 E{(const float*)(ws + WS_BIAS2), (const LAS float*)tab, (bf16*)(ws + WS_HID)};
        pg8::gemm_phase<pg8::EpiFF1, pg8::StaticOrder, FF1_ALIGN, true>(F.lds + RING_OFF, g, S, E, F.wave);
    } if (IN(8) && IN(9)) { STAMP(16); GSYNC(2); STAMP(17); }
    if (IN(9)) {
        pg8::Gemm g{(const bf16*)(ws + WS_HID), (const bf16*)(ws + WS_W2), M, D, FF, (size_t)256 * FF * 2}; pg8::StaticOrder S; S.init(M, D, F.G, (int)blockIdx.x);
        pg8::EpiRes2Norm E{args.out, args.out, (const float*)(ws + WS_MODF), F.final_norm_w, (float*)(ws + WS_SSQ3), (unsigned*)(F.ctl + CW_GRP + (3 * 64 + gpm_) * 64), (unsigned*)(F.ctl + CW_BAR + XB_TMO)};
        pg8::gemm_phase<pg8::EpiRes2Norm, pg8::StaticOrder, false, true>(F.lds + RING_OFF, g, S, E, F.wave);
    }
    STAMP(18); STAMP(19);
#ifdef PH_MAXP0
    if (blockIdx.x == 0 && F.wave == 0) { const unsigned long long te = __builtin_amdgcn_s_memrealtime(), d = (PH_MAXP0 == 1) ? (unsigned long long)mx_ * 4ull : (unsigned long long)amx_ * 100ull; while (__builtin_amdgcn_s_memrealtime() - te < d) __builtin_amdgcn_s_sleep(8); }
#endif
#ifdef PH_TA
    STAMP(20); STAMP(21);
    if ((int)blockIdx.x == PH_BLK && F.wave == 0) { const unsigned long long te = __builtin_amdgcn_s_memrealtime(), d = (tb_ - ta_) * 4ull; while (__builtin_amdgcn_s_memrealtime() - te < d) __builtin_amdgcn_s_sleep(8); }
#endif
#undef IN
#undef SEAM
}

#ifndef HYB_N_LAUNCHES
#define HYB_N_LAUNCHES 1
#endif
extern "C" void kernel_launch(void* const* d_in, const int* in_sizes, int n_in, void* d_out, int out_size, void* d_ws, size_t ws_size, hipStream_t stream) {
    static int grid = 0;
    if (grid == 0) {
        if (n_in != 16 || in_sizes[0] != M * D || out_size != M * D || ws_size < WS_END) { fprintf(stderr, "kernel_launch: unexpected shapes (n_in %d, in0 %d, out %d, ws %zu); nothing launched\n", n_in, n_in > 0 ? in_sizes[0] : -1, out_size, ws_size); grid = -1; return; }
        int dev = 0, cus = 0, per_cu = 0;
        if (hipGetDevice(&dev) != hipSuccess || hipDeviceGetAttribute(&cus, hipDeviceAttributeMultiprocessorCount, dev) != hipSuccess) { grid = -1; return; }
        if (hipFuncSetAttribute((const void*)hyb_fwd, hipFuncAttributeMaxDynamicSharedMemorySize, LDS_BYTES) != hipSuccess) { fprintf(stderr, "kernel_launch: hipFuncSetAttribute failed\n"); grid = -1; return; }
        if (hipOccupancyMaxActiveBlocksPerMultiprocessor(&per_cu, (const void*)hyb_fwd, NWAVES * 64, LDS_BYTES) != hipSuccess || per_cu < 1) { fprintf(stderr, "kernel_launch: occupancy query says %d workgroups per CU; nothing launched\n", per_cu); (void)hipGetLastError(); grid = -1; return; }
        { bool okp = true; pg8::StaticOrder S; for (int c = 0; c < cus && okp; ++c) { S.init(M, FF, cus, c); pg8::Unit u0, u; if (!S.next(0, u0)) continue; for (int i = 1; S.next(i, u); ++i) okp = okp && (u.pm == u0.pm); }
          if (!okp) { fprintf(stderr, "kernel_launch: FF1's unit order does not keep a workgroup inside one row panel on %d CUs; nothing launched\n", cus); grid = -1; return; } }
        { bool okp = true; pg8::StaticOrder S1, S4; for (int c = 0; c < cus && okp; ++c) { S1.init(M, D, cus, c); S4.init(M, FF, cus, c); pg8::Unit a, b2; okp = S1.next(0, a) && S4.next(0, b2) && a.pm == b2.pm && !S1.next(1, b2); }
          if (!okp || cus != 256) { fprintf(stderr, "kernel_launch: the row-panel chain needs 256 CUs with one N=1024 unit each in the panel of their FF1 units; nothing launched\n"); grid = -1; return; } }
        grid = cus;
        if (grid != 256) fprintf(stderr, "kernel_launch: %d CUs (built for 256)\n", grid);
    }
    if (grid < 0) return;
    (void)hipMemsetAsync((char*)d_ws + WS_CTL, 0, CTL_ZERO_BYTES, stream);
    Args a{};
    for (int i = 0; i < 16; ++i) a.in[i] = d_in[i];
    a.out = (float*)d_out; a.ws = (unsigned char*)d_ws;
#if HYB_N_LAUNCHES == 1
    a.ph_lo = 0; a.ph_hi = N_PHASES; a.use_bar = 1;
    hipLaunchKernelGGL(hyb_fwd, dim3(grid), dim3(NWAVES * 64), LDS_BYTES, stream, a);
#ifdef PH_WHOLE2
    (void)hipMemsetAsync((char*)d_ws + WS_CTL, 0, CTL_ZERO_BYTES, stream);
    hipLaunchKernelGGL(hyb_fwd, dim3(grid), dim3(NWAVES * 64), LDS_BYTES, stream, a);
#endif
#else
    for (int p = 0; p < N_PHASES; ++p) { a.ph_lo = p; a.ph_hi = p + 1; a.use_bar = 0; hipLaunchKernelGGL(hyb_fwd, dim3(grid), dim3(NWAVES * 64), LDS_BYTES, stream, a); }
#endif
}
```

```cpp
#include <hip/hip_runtime.h>
#include <cstdio>
#include <cstdint>
namespace pg8 {
#define PG8_LAS __attribute__((address_space(3)))
typedef unsigned short bf16_t;
typedef short bf16x8 __attribute__((ext_vector_type(8)));
typedef float f32x4 __attribute__((ext_vector_type(4)));
typedef unsigned u32x4 __attribute__((ext_vector_type(4)));
constexpr int BM = 256, BK = 64, HALF = 128, HTB = HALF * BK * 2  , STAGE_BYTES = 8 * HTB, NXCD = 8, WGM = 8;

__host__ __device__ __forceinline__ int lds_byte(int r, int c) { const int st = (r >> 4) * 2 + (c >> 5), rr = r & 15, cc = c & 31, ob = rr * 64 + cc * 2; return st * 1024 + (ob ^ (((ob >> 9) & 1) << 5)); }
__host__ __device__ __forceinline__ void stage_rc(int b, int& R, int& C) { const int st = b / 1024, sb = b % 1024, swz = sb ^ (((sb >> 9) & 1) << 5); R = (st >> 1) * 16 + swz / 64; C = (st & 1) * 32 + (swz % 64) / 2; }
__host__ __device__ __forceinline__ int perm32(int rho) { const int n = rho >> 4, i = rho & 15; return 8 * (i >> 2) + 4 * n + (i & 3); }

struct Unit { int pm, pn; };
struct Gemm { const bf16_t* A; const bf16_t* Bt; int M, N, K; size_t a_pstride; int a_lda; size_t a_kstep; int a_cbstride; };

struct StaticOrder {
    int nM, nN, nwg, G, c;
    __host__ __device__ void init(int M, int N, int G_, int c_) { nM = M / BM; nN = N / BM; nwg = nM * nN; G = G_; c = c_; }
    __host__ __device__ bool next(int i, Unit& u) const {
        const long L = (long)i * G + c; if (L >= nwg) return false;
        int wgid = (int)L; { const int q = nwg / NXCD, r = nwg % NXCD, xcd = wgid % NXCD, off = wgid / NXCD; wgid = (xcd < r ? xcd * (q + 1) : r * (q + 1) + (xcd - r) * q) + off; }
        const int nig = WGM * nN, gid = wgid / nig, fm = gid * WGM, gsz = (nM - fm) < WGM ? (nM - fm) : WGM;
        u.pm = fm + ((wgid % nig) % gsz); u.pn = (wgid % nig) / gsz; return true;
    }
    __device__ __forceinline__ void a_ready(const Unit&) const {}
    __device__ __forceinline__ void done(const Unit&) const {}
};

__device__ __forceinline__ unsigned cvt_pk_bf16(float lo, float hi) { unsigned r; asm volatile("v_cvt_pk_bf16_f32 %0, %1, %2" : "=v"(r) : "v"(lo), "v"(hi)); return r; }
typedef float f32x2 __attribute__((ext_vector_type(2)));
__device__ __forceinline__ int lane_id_v() { int l; asm volatile("v_mbcnt_lo_u32_b32 %0, -1, 0\n\tv_mbcnt_hi_u32_b32 %0, -1, %0" : "=v"(l)); return l; }
typedef __amdgpu_buffer_rsrc_t rsrc_t;
typedef unsigned v2u_t __attribute__((ext_vector_type(2)));
__device__ __forceinline__ rsrc_t mk_rsrc(const void* base, unsigned bytes) { return __builtin_amdgcn_make_buffer_rsrc((void*)base, 0, bytes, 0x00020000); }
__device__ __forceinline__ void st8_wt(rsrc_t r, unsigned off, v2u_t v) { __builtin_amdgcn_raw_buffer_store_b64(v, r, off, 0, 16); }
__device__ __forceinline__ void st16_wt(rsrc_t r, unsigned off, u32x4 v) { __builtin_amdgcn_raw_buffer_store_b128(v, r, off, 0, 16); }
struct OrderG1 : StaticOrder {
    __host__ __device__ bool next(int i, Unit& u) const { if (!StaticOrder::next(i, u)) return false; const int r = u.pn >> 2; u.pn = (int)((0x10765432u >> (4 * r)) & 7u) * 4 + (u.pn & 3); return true; }
};
typedef unsigned u32x2 __attribute__((ext_vector_type(2)));
__device__ __forceinline__ unsigned cvtpk(float lo, float hi) { typedef float f2_t __attribute__((ext_vector_type(2))); typedef __bf16 b2_t __attribute__((ext_vector_type(2))); f2_t v = {lo, hi}; b2_t b = __builtin_convertvector(v, b2_t); return __builtin_bit_cast(unsigned, b); }
__device__ __forceinline__ float bflo(unsigned w) { return __builtin_bit_cast(float, w << 16); }
__device__ __forceinline__ float bfhi(unsigned w) { return __builtin_bit_cast(float, w & 0xffff0000u); }
__device__ __forceinline__ float fast_rcp(float x) { return __builtin_amdgcn_rcpf(x); }
__device__ __forceinline__ float sigmoidf_(float x) { return fast_rcp(1.0f + __expf(-x)); }
__device__ __forceinline__ void sincos_rev(float ang, float& s, float& c) {
    const float I2P = 0.15915493667125702f, I2P_LO = 6.420638326565253e-09f;
    const float r = ang * I2P; float e = __builtin_fmaf(ang, I2P, -r); e = __builtin_fmaf(ang, I2P_LO, e);
    const float k = __builtin_rintf(r); const float f = (r - k) + e;
    s = __builtin_amdgcn_sinf(f); c = __builtin_amdgcn_cosf(f);
}
__device__ __forceinline__ u32x4 pack8(const f32x4 a, const f32x4 b) { u32x4 w; w.x = cvtpk(a[0], a[1]); w.y = cvtpk(a[2], a[3]); w.z = cvtpk(b[0], b[1]); w.w = cvtpk(b[2], b[3]); return w; }

__device__ __forceinline__ float dpp_ror1(float x) { float r; asm volatile("s_nop 1\n\tv_mov_b32_dpp %0, %1 row_ror:1 row_mask:0xf bank_mask:0xf" : "=v"(r) : "v"(x)); return r; }
__device__ __forceinline__ float dpp_ror2(float x) { float r; asm volatile("s_nop 1\n\tv_mov_b32_dpp %0, %1 row_ror:2 row_mask:0xf bank_mask:0xf" : "=v"(r) : "v"(x)); return r; }
struct EpiProj {
    static constexpr int EPI_ID = 1;
    static constexpr bool PERM = true, AFTER_DRAIN = false, HAS_MID = false;
    bf16_t* QK; bf16_t* V; bf16_t* R; bf16_t* Z; const int* pos; bf16_t* HALO; const float* conv_w; PG8_LAS f32x4* xl; unsigned* cbcnt; bf16_t* CB01; bool same;
    __device__ __forceinline__ void mid(f32x4 (&)[2][2][4][2], const Unit&, int, int, int, int) const {}
    __device__ __forceinline__ void operator()(const f32x4 (&acc)[2][2][4][2], const Unit& u, int wr, int wc, int fr, int fq) const {
        const int row0 = u.pm * BM + wr * 64 + fr, cw = wc * 32 + 8 * fq, pn = u.pn;
        if (pn < 4) {
            const float ksc = pn >= 2 ? 0.08838834764831845f : 1.0f;
            const int g = 4 * wc + fq; float invf[4];
#pragma unroll
            for (int i = 0; i < 4; ++i) invf[i] = exp2f(-(float)(4 * g + i) * (13.287712379549449f / 64.0f));
            int posv[2][4];
#pragma unroll
            for (int ai = 0; ai < 2; ++ai)
#pragma unroll
                for (int m = 0; m < 4; ++m) posv[ai][m] = pos[row0 + ai * HALF + m * 16];
            __builtin_amdgcn_sched_barrier(0);
#pragma unroll
            for (int ai = 0; ai < 2; ++ai)
#pragma unroll
                for (int m = 0; m < 4; ++m) { const int row = row0 + ai * HALF + m * 16; const float p = (float)posv[ai][m];
                    f32x4 cs, sn;
#pragma unroll
                    for (int i = 0; i < 4; ++i) { float s_, c_; sincos_rev(p * invf[i], s_, c_); cs[i] = c_ * ksc; sn[i] = s_ * ksc; }
                    bf16_t* rowp = QK + (size_t)u.pm * 262144 + (size_t)(pn * 8 + wc) * 8192 + (size_t)(row - u.pm * BM) * 32 + 8 * fq;
#pragma unroll
                    for (int bj = 0; bj < 2; ++bj) { const f32x4 x1 = acc[ai][bj][m][0], x2 = acc[ai][bj][m][1];
                        const f32x4 o1 = x1 * cs - x2 * sn, o2 = x1 * sn + x2 * cs;
                        *(u32x4*)(rowp + bj * (4 * 8192)) = pack8(o1, o2); } }
        } else if (pn >= 16) {
            const int c = pn - 16, pn2 = c >> 2, bjc = (c >> 1) & 1, nc = c & 1;
#define ZV(ai, m) (acc[ai][0][m][1] * acc[ai][1][m][0])
            if (fr >= 14) {
                if (wr == 0) {
#pragma unroll
                    for (int ai = 0; ai < 2; ++ai) xl[((ai * 4 + wc) * 2 + (fr & 1)) * 4 + fq] = ZV(ai, 3);
                } else xl[((2 * 4 + wc) * 2 + (fr & 1)) * 4 + fq] = ZV(0, 3); }
            __syncthreads();
            const int rl0 = wr * 64 + fr, ch0 = 256 * pn2 + 128 * bjc + 32 * wc + 8 * fq + 4 * nc;
            bf16_t* ap = R + (size_t)u.pm * 1048576 + (size_t)(32 + (ch0 >> 5)) * 8192 + (ch0 & 31);
            unsigned char* G8 = (unsigned char*)R + (size_t)u.pm * 2097152 + 1048576 + (size_t)pn2 * 65536 + (size_t)(wr * 4 + wc) * 8192 + (fq * 16 + fr) * 16 + 4 * (2 * bjc + nc);
            const f32x4 w0 = *(const f32x4*)(conv_w + ch0), w1 = *(const f32x4*)(conv_w + 1024 + ch0), w2 = *(const f32x4*)(conv_w + 2048 + ch0);
#pragma unroll
            for (int ai = 0; ai < 2; ++ai) {
                f32x4 zp = {0.f, 0.f, 0.f, 0.f};
                if (wr == 1) zp = xl[((ai * 4 + wc) * 2 + (fr & 1)) * 4 + fq];
                else if (ai == 1) zp = xl[((2 * 4 + wc) * 2 + (fr & 1)) * 4 + fq];
                f32x4 p1, p2;
#pragma unroll
                for (int e = 0; e < 4; ++e) { p1[e] = dpp_ror1(zp[e]); p2[e] = dpp_ror2(zp[e]); }
#pragma unroll
                for (int m = 0; m < 4; ++m) { const f32x4 zc = ZV(ai, m), cb = acc[ai][0][m][0], gp = acc[ai][1][m][1]; f32x4 cz, c1, c2;
#pragma unroll
                    for (int e = 0; e < 4; ++e) { c1[e] = dpp_ror1(zc[e]); c2[e] = dpp_ror2(zc[e]);
                        const float z1 = fr >= 1 ? c1[e] : p1[e], z2 = fr >= 2 ? c2[e] : p2[e];
                        cz[e] = w0[e] * z2 + w1[e] * z1 + w2[e] * zc[e]; }
                    p1 = c1; p2 = c2;
                    const int rl = rl0 + ai * HALF + m * 16;
                    u32x2 o; o.x = cvtpk(cb[0] * cz[0], cb[1] * cz[1]); o.y = cvtpk(cb[2] * cz[2], cb[3] * cz[3]);
                    *(u32x2*)(ap + (size_t)rl * 32) = o;
                    unsigned d = 0u;
#pragma unroll
                    for (int e = 0; e < 4; ++e) d |= (unsigned)(255.0f * sigmoidf_(gp[e]) + 0.5f) << (8 * e);
                    *(unsigned*)(G8 + (ai * 4 + m) * 1024) = d;
                    if (ai == 0 && m == 0 && wr == 0 && fr < 2) { u32x2 w; w.x = cvtpk(cb[0], cb[1]); w.y = cvtpk(cb[2], cb[3]); *(u32x2*)(CB01 + ((size_t)(u.pm * 2 + fr) * 1024 + ch0)) = w; }
                    if (ai == 1 && m == 3 && wr == 1 && fr >= 14) { u32x2 w; w.x = cvtpk(zc[0], zc[1]); w.y = cvtpk(zc[2], zc[3]);
                        st8_wt(mk_rsrc(HALO, 64 * 2 * 1024 * 2), (unsigned)(((u.pm * 2 + (fr - 14)) * 1024 + ch0) * 2), __builtin_bit_cast(v2u_t, w)); } } }
#undef ZV
        } else {
            if (pn >= 12) {
                unsigned char* G = (unsigned char*)R + (size_t)u.pm * 2097152 + 1048576 + 262144 + (size_t)(pn & 3) * 65536 + (size_t)(wr * 4 + wc) * 8192 + (fq * 16 + fr) * 16;
#pragma unroll
                for (int ai = 0; ai < 2; ++ai)
#pragma unroll
                    for (int m = 0; m < 4; ++m) { u32x4 w;
#pragma unroll
                        for (int bj = 0; bj < 2; ++bj)
#pragma unroll
                            for (int n = 0; n < 2; ++n) { const f32x4 v = acc[ai][bj][m][n]; unsigned d = 0u;
#pragma unroll
                                for (int i = 0; i < 4; ++i) d |= (unsigned)(255.0f * sigmoidf_(v[i]) + 0.5f) << (8 * i);
                                w[2 * bj + n] = d; }
                        *(u32x4*)(G + (ai * 4 + m) * 1024) = w; }
            } else {
            bf16_t* base; int mode;
            if (pn < 8) { base = V + (size_t)u.pm * 262144 + (size_t)((pn - 4) * 8 + wc) * 8192; mode = 0; }
            else { base = R + (size_t)u.pm * 1048576 + (size_t)((pn - 8) * 8 + wc) * 8192; mode = 1; }
            const int rl0 = wr * 64 + fr;
#pragma unroll
            for (int ai = 0; ai < 2; ++ai)
#pragma unroll
                for (int m = 0; m < 4; ++m) { const int rl = rl0 + ai * HALF + m * 16; bf16_t* rowp = base + (size_t)rl * 32 + 8 * fq;
#pragma unroll
                    for (int bj = 0; bj < 2; ++bj) { f32x4 v0 = acc[ai][bj][m][0], v1 = acc[ai][bj][m][1];
                        if (mode != 0) {
#pragma unroll
                            for (int i = 0; i < 4; ++i) { v0[i] *= sigmoidf_(v0[i]); v1[i] *= sigmoidf_(v1[i]); } }
                        *(u32x4*)(rowp + bj * (4 * 8192)) = pack8(v0, v1); } }
            }
        }
    }
};

struct EpiMerge {
    static constexpr int EPI_ID = 2;
    static constexpr bool PERM = true, AFTER_DRAIN = false, HAS_MID = true;
    const bf16_t* R; bf16_t* MERGED;
#define MG_LOAD(buf, k) do { _Pragma("unroll") for (int mm = 0; mm < 2; ++mm) { const unsigned char* pp = G + (((k) >> 1) * 4 + 2 * ((k) & 1) + mm) * 1024; \
        buf[mm][0] = *(const u32x4*)pp; buf[mm][1] = *(const u32x4*)(pp + 262144); } __builtin_amdgcn_sched_barrier(0); } while (0)
#define MG_USE(buf, k) do { _Pragma("unroll") for (int mm = 0; mm < 2; ++mm) _Pragma("unroll") for (int bj = 0; bj < 2; ++bj) _Pragma("unroll") for (int n = 0; n < 2; ++n) _Pragma("unroll") for (int e = 0; e < 4; ++e) { \
        const float a = (float)((buf[mm][0][2 * bj + n] >> (8 * e)) & 0xffu), b = fmaxf((float)((buf[mm][1][2 * bj + n] >> (8 * e)) & 0xffu), 1.0f); \
        acc[(k) >> 1][bj][2 * ((k) & 1) + mm][n][e] *= a * fast_rcp(b); } __builtin_amdgcn_sched_barrier(0); } while (0)
    __device__ __forceinline__ void mid(f32x4 (&acc)[2][2][4][2], const Unit& u, int wr, int wc, int fr, int fq) const {
        const unsigned char* G = (const unsigned char*)R + (size_t)u.pm * 2097152 + 1048576 + (size_t)u.pn * 65536 + (size_t)(wr * 4 + wc) * 8192 + (fq * 16 + fr) * 16;
        u32x4 bufA[2][2], bufB[2][2], bufC[2][2], bufD[2][2];
        MG_LOAD(bufA, 0); MG_LOAD(bufB, 1); MG_LOAD(bufC, 2); MG_LOAD(bufD, 3);
        MG_USE(bufA, 0); MG_USE(bufB, 1); MG_USE(bufC, 2); MG_USE(bufD, 3);
    }
#undef MG_LOAD
#undef MG_USE
    __device__ __forceinline__ void operator()(const f32x4 (&acc)[2][2][4][2], const Unit& u, int wr, int wc, int fr, int fq) const {
        const int rl0 = wr * 64 + fr, col0 = u.pn * BM + wc * 32 + 8 * fq; const unsigned char* G = (const unsigned char*)R + (size_t)u.pm * 2097152 + 1048576 + 262144 + (size_t)u.pn * 65536 + (size_t)(wr * 4 + wc) * 8192 + (fq * 16 + fr) * 16;
        u32x4 gb[2][4];
#pragma unroll
        for (int ai = 0; ai < 2; ++ai)
#pragma unroll
            for (int m = 0; m < 4; ++m) gb[ai][m] = *(const u32x4*)(G + (ai * 4 + m) * 1024);
        __builtin_amdgcn_sched_barrier(0);
#pragma unroll
        for (int ai = 0; ai < 2; ++ai)
#pragma unroll
            for (int m = 0; m < 4; ++m) { bf16_t* op = MERGED + (size_t)u.pm * 262144 + (size_t)(u.pn * 8 + wc) * 8192 + (size_t)(rl0 + ai * HALF + m * 16) * 32 + 8 * fq;
#pragma unroll
                for (int bj = 0; bj < 2; ++bj) { const unsigned g0 = gb[ai][m][2 * bj], g1 = gb[ai][m][2 * bj + 1]; f32x4 v0 = acc[ai][bj][m][0], v1 = acc[ai][bj][m][1];
#pragma unroll
                    for (int e = 0; e < 4; ++e) { v0[e] *= fmaxf((float)((g0 >> (8 * e)) & 0xffu), 1.0f) * (1.0f / 255.0f); v1[e] *= fmaxf((float)((g1 >> (8 * e)) & 0xffu), 1.0f) * (1.0f / 255.0f); }
                    *(u32x4*)(op + bj * (4 * 8192)) = pack8(v0, v1); } }
    }
};

struct EpiRes1 {
    static constexpr int EPI_ID = 3;
    static constexpr bool PERM = true, AFTER_DRAIN = false, HAS_MID = false;
    const float* x; bf16_t* h1b; bf16_t* hhat; const float* modf; const float* norm2w; float* ssq;
    __device__ __forceinline__ void mid(f32x4 (&)[2][2][4][2], const Unit&, int, int, int, int) const {}
    __device__ __forceinline__ void operator()(f32x4 (&acc)[2][2][4][2], const Unit& u, int wr, int wc, int fr, int fq) const {
        const int row0 = u.pm * BM + wr * 64 + fr, col0 = u.pn * BM + wc * 32 + 8 * fq, b = u.pm >> 4;
        { f32x4 g1[2][2];
#pragma unroll
          for (int bj = 0; bj < 2; ++bj)
#pragma unroll
            for (int n = 0; n < 2; ++n) g1[bj][n] = *(const f32x4*)(modf + b * 6144 + 2048 + col0 + bj * HALF + 4 * n);
#pragma unroll
          for (int ai = 0; ai < 2; ++ai) {
            f32x4 xv[4][2][2];
#pragma unroll
            for (int m = 0; m < 4; ++m) { const size_t off = (size_t)(row0 + ai * HALF + m * 16) * 1024 + col0;
#pragma unroll
                for (int bj = 0; bj < 2; ++bj) { xv[m][bj][0] = *(const f32x4*)(x + off + bj * HALF); xv[m][bj][1] = *(const f32x4*)(x + off + bj * HALF + 4); } }
            __builtin_amdgcn_sched_barrier(0);
#pragma unroll
            for (int m = 0; m < 4; ++m) { const int row = row0 + ai * HALF + m * 16; float q = 0.f;
#pragma unroll
                for (int bj = 0; bj < 2; ++bj) { const f32x4 h0 = xv[m][bj][0] + g1[bj][0] * acc[ai][bj][m][0], hb = xv[m][bj][1] + g1[bj][1] * acc[ai][bj][m][1];
                    acc[ai][bj][m][0] = h0; acc[ai][bj][m][1] = hb;
                    q += (h0[0] * h0[0] + h0[1] * h0[1]) + (h0[2] * h0[2] + h0[3] * h0[3]) + (hb[0] * hb[0] + hb[1] * hb[1]) + (hb[2] * hb[2] + hb[3] * hb[3]); }
                q += __shfl_xor(q, 16); q += __shfl_xor(q, 32);
                if (fq == 0) ssq[(size_t)row * 16 + u.pn * 4 + wc] = q; }
            __builtin_amdgcn_sched_barrier(0);
          } }
        f32x4 cs[2][2];
#pragma unroll
        for (int bj = 0; bj < 2; ++bj)
#pragma unroll
            for (int n = 0; n < 2; ++n) { const int c = col0 + bj * HALF + 4 * n; const f32x4 sc = *(const f32x4*)(modf + b * 6144 + 4096 + c), w = *(const f32x4*)(norm2w + c); cs[bj][n] = w * (sc + 1.0f); }
#pragma unroll
        for (int ai = 0; ai < 2; ++ai)
#pragma unroll
            for (int m = 0; m < 4; ++m) { const size_t off = (size_t)u.pm * 262144 + (size_t)(u.pn * 8 + wc) * 8192 + (size_t)(row0 - u.pm * BM + ai * HALF + m * 16) * 32 + 8 * fq;
#pragma unroll
                for (int bj = 0; bj < 2; ++bj) *(u32x4*)(hhat + off + bj * (4 * 8192)) = pack8(acc[ai][bj][m][0] * cs[bj][0], acc[ai][bj][m][1] * cs[bj][1]); }
    }
};

struct EpiFF1 {
    static constexpr int EPI_ID = 4;
    static constexpr bool PERM = true, AFTER_DRAIN = false, HAS_MID = false;
    const float* bias2; const PG8_LAS float* rstd; bf16_t* HID;
    __device__ __forceinline__ void mid(f32x4 (&)[2][2][4][2], const Unit&, int, int, int, int) const {}
    __device__ __forceinline__ void operator()(const f32x4 (&acc)[2][2][4][2], const Unit& u, int wr, int wc, int fr, int fq) const {
        const int rl0 = wr * 64 + fr, col0 = u.pn * BM + wc * 32 + 8 * fq, b = u.pm >> 4;
        f32x4 bv[2][2];
#pragma unroll
        for (int bj = 0; bj < 2; ++bj)
#pragma unroll
            for (int n = 0; n < 2; ++n) bv[bj][n] = *(const f32x4*)(bias2 + b * 4096 + col0 + bj * HALF + 4 * n);
#pragma unroll
        for (int ai = 0; ai < 2; ++ai)
#pragma unroll
            for (int m = 0; m < 4; ++m) { const int rl = rl0 + ai * HALF + m * 16; const float rs = rstd[rl]; bf16_t* op = HID + (size_t)u.pm * 1048576 + (size_t)(u.pn * 8 + wc) * 8192 + (size_t)rl * 32 + 8 * fq;
#pragma unroll
                for (int bj = 0; bj < 2; ++bj) { f32x4 v0 = acc[ai][bj][m][0] * rs + bv[bj][0], v1 = acc[ai][bj][m][1] * rs + bv[bj][1];
#pragma unroll
                    for (int i = 0; i < 4; ++i) { const float a = fmaxf(v0[i], 0.f), c = fmaxf(v1[i], 0.f); v0[i] = a * a; v1[i] = c * c; }
                    *(u32x4*)(op + bj * (4 * 8192)) = pack8(v0, v1); } }
    }
};

struct EpiRes2 {
    static constexpr int EPI_ID = 5;
    static constexpr bool PERM = true, AFTER_DRAIN = false, HAS_MID = false;
    const float* h; float* ho; const float* modf; float* ssq;
    __device__ __forceinline__ void mid(f32x4 (&)[2][2][4][2], const Unit&, int, int, int, int) const {}
    __device__ __forceinline__ void operator()(const f32x4 (&acc)[2][2][4][2], const Unit& u, int wr, int wc, int fr, int fq) const {
        const int row0 = u.pm * BM + wr * 64 + fr, col0 = u.pn * BM + wc * 32 + 8 * fq, b = u.pm >> 4;
        f32x4 g2[2][2];
#pragma unroll
        for (int bj = 0; bj < 2; ++bj)
#pragma unroll
            for (int n = 0; n < 2; ++n) g2[bj][n] = *(const f32x4*)(modf + b * 6144 + 5120 + col0 + bj * HALF + 4 * n);
#pragma unroll
        for (int ai = 0; ai < 2; ++ai)
#pragma unroll
            for (int m = 0; m < 4; ++m) { const int row = row0 + ai * HALF + m * 16; const size_t off = (size_t)row * 1024 + col0; float q = 0.f;
#pragma unroll
                for (int bj = 0; bj < 2; ++bj) { const f32x4 x0 = *(const f32x4*)(h + off + bj * HALF), x1 = *(const f32x4*)(h + off + bj * HALF + 4);
                    const f32x4 h0 = x0 + g2[bj][0] * acc[ai][bj][m][0], hb = x1 + g2[bj][1] * acc[ai][bj][m][1];
                    *(f32x4*)(ho + off + bj * HALF) = h0; *(f32x4*)(ho + off + bj * HALF + 4) = hb;
                    q += (h0[0] * h0[0] + h0[1] * h0[1]) + (h0[2] * h0[2] + h0[3] * h0[3]) + (hb[0] * hb[0] + hb[1] * hb[1]) + (hb[2] * hb[2] + hb[3] * hb[3]); }
                q += __shfl_xor(q, 16); q += __shfl_xor(q, 32);
                if (fq == 0) ssq[(size_t)row * 16 + u.pn * 4 + wc] = q; }
    }
};

template <class Epi, class Sched, bool ALIGN_EPI = false, bool SP2 = false>
__device__ __forceinline__ void gemm_phase(PG8_LAS unsigned char* lds, const Gemm g, const Sched& S, const Epi& E, const int wid) {
    const int lane = lane_id_v(), tid = wid * 64 + lane, wr = wid >> 2, wc = wid & 3, fr = lane & 15, fq = lane >> 4;
    const int K = g.K, nt = K / BK;
    unsigned voffA[2], voffB[2];
#pragma unroll
    for (int i = 0; i < 2; ++i) { int R, C; stage_rc(tid * 16 + i * 8192, R, C); const int Rb = Epi::PERM ? ((R & ~31) + perm32(R & 31)) : R;
        voffA[i] = (unsigned)((C >> 5) * g.a_cbstride + R * g.a_lda + (C & 31)) * 2u; voffB[i] = (unsigned)(Rb * K + C) * 2u; }
    const size_t kstepB = (size_t)(BK * 2), kstepA = g.a_kstep;
    const size_t hstepB = (size_t)HALF * K * 2, hstepA = (size_t)HALF * g.a_lda * 2;
    const size_t tstep = 2 * hstepB;
    const unsigned ldsw = (unsigned)wid * 1024u;
    const int aoff = lds_byte(wr * 64 + fr, fq * 8), boff = lds_byte(wc * 32 + fr, fq * 8);
#define PG8_SA(b, h) (((b) * 2 + (h)) * HTB)
#define PG8_SB(b, h) ((4 + (b) * 2 + (h)) * HTB)
#define PG8_STAGE(bufoff, gbase, voff) do { _Pragma("unroll") for (int _i = 0; _i < 2; ++_i) \
        __builtin_amdgcn_global_load_lds((const unsigned*)((const char*)(gbase) + (voff)[_i]), (PG8_LAS unsigned*)(lds + (bufoff) + ldsw + _i * 8192), 16, 0, 0); } while (0)
#define PG8_LDA(dst, b, h) do { _Pragma("unroll") for (int m = 0; m < 4; ++m) _Pragma("unroll") for (int k = 0; k < 2; ++k) dst[m][k] = *(const PG8_LAS bf16x8*)(lds + PG8_SA(b, h) + aoff + m * 2048 + k * 1024); } while (0)
#define PG8_LDB(dst, b, h) do { _Pragma("unroll") for (int n = 0; n < 2; ++n) _Pragma("unroll") for (int k = 0; k < 2; ++k) dst[n][k] = *(const PG8_LAS bf16x8*)(lds + PG8_SB(b, h) + boff + n * 2048 + k * 1024); } while (0)
#define PG8_MMA(ai, bj, At, Bt) do { __builtin_amdgcn_s_setprio(1); _Pragma("unroll") for (int m = 0; m < 4; ++m) _Pragma("unroll") for (int n = 0; n < 2; ++n) _Pragma("unroll") for (int k = 0; k < 2; ++k) \
        acc[ai][bj][m][n] = __builtin_amdgcn_mfma_f32_16x16x32_bf16(Bt[n][k], At[m][k], acc[ai][bj][m][n], 0, 0, 0); __builtin_amdgcn_s_setprio(0); } while (0)
#define PG8_WAIT_V(n) asm volatile("s_waitcnt vmcnt(" #n ")" ::: "memory")
#define PG8_WAIT_L(n) asm volatile("s_waitcnt lgkmcnt(" #n ")" ::: "memory")
#define PG8_BAR __builtin_amdgcn_s_barrier()
#define PG8_SCHED __builtin_amdgcn_sched_barrier(0)
    Unit cur, nxt; int ui = 0;
    if (!S.next(0, cur)) return;
    f32x4 acc[2][2][4][2];
#pragma unroll
    for (int a = 0; a < 2; ++a)
#pragma unroll
        for (int b = 0; b < 2; ++b)
#pragma unroll
            for (int m = 0; m < 4; ++m)
#pragma unroll
                for (int n = 0; n < 2; ++n) acc[a][b][m][n] = (f32x4){0.f, 0.f, 0.f, 0.f};
    bf16x8 At[4][2], B0[2][2], B1[2][2];
    const char* cA = (const char*)g.A + (size_t)cur.pm * g.a_pstride; const char* cB = (const char*)g.Bt + (size_t)cur.pn * tstep;
    S.a_ready(cur);
    if constexpr (SP2) {
        PG8_STAGE(PG8_SB(0, 0), cB, voffB); PG8_STAGE(PG8_SB(0, 1), cB + hstepB, voffB); PG8_STAGE(PG8_SA(0, 0), cA, voffA); PG8_STAGE(PG8_SA(0, 1), cA + hstepA, voffA);
        if (wr == 1) PG8_BAR;
        PG8_WAIT_V(2); PG8_BAR;
        PG8_STAGE(PG8_SB(1, 0), cB + kstepB, voffB); PG8_STAGE(PG8_SA(1, 0), cA + kstepA, voffA); PG8_STAGE(PG8_SB(1, 1), cB + hstepB + kstepB, voffB);
        PG8_WAIT_V(6); PG8_BAR;
    } else {
        PG8_STAGE(PG8_SB(0, 0), cB, voffB); PG8_STAGE(PG8_SA(0, 0), cA, voffA); PG8_STAGE(PG8_SB(0, 1), cB + hstepB, voffB); PG8_STAGE(PG8_SA(0, 1), cA + hstepA, voffA);
        if (wr == 1) PG8_BAR;
        PG8_WAIT_V(4); PG8_BAR;
        PG8_STAGE(PG8_SB(1, 0), cB + kstepB, voffB); PG8_STAGE(PG8_SA(1, 0), cA + kstepA, voffA); PG8_STAGE(PG8_SB(1, 1), cB + hstepB + kstepB, voffB);
        PG8_WAIT_V(6); PG8_BAR;
    }
#ifdef PH_GEMMPROBE
#define GP_STAMP(k) do { if (Epi::EPI_ID == PH_GEMMPROBE && ui == PH_GEMMUNIT && wid == 0) { const unsigned long long t_ = __builtin_amdgcn_s_memrealtime(); if (lane == 0) *(PG8_LAS unsigned long long*)(lds + 139264 + 2048 + 8 * (k)) = t_; } } while (0)
#else
#define GP_STAMP(k) do { } while (0)
#endif
    for (;;) {
        const bool has_next = S.next(ui + 1, nxt);
        GP_STAMP(0);
        const char* nA = has_next ? (const char*)g.A + (size_t)nxt.pm * g.a_pstride : cA; const char* nB = has_next ? (const char*)g.Bt + (size_t)nxt.pn * tstep : cB;
        for (int t = 0; t < nt; t += 2) {
            if constexpr (Epi::HAS_MID) { if (t == (nt >> 1)) { int fr_e = fr, fq_e = fq; asm volatile("" : "+v"(fr_e), "+v"(fq_e)); E.mid(acc, cur, wr, wc, fr_e, fq_e); } }
            const bool last = (t == nt - 2);
            const char* a1 = cA + (size_t)(t + 1) * kstepA;
            const char* a2 = last ? nA : cA + (size_t)(t + 2) * kstepA; const char* b2 = last ? nB : cB + (size_t)(t + 2) * kstepB;
            const char* a3 = a2 + kstepA; const char* b3 = b2 + kstepB;
            if (last && has_next) S.a_ready(nxt);
            if constexpr (SP2) {
            PG8_LDB(B0, 0, 0); PG8_LDB(B1, 0, 1); PG8_SCHED; PG8_LDA(At, 0, 0); PG8_STAGE(PG8_SA(1, 1), a1 + hstepA, voffA);
            PG8_WAIT_V(8); PG8_WAIT_L(0); PG8_BAR; PG8_MMA(0, 0, At, B0); PG8_MMA(0, 1, At, B1); PG8_BAR; PG8_SCHED;
            PG8_LDA(At, 0, 1); PG8_STAGE(PG8_SB(0, 0), b2, voffB); PG8_STAGE(PG8_SB(0, 1), b2 + hstepB, voffB); PG8_STAGE(PG8_SA(0, 0), a2, voffA);
            PG8_WAIT_V(8); PG8_WAIT_L(0); PG8_BAR; PG8_MMA(1, 0, At, B0); PG8_MMA(1, 1, At, B1); PG8_BAR; PG8_SCHED;
            PG8_LDB(B0, 1, 0); PG8_LDB(B1, 1, 1); PG8_SCHED; PG8_LDA(At, 1, 0); PG8_STAGE(PG8_SA(0, 1), a2 + hstepA, voffA);
            PG8_WAIT_V(8); PG8_WAIT_L(0); PG8_BAR; PG8_MMA(0, 0, At, B0); PG8_MMA(0, 1, At, B1); PG8_BAR; PG8_SCHED;
            PG8_LDA(At, 1, 1); PG8_STAGE(PG8_SB(1, 0), b3, voffB); PG8_STAGE(PG8_SB(1, 1), b3 + hstepB, voffB); PG8_STAGE(PG8_SA(1, 0), a3, voffA);
            PG8_WAIT_V(8); PG8_WAIT_L(0); PG8_BAR; PG8_MMA(1, 0, At, B0); PG8_MMA(1, 1, At, B1); PG8_BAR; PG8_SCHED;
            } else {
            PG8_LDB(B0, 0, 0); PG8_SCHED; PG8_LDA(At, 0, 0); PG8_STAGE(PG8_SA(1, 1), a1 + hstepA, voffA);
            PG8_WAIT_L(8); PG8_BAR; PG8_WAIT_L(0); PG8_MMA(0, 0, At, B0); PG8_BAR; PG8_SCHED;
            PG8_LDB(B1, 0, 1); PG8_STAGE(PG8_SB(0, 0), b2, voffB);
            PG8_BAR; PG8_WAIT_L(0); PG8_MMA(0, 1, At, B1); PG8_BAR;
            PG8_LDA(At, 0, 1); PG8_STAGE(PG8_SA(0, 0), a2, voffA);
            PG8_BAR; PG8_WAIT_L(0); PG8_MMA(1, 0, At, B0); PG8_BAR; PG8_SCHED;
            PG8_STAGE(PG8_SB(0, 1), b2 + hstepB, voffB);
            PG8_WAIT_V(6); PG8_BAR; PG8_MMA(1, 1, At, B1); PG8_BAR;
            PG8_LDB(B0, 1, 0); PG8_SCHED; PG8_LDA(At, 1, 0); PG8_STAGE(PG8_SA(0, 1), a2 + hstepA, voffA);
            PG8_WAIT_L(8); PG8_BAR; PG8_WAIT_L(0); PG8_MMA(0, 0, At, B0); PG8_BAR; PG8_SCHED;
            PG8_LDB(B1, 1, 1); PG8_STAGE(PG8_SB(1, 0), b3, voffB);
            PG8_BAR; PG8_WAIT_L(0); PG8_MMA(0, 1, At, B1); PG8_BAR;
            PG8_LDA(At, 1, 1); PG8_STAGE(PG8_SA(1, 0), a3, voffA);
            PG8_BAR; PG8_WAIT_L(0); PG8_MMA(1, 0, At, B0); PG8_BAR; PG8_SCHED;
            PG8_STAGE(PG8_SB(1, 1), b3 + hstepB, voffB);
            PG8_WAIT_V(6); PG8_BAR; PG8_MMA(1, 1, At, B1); PG8_BAR;
            }
        }
        GP_STAMP(1);
        if constexpr (ALIGN_EPI) { if (wr == 0) PG8_BAR; }
        if constexpr (!Epi::AFTER_DRAIN) { int fr_e = fr, fq_e = fq; asm volatile("" : "+v"(fr_e), "+v"(fq_e));
            E(acc, cur, wr, wc, fr_e, fq_e);
#ifdef PH_EPI2
            if (Epi::EPI_ID == PH_EPI2) { asm volatile("" : "+v"(fr_e), "+v"(fq_e)); E(acc, cur, wr, wc, fr_e, fq_e); }
#endif
            S.done(cur); }
        GP_STAMP(2);
        if (!has_next) break;
#pragma unroll
        for (int a = 0; a < 2; ++a)
#pragma unroll
            for (int b = 0; b < 2; ++b)
#pragma unroll
                for (int m = 0; m < 4; ++m)
#pragma unroll
                    for (int n = 0; n < 2; ++n) acc[a][b][m][n] = (f32x4){0.f, 0.f, 0.f, 0.f};
        cur = nxt; cA = nA; cB = nB; ++ui;
        if constexpr (ALIGN_EPI) { if (wr == 1) PG8_BAR; }
    }
    PG8_WAIT_V(0);
    if constexpr (!ALIGN_EPI) { if (wr == 0) PG8_BAR; }
    PG8_BAR;
    if constexpr (Epi::AFTER_DRAIN) { E.fused(acc, cur, wr, wc, fr, fq, lds, wid, lane); S.done(cur); }
#undef PG8_SA
#undef PG8_SB
#undef PG8_STAGE
#undef PG8_LDA
#undef PG8_LDB
#undef PG8_MMA
#undef PG8_WAIT_V
#undef PG8_WAIT_L
#undef PG8_BAR
#undef PG8_SCHED
}
}

#define GAS __attribute__((address_space(1)))
#define LAS __attribute__((address_space(3)))
typedef unsigned short bf16;
typedef unsigned v4u __attribute__((ext_vector_type(4)));
typedef float f32x4 __attribute__((ext_vector_type(4)));
typedef short bf16x8 __attribute__((ext_vector_type(8)));
typedef GAS unsigned gu32;
typedef GAS unsigned long long gu64;
#define RLX_AGENT __ATOMIC_RELAXED, __HIP_MEMORY_SCOPE_AGENT
#define LDS_WAIT() asm volatile("s_waitcnt lgkmcnt(0)" ::: "memory")
#define VM_WAIT() asm volatile("s_waitcnt vmcnt(0)" ::: "memory")
__device__ __forceinline__ unsigned long long rt() { return __builtin_amdgcn_s_memrealtime(); }
__device__ __forceinline__ unsigned f2bf(float f) { unsigned u = __builtin_bit_cast(unsigned, f); return (u + 0x7fffu + ((u >> 16) & 1u)) >> 16; }
__device__ __forceinline__ unsigned pk2(float lo, float hi) { return f2bf(lo) | (f2bf(hi) << 16); }

#define XB_TMO      128
#define XB_XCNT(j)  (256  + 64 * (j))
#define XB_XSUB(j)  (1280 + 64 * (j))
#define XB_XGEN(j)  (2304 + 64 * (j))
#define XB_TOP      3328
#define XB_TOPGEN   3392
#define XCD_BAR_WORDS 3456
#define XB_SPIN_CAP (1u << 18)

__device__ __forceinline__ unsigned xb_ld(unsigned* p)              { return __hip_atomic_load(p, __ATOMIC_RELAXED, __HIP_MEMORY_SCOPE_AGENT); }
__device__ __forceinline__ unsigned xb_add(unsigned* p, unsigned v) { return __hip_atomic_fetch_add(p, v, __ATOMIC_RELAXED, __HIP_MEMORY_SCOPE_AGENT); }
__device__ __forceinline__ unsigned xb_xcc_id() { return (unsigned)__builtin_amdgcn_s_getreg((3 << 11) | 20) & 0xFu; }
#define XB_SPIN(cond, bar) do { unsigned _sp = 0; while (cond) { __builtin_amdgcn_s_sleep(1); \
    if ((++_sp & 255u) == 0u) { if (xb_ld(&(bar)[XB_TMO])) break; if (_sp > XB_SPIN_CAP) { atomicAdd(&(bar)[XB_TMO], 1u); break; } } } } while (0)

struct XcdBarrier {
    unsigned* bar; unsigned x;
    volatile LAS unsigned* st;
};

__device__ __forceinline__ XcdBarrier xcd_barrier_post(unsigned* bar, volatile LAS unsigned* st, const int wave) {
    XcdBarrier b; b.bar = bar; b.x = xb_xcc_id(); b.st = st;
    if (wave == 0 && pg8::lane_id_v() == 0) (void)xb_add(&bar[XB_XCNT(b.x)], 1u);
    return b;
}
__device__ __forceinline__ void xcd_barrier_complete(unsigned* bar, unsigned x, unsigned& nloc, unsigned& nx) {
    const unsigned G = gridDim.x * gridDim.y * gridDim.z;
    unsigned sum, cnt, mine, sp = 0u;
    for (;;) {
        sum = 0u; cnt = 0u; mine = 0u;
#pragma unroll
        for (unsigned j = 0; j < 16; ++j) { const unsigned c = xb_ld(&bar[XB_XCNT(j)]); sum += c; cnt += (c > 0u) ? 1u : 0u; mine = (j == x) ? c : mine; }
        if (sum == G) break;
        __builtin_amdgcn_s_sleep(1);
        if ((++sp & 255u) == 0u) { if (xb_ld(&bar[XB_TMO])) break; if (sp > XB_SPIN_CAP) { atomicAdd(&bar[XB_TMO], 1u); break; } }
    }
    nloc = mine > 0u ? mine : 1u; nx = cnt > 0u ? cnt : 1u;
}

__device__ __forceinline__ void xcd_barrier(const XcdBarrier& b, const int wave) {
    asm volatile("s_waitcnt vmcnt(0)" ::: "memory");
    __syncthreads();
    if (wave == 0 && pg8::lane_id_v() == 0) {
        unsigned* bar = b.bar;
        __builtin_amdgcn_s_waitcnt(0);
        unsigned nloc = b.st[0], nx = b.st[1];
        if (nloc == 0u) { xcd_barrier_complete(bar, b.x, nloc, nx); b.st[0] = nloc; b.st[1] = nx; }
        const unsigned old = xb_add(&bar[XB_XSUB(b.x)], 1u);
        const unsigned gen = old / nloc;
        if (old + 1u == (gen + 1u) * nloc) {
            __builtin_amdgcn_fence(__ATOMIC_RELEASE, "agent");
            asm volatile("s_waitcnt vmcnt(0)" ::: "memory");
            const unsigned og = xb_add(&bar[XB_TOP], 1u);
            const unsigned tg = og / nx;
            if (og + 1u == (tg + 1u) * nx) xb_add(&bar[XB_TOPGEN], 1u);
            else XB_SPIN(xb_ld(&bar[XB_TOPGEN]) == tg, bar);
            __builtin_amdgcn_fence(__ATOMIC_ACQUIRE, "agent");
            xb_add(&bar[XB_XGEN(b.x)], 1u);
            asm volatile("s_waitcnt vmcnt(0)" ::: "memory");
        } else {
            XB_SPIN(xb_ld(&bar[XB_XGEN(b.x)]) == gen, bar);
            __builtin_amdgcn_fence(__ATOMIC_ACQUIRE, "agent");
            asm volatile("s_waitcnt vmcnt(0)" ::: "memory");
        }
    }
    __syncthreads();
}


__device__ __forceinline__ void group_sync(unsigned* cnt, unsigned want, unsigned* tmo, const int wave, const bool same_l2 = false, unsigned* cnt2 = nullptr, unsigned want2 = 0u) {
    asm volatile("s_waitcnt vmcnt(0)" ::: "memory");
    __syncthreads();
    if (wave == 0 && pg8::lane_id_v() == 0) {
        if (!same_l2) __builtin_amdgcn_fence(__ATOMIC_RELEASE, "agent");
        asm volatile("s_waitcnt vmcnt(0)" ::: "memory");
        (void)xb_add(cnt, 1u);
        unsigned sp = 0u;
        while (xb_ld(cnt) < want || (cnt2 != nullptr && xb_ld(cnt2) < want2)) { __builtin_amdgcn_s_sleep(1); if ((++sp & 255u) == 0u) { if (xb_ld(tmo)) break; if (sp > XB_SPIN_CAP) { atomicAdd(tmo, 1u); break; } } }
        __builtin_amdgcn_fence(__ATOMIC_ACQUIRE, "agent");
        asm volatile("s_waitcnt vmcnt(0)" ::: "memory");
    }
    __syncthreads();
}

constexpr int NWAVES = 8;
constexpr int BATCH = 4, SEQ = 4096, D = 1024, M = BATCH * SEQ, NPROJ = 8192, FF = 4096, NMOD = 6 * D;
constexpr int RH = 4, DK = 128, DV = 256, SCH = 256  , NJ = SEQ / SCH  ;
constexpr float EPS = 1e-6f;
constexpr int KS_MOD = 8;
constexpr size_t MiB = 1u << 20;
constexpr size_t WS_CTL = 0, CTL_ZERO_BYTES = 320 * 1024;
constexpr size_t WS_MODP = 1 * MiB;
constexpr size_t WS_MODF = 2 * MiB + 512 * 1024;
constexpr size_t WS_BIAS2 = WS_MODF + 128 * 1024;
constexpr size_t WS_SSQ2 = 3 * MiB, WS_SSQ3 = 4 * MiB, WS_HALO = 4 * MiB + 512 * 1024, WS_CB01 = WS_HALO + 256 * 1024;
constexpr size_t WS_WIN = 5 * MiB, WS_WRC = 21 * MiB, WS_WO = 25 * MiB, WS_W1 = 27 * MiB, WS_W2 = 35 * MiB;
constexpr size_t WS_ST = 236 * MiB;
constexpr size_t WS_QK = 44 * MiB, WS_V = 76 * MiB, WS_R = 108 * MiB, WS_END = 252 * MiB;
constexpr size_t WS_MERGED = WS_QK, WS_HHAT = WS_V, WS_HID = WS_R;
constexpr size_t OUT_U = 0, OUT_Z = 32 * MiB, OUT_KV = 0;
static_assert(WS_W2 + (size_t)D * FF * 2 <= WS_QK && WS_HID + (size_t)M * FF * 2 <= WS_END, "d_ws map");
constexpr int CW_TMO = 0, CW_BAR = 4096, CW_MOD = 8192, CW_WAR = 8256, CW_W = 8320  , CW_P1 = 8384  , CW_XCC = 12288, CW_GRP = 32768;
constexpr int RING_OFF = 0, PHASE_BYTES = 139264, LDSCTL_OFF = PHASE_BYTES, MISC_OFF = LDSCTL_OFF + 320, TAB_OFF = LDSCTL_OFF + 1024, LDS_BYTES = PHASE_BYTES + 4096;

struct Frame {
    LAS unsigned char* lds; volatile LAS unsigned* MISC; gu32* ctl;
    int wave, vcu, G;
    const float *x, *c, *w_ada, *b_ada, *norm1_w, *w_in, *ret_gn_w, *conv_w, *w_ret_out, *w_conv_out, *w_o, *norm2_w, *w_ff1, *w_ff2, *final_norm_w; const int* positions;
    float* out; unsigned char* ws;
};
__device__ __forceinline__ float wave_sum(float v) {
#pragma unroll
    for (int o = 1; o < 64; o <<= 1) v += __shfl_xor(v, o);
    return v;
}
__device__ __forceinline__ unsigned cvtpk2(float lo, float hi) { return pg8::cvtpk(lo, hi); }

__device__ __forceinline__ int vmap_in(int n) {
    if (n < 1024) { const int hb = n & ~127, d = n & 127; const int dd = d & 63; return hb + 8 * (dd >> 2) + (d >= 64 ? 4 : 0) + (dd & 3); }
    if (n < 3072) return n;
    if (n >= 7168) return n - 7168 + 3072;
    { const int q = (n - 3072) >> 10, ch = (n - 3072) & 1023, c = 4 * (ch >> 8) + 2 * ((ch >> 7) & 1) + ((ch >> 2) & 1);
      return 4096 + 256 * c + 128 * (q >> 1) + 32 * ((ch >> 5) & 3) + 8 * ((ch >> 3) & 3) + 4 * (q & 1) + (ch & 3); }
}
struct P0Tile { const float* W; bf16* WT; int N, ldt, kofs, k0, n0, vm; };
__device__ __forceinline__ P0Tile p0_tile(const Frame& F, int t) {
    P0Tile T; int r = t;
    if (r < 512) { T.W = F.w_in; T.WT = (bf16*)(F.ws + WS_WIN); T.N = NPROJ; T.ldt = D; T.kofs = 0; T.vm = 1; T.n0 = 256 * (r >> 4); T.k0 = 64 * (r & 15); return T; } r -= 512;
    if (r < 64) { T.W = F.w_ret_out; T.WT = (bf16*)(F.ws + WS_WRC); T.N = D; T.ldt = 2 * D; T.kofs = 0; T.vm = 0; T.n0 = 256 * (r >> 4); T.k0 = 64 * (r & 15); return T; } r -= 64;
    if (r < 64) { T.W = F.w_conv_out; T.WT = (bf16*)(F.ws + WS_WRC); T.N = D; T.ldt = 2 * D; T.kofs = D; T.vm = 0; T.n0 = 256 * (r >> 4); T.k0 = 64 * (r & 15); return T; } r -= 64;
    if (r < 64) { T.W = F.w_o; T.WT = (bf16*)(F.ws + WS_WO); T.N = D; T.ldt = D; T.kofs = 0; T.vm = 0; T.n0 = 256 * (r >> 4); T.k0 = 64 * (r & 15); return T; } r -= 64;
    if (r < 256) { T.W = F.w_ff1; T.WT = (bf16*)(F.ws + WS_W1); T.N = FF; T.ldt = D; T.kofs = 0; T.vm = 0; T.n0 = 256 * (r >> 4); T.k0 = 64 * (r & 15); return T; } r -= 256;
    T.W = F.w_ff2; T.WT = (bf16*)(F.ws + WS_W2); T.N = D; T.ldt = FF; T.kofs = 0; T.vm = 0; T.n0 = 256 * (r >> 6); T.k0 = 64 * (r & 63); return T;
}
constexpr int P0_NTILES = 512 + 3 * 64 + 256 + 256;
constexpr int P0_PITCH = 1040;
__device__ __forceinline__ void p0_dma(const P0Tile& T, LAS unsigned char* buf, int wave, int lane) {
#pragma unroll
    for (int i = 0; i < 8; ++i) { const int row = 8 * wave + i;
        __builtin_amdgcn_global_load_lds((const unsigned*)(T.W + (size_t)(T.k0 + row) * T.N + T.n0 + lane * 4), (LAS unsigned*)(buf + row * P0_PITCH), 16, 0, 2  ); }
}
__device__ __forceinline__ float siluf_(float x) { return x / (1.0f + __expf(-x)); }
__device__ __forceinline__ void p0_prologue(Frame& F) {
    const int lane_ = pg8::lane_id_v(), tid_ = F.wave * 64 + lane_; (void)tid_;
    const int gw = F.vcu * NWAVES + F.wave, NGW = F.G * NWAVES;
    for (int vb = F.vcu; vb < 32 * KS_MOD; vb += F.G) {
        const int cb = vb & 31, ks = vb >> 5, k0 = ks * (D / KS_MOD) + 16 * F.wave; const int col = 192 * cb + 4 * (lane_ < 48 ? lane_ : 0);
        f32x4 a0 = {0.f, 0.f, 0.f, 0.f}, a1 = a0, a2 = a0, a3 = a0;
        const float* wp = F.w_ada + (size_t)k0 * NMOD + col;
        f32x4 wv[16];
#pragma unroll
        for (int kk = 0; kk < 16; ++kk) wv[kk] = __builtin_nontemporal_load((const GAS f32x4*)(wp + (size_t)kk * NMOD));
#pragma unroll
        for (int kk = 0; kk < 16; ++kk) { const int k = k0 + kk; const float s0 = siluf_(F.c[k]), s1 = siluf_(F.c[D + k]), s2 = siluf_(F.c[2 * D + k]), s3 = siluf_(F.c[3 * D + k]);
            a0 += wv[kk] * s0; a1 += wv[kk] * s1; a2 += wv[kk] * s2; a3 += wv[kk] * s3; }
        LAS f32x4* red = (LAS f32x4*)(F.lds + RING_OFF);
        if (lane_ < 48) { LAS f32x4* rp = red + (F.wave * 4) * 48 + lane_; rp[0] = a0; rp[48] = a1; rp[96] = a2; rp[144] = a3; }
        __syncthreads();
        if (tid_ < 192) { f32x4 sacc = {0.f, 0.f, 0.f, 0.f};
#pragma unroll
            for (int w = 0; w < NWAVES; ++w) sacc += red[w * 192 + tid_];
            pg8::st16_wt(pg8::mk_rsrc(F.ws + WS_MODP, KS_MOD * 4 * NMOD * 4), (unsigned)(((size_t)ks * 4 * NMOD + (size_t)(tid_ / 48) * NMOD + 192 * cb + 4 * (tid_ % 48)) * 4), __builtin_bit_cast(pg8::u32x4, sacc)); }
        asm volatile("s_waitcnt vmcnt(0)" ::: "memory"); __syncthreads();
        if (F.wave == 0 && lane_ == 0) (void)xb_add((unsigned*)(F.ctl + CW_MOD), 1u);
    }
    const int t0 = (int)(((long)F.vcu * P0_NTILES) / F.G), t1 = (int)(((long)(F.vcu + 1) * P0_NTILES) / F.G);
    if (t0 < t1) { const P0Tile T0 = p0_tile(F, t0); p0_dma(T0, F.lds + RING_OFF, F.wave, lane_); }
    for (int t = t0; t < t1; ++t) {
        LAS unsigned char* buf = F.lds + RING_OFF + ((t - t0) & 1) * (64 * P0_PITCH);
        const P0Tile T = p0_tile(F, t);
        __syncthreads();
        if (t + 1 < t1) { const P0Tile Tn = p0_tile(F, t + 1); p0_dma(Tn, F.lds + RING_OFF + ((t + 1 - t0) & 1) * (64 * P0_PITCH), F.wave, lane_); }
        const pg8::rsrc_t wr_ = pg8::mk_rsrc(T.WT, (unsigned)((size_t)T.N * T.ldt * 2)); const int q_ = tid_ & 7;
#pragma unroll
        for (int rr = 0; rr < 4; ++rr) { const int cl = (tid_ >> 3) + 64 * rr; float v[8];
#pragma unroll
            for (int j = 0; j < 8; ++j) v[j] = *(const LAS float*)(buf + (8 * q_ + j) * P0_PITCH + cl * 4);
            const int n = T.n0 + cl, vr = T.vm ? vmap_in(n) : n;
            pg8::u32x4 o; o.x = cvtpk2(v[0], v[1]); o.y = cvtpk2(v[2], v[3]); o.z = cvtpk2(v[4], v[5]); o.w = cvtpk2(v[6], v[7]);
            pg8::st16_wt(wr_, (unsigned)(((size_t)vr * T.ldt + T.kofs + T.k0 + 8 * q_) * 2), o); }
    }
    asm volatile("s_waitcnt vmcnt(0)" ::: "memory"); __syncthreads();
    if (F.wave == 0 && lane_ == 0) (void)xb_add((unsigned*)(F.ctl + CW_W), 1u);
}

__device__ __forceinline__ float modp_sum(const float* modp, int idx) { float s = 0.f;
#pragma unroll
    for (int ks = 0; ks < KS_MOD; ++ks) s += modp[(size_t)ks * 4 * NMOD + idx];
    return s; }
__device__ __forceinline__ void p1_unorm(Frame& F, const int blk) {
    const int lane_ = pg8::lane_id_v(), tid_ = F.wave * 64 + lane_; (void)tid_;
    const float* modp = (const float*)(F.ws + WS_MODP); float* modf = (float*)(F.ws + WS_MODF);
    if (F.wave == 0 && lane_ == 0) { unsigned* cm = (unsigned*)(F.ctl + CW_MOD); unsigned* tmo = (unsigned*)(F.ctl + CW_BAR + XB_TMO); unsigned sp = 0u;
        while (xb_ld(cm) < 32u * KS_MOD) { __builtin_amdgcn_s_sleep(1); if ((++sp & 255u) == 0u) { if (xb_ld(tmo)) break; if (sp > XB_SPIN_CAP) { atomicAdd(tmo, 1u); break; } } }
        __builtin_amdgcn_fence(__ATOMIC_ACQUIRE, "agent"); asm volatile("s_waitcnt vmcnt(0)" ::: "memory"); }
    __syncthreads();
    const int b = blk >> 6;
    LAS float* cs1 = (LAS float*)(F.lds + RING_OFF); LAS float* sh1 = cs1 + D;
    for (int k = tid_; k < D; k += NWAVES * 64) {
        const float sh = modp_sum(modp, b * NMOD + k) + F.b_ada[k], sc = modp_sum(modp, b * NMOD + D + k) + F.b_ada[D + k];
        cs1[k] = F.norm1_w[k] * (1.0f + sc); sh1[k] = sh; }
    if (tid_ < 96) { const int idx = blk * 96 + tid_; if (idx < 4 * NMOD) __hip_atomic_store(modf + idx, modp_sum(modp, idx) + F.b_ada[idx % NMOD], __ATOMIC_RELAXED, __HIP_MEMORY_SCOPE_AGENT); }
    __syncthreads();
    bf16* U = (bf16*)((unsigned char*)F.out + OUT_U);
    for (int r0 = 0; r0 < 8; r0 += 4) {
        f32x4 v[4][4]; float ss[4];
#pragma unroll
        for (int q = 0; q < 4; ++q) { const int m = blk * 64 + F.wave * 8 + r0 + q; const GAS f32x4* xr = (const GAS f32x4*)(F.x + (size_t)m * D) + lane_;
#pragma unroll
            for (int j = 0; j < 4; ++j) v[q][j] = __builtin_nontemporal_load(xr + 64 * j); }
#pragma unroll
        for (int q = 0; q < 4; ++q) { float s = 0.f;
#pragma unroll
            for (int j = 0; j < 4; ++j) s += (v[q][j].x * v[q][j].x + v[q][j].y * v[q][j].y) + (v[q][j].z * v[q][j].z + v[q][j].w * v[q][j].w);
            ss[q] = 1.0f / sqrtf(wave_sum(s) * (1.0f / D) + EPS); }
#pragma unroll
        for (int q = 0; q < 4; ++q) { const int m = blk * 64 + F.wave * 8 + r0 + q; GAS unsigned long long* o8 = (GAS unsigned long long*)(U + (size_t)(m >> 8) * 262144 + (size_t)(m & 255) * 64);
#pragma unroll
            for (int j = 0; j < 4; ++j) { const int k = 4 * lane_ + 256 * j; const f32x4 a = *(const LAS f32x4*)(cs1 + k), sh = *(const LAS f32x4*)(sh1 + k);
                const f32x4 u = v[q][j] * ss[q] * a + sh;
                o8[(k >> 6) * 4096 + ((k & 63) >> 2)] = (unsigned long long)cvtpk2(u.x, u.y) | ((unsigned long long)cvtpk2(u.z, u.w) << 32); } }
    }
}

typedef short s16x4 __attribute__((ext_vector_type(4)));
typedef float f32x16 __attribute__((ext_vector_type(16)));
#define MFMA32(a, b, c) __builtin_amdgcn_mfma_f32_32x32x16_bf16((a), (b), (c), 0, 0, 0)
__device__ __forceinline__ int crow(int reg, int hh) { return (reg & 3) + 8 * (reg >> 2) + 4 * hh; }
__device__ __forceinline__ bf16x8 tr_frag(LAS unsigned char* p) {
    const s16x4 lo = __builtin_amdgcn_ds_read_tr16_b64_v4i16((LAS s16x4*)p), hi = __builtin_amdgcn_ds_read_tr16_b64_v4i16((LAS s16x4*)(p + 512));
    return __builtin_shufflevector(lo, hi, 0, 1, 2, 3, 4, 5, 6, 7);
}
__device__ __forceinline__ void tr_issue(s16x4& lo, s16x4& hi, LAS unsigned char* p) {
    asm volatile("ds_read_b64_tr_b16 %0, %2\n\tds_read_b64_tr_b16 %1, %2 offset:512" : "=&v"(lo), "=&v"(hi) : "v"((unsigned)(uintptr_t)p) : "memory");
}
#define TR_WAIT() asm volatile("s_waitcnt lgkmcnt(0)" ::: "memory")
#define TR_JOIN(lo, hi) __builtin_shufflevector((lo), (hi), 0, 1, 2, 3, 4, 5, 6, 7)
__device__ __forceinline__ float log2_gamma(int hd) { return log2f(1.0f - exp2f(-5.0f - (float)hd)); }
constexpr int RT_K = 0, RT_V = 8192, RT_BLK = 24576;
template <int AUX = 0>
__device__ __forceinline__ void rt_dma_block(const bf16* QKp, const bf16* Vp, int row0, int hd, LAS unsigned char* slot, int wave, int lane) {
#pragma unroll
    for (int i = 0; i < 3; ++i) { const int idx = 3 * wave + i; const bool isk = idx >= 16; const int j = isk ? idx - 16 : idx, cb = j >> 1, half = j & 1;
        const int off = (row0 + 16 * half) * 32 + lane * 8;
        const bf16* src = isk ? QKp + (size_t)(16 + hd * 4 + cb) * 8192 + off : Vp + (size_t)(hd * 8 + cb) * 8192 + off;
        __builtin_amdgcn_global_load_lds((const unsigned*)src, (LAS unsigned*)(slot + (isk ? RT_K : RT_V) + cb * 2048 + half * 1024), 16, 0, AUX); }
}
#define RT_WAITBAR(n) do { asm volatile("s_waitcnt vmcnt(" #n ")" ::: "memory"); __builtin_amdgcn_s_barrier(); asm volatile("" ::: "memory"); } while (0)
__device__ __forceinline__ void p3a_kvsum(Frame& F, int unit) {
    const int lane = pg8::lane_id_v();
    const int bh = unit >> 4, J = unit & 15, b = bh >> 2, hd = bh & 3;
    const size_t panel_ = (size_t)(bh >> 2) * 16 + J;
    const bf16* QK = (const bf16*)(F.ws + WS_QK) + panel_ * 262144; const bf16* V = (const bf16*)(F.ws + WS_V) + panel_ * 262144;
    bf16* KV = (bf16*)(F.ws + WS_ST) + (size_t)unit * (DV * DK);
    const int w = F.wave, r = lane & 31, hh = lane >> 5;
    const float l2g = log2_gamma(hd);
    const size_t mbase = (size_t)b * SEQ + (size_t)J * SCH;
    const int lane_off = (4 * hh + ((lane & 15) >> 2)) * 64 + ((lane >> 4) & 1) * 32 + (lane & 3) * 8;
    f32x16 acc[4];
#pragma unroll
    for (int d = 0; d < 4; ++d)
#pragma unroll
        for (int i = 0; i < 16; ++i) acc[d][i] = 0.f;
    float cj[8];
#pragma unroll
    for (int j = 0; j < 8; ++j) cj[j] = __builtin_amdgcn_exp2f(-(float)(8 * (j >> 2) + (j & 3)) * l2g);
#pragma unroll
    for (int p = 0; p < 3; ++p) rt_dma_block(QK, V, 32 * p, hd, F.lds + p * RT_BLK, w, lane);
#pragma unroll
    for (int sb = 0; sb < 8; ++sb) {
        if (sb <= 5) RT_WAITBAR(6); else if (sb == 6) RT_WAITBAR(3); else RT_WAITBAR(0);
        if (sb + 3 < 8) rt_dma_block(QK, V, 32 * (sb + 3), hd, F.lds + ((sb + 3) & 3) * RT_BLK, w, lane);
        LAS unsigned char* slot = F.lds + (sb & 3) * RT_BLK;
        s16x4 vlo[2], vhi[2], klo[2][4], khi[2][4];
#pragma unroll
        for (int ks2 = 0; ks2 < 2; ++ks2) { tr_issue(vlo[ks2], vhi[ks2], slot + RT_V + w * 2048 + ks2 * 1024 + lane_off);
#pragma unroll
            for (int d = 0; d < 4; ++d) tr_issue(klo[ks2][d], khi[ks2][d], slot + RT_K + d * 2048 + ks2 * 1024 + lane_off); }
        asm volatile("s_waitcnt lgkmcnt(0)" : "+v"(vlo[0]), "+v"(vhi[0]), "+v"(vlo[1]), "+v"(vhi[1]), "+v"(klo[0][0]), "+v"(khi[0][0]), "+v"(klo[0][1]), "+v"(khi[0][1]), "+v"(klo[0][2]), "+v"(khi[0][2]), "+v"(klo[0][3]), "+v"(khi[0][3]),
                     "+v"(klo[1][0]), "+v"(khi[1][0]), "+v"(klo[1][1]), "+v"(khi[1][1]), "+v"(klo[1][2]), "+v"(khi[1][2]), "+v"(klo[1][3]), "+v"(khi[1][3]) :: "memory");
#pragma unroll
        for (int ks2 = 0; ks2 < 2; ++ks2) {
            const v4u bvr = __builtin_bit_cast(v4u, TR_JOIN(vlo[ks2], vhi[ks2]));
            const float base = __builtin_amdgcn_exp2f((float)(255 - 32 * sb - 16 * ks2 - 4 * hh) * l2g); v4u bs;
#pragma unroll
            for (int q = 0; q < 4; ++q) bs[q] = cvtpk2(pg8::bflo(bvr[q]) * (base * cj[2 * q]), pg8::bfhi(bvr[q]) * (base * cj[2 * q + 1]));
            const bf16x8 bv = __builtin_bit_cast(bf16x8, bs);
#pragma unroll
            for (int d = 0; d < 4; ++d) { const bf16x8 ak = TR_JOIN(klo[ks2][d], khi[ks2][d]); acc[d] = MFMA32(ak, bv, acc[d]); }
        }
    }
#pragma unroll
    for (int d = 0; d < 4; ++d)
#pragma unroll
        for (int gp = 0; gp < 2; ++gp) {
            unsigned ax = cvtpk2(acc[d][8 * gp], acc[d][8 * gp + 1]), ay = cvtpk2(acc[d][8 * gp + 2], acc[d][8 * gp + 3]), bx = cvtpk2(acc[d][8 * gp + 4], acc[d][8 * gp + 5]), by = cvtpk2(acc[d][8 * gp + 6], acc[d][8 * gp + 7]);
            { const auto t = __builtin_amdgcn_permlane32_swap(ax, bx, false, false); ax = t[0]; bx = t[1]; }
            { const auto t = __builtin_amdgcn_permlane32_swap(ay, by, false, false); ay = t[0]; by = t[1]; }
            *(LAS pg8::u32x4*)(F.lds + (32 * w + r) * 272 + (32 * d + 16 * gp + 8 * hh) * 2) = (pg8::u32x4){ax, ay, bx, by}; }
    __syncthreads();
    const pg8::rsrc_t kvr = pg8::mk_rsrc(KV, DV * DK * 2);
#pragma unroll
    for (int i = 0; i < 8; ++i) { const int g = i * 512 + w * 64 + lane;
        pg8::st16_wt(kvr, (unsigned)(g * 16), *(const LAS pg8::u32x4*)(F.lds + (g >> 4) * 272 + (g & 15) * 16)); }
    __syncthreads();
}
__device__ __forceinline__ void p3a_convfix(Frame& F, int pm) {
    const int tid_ = F.wave * 64 + pg8::lane_id_v(), row = tid_ >> 8, c4 = (tid_ & 255) * 4;
    const bf16* H = (const bf16*)(F.ws + WS_HALO) + (size_t)(pm - 1) * 2048; const bf16* CB = (const bf16*)(F.ws + WS_CB01) + (size_t)(pm * 2 + row) * 1024;
    bf16* Ap = (bf16*)(F.ws + WS_R) + (size_t)pm * 1048576 + (size_t)(32 + (c4 >> 5)) * 8192 + (size_t)row * 32 + (c4 & 31);
    typedef unsigned u2_t __attribute__((ext_vector_type(2)));
    const u2_t z254 = *(const GAS u2_t*)(H + c4), z255 = *(const GAS u2_t*)(H + 1024 + c4), cb = *(const GAS u2_t*)(CB + c4), a = *(const GAS u2_t*)Ap;
    const f32x4 w0 = *(const GAS f32x4*)(F.conv_w + c4), w1 = *(const GAS f32x4*)(F.conv_w + D + c4);
    float t[4];
    { const float y0 = pg8::bflo(z255.x), y1 = pg8::bfhi(z255.x), y2 = pg8::bflo(z255.y), y3 = pg8::bfhi(z255.y), x0 = pg8::bflo(z254.x), x1 = pg8::bfhi(z254.x), x2 = pg8::bflo(z254.y), x3 = pg8::bfhi(z254.y);
      if (row == 0) { t[0] = w1[0] * y0 + w0[0] * x0; t[1] = w1[1] * y1 + w0[1] * x1; t[2] = w1[2] * y2 + w0[2] * x2; t[3] = w1[3] * y3 + w0[3] * x3; }
      else { t[0] = w0[0] * y0; t[1] = w0[1] * y1; t[2] = w0[2] * y2; t[3] = w0[3] * y3; } }
    u2_t o; o.x = cvtpk2(pg8::bflo(a.x) + pg8::bflo(cb.x) * t[0], pg8::bfhi(a.x) + pg8::bfhi(cb.x) * t[1]); o.y = cvtpk2(pg8::bflo(a.y) + pg8::bflo(cb.y) * t[2], pg8::bfhi(a.y) + pg8::bfhi(cb.y) * t[3]);
    *(GAS u2_t*)Ap = o;
}
__device__ __forceinline__ void p3a_bias2(Frame& F) {
    const int lane_ = pg8::lane_id_v();
    const float* modf = (const float*)(F.ws + WS_MODF); const bf16* W1_t = (const bf16*)(F.ws + WS_W1); float* bias2 = (float*)(F.ws + WS_BIAS2);
    const int gw = F.vcu * NWAVES + F.wave, NGW = F.G * NWAVES;
    if (gw >= FF) return;
    f32x4 sh[4][2][2];
#pragma unroll
    for (int bb = 0; bb < 4; ++bb)
#pragma unroll
        for (int i = 0; i < 2; ++i) { const float* p = modf + bb * NMOD + 3 * D + (lane_ + 64 * i) * 8; sh[bb][i][0] = *(const f32x4*)p; sh[bb][i][1] = *(const f32x4*)(p + 4); }
    for (int f0 = gw; f0 < FF; f0 += 2 * NGW) {
        const int f1 = f0 + NGW; const bool has1 = f1 < FF;
        v4u wv[2][2];
#pragma unroll
        for (int i = 0; i < 2; ++i) { wv[0][i] = *(const GAS v4u*)(W1_t + (size_t)f0 * D + (lane_ + 64 * i) * 8); wv[1][i] = *(const GAS v4u*)(W1_t + (size_t)(has1 ? f1 : f0) * D + (lane_ + 64 * i) * 8); }
        float a[2][4];
#pragma unroll
        for (int rr = 0; rr < 2; ++rr)
#pragma unroll
            for (int bb = 0; bb < 4; ++bb) { float t = 0.f;
#pragma unroll
                for (int i = 0; i < 2; ++i) { const v4u w = wv[rr][i]; const f32x4 s0 = sh[bb][i][0], s1 = sh[bb][i][1];
                    t += pg8::bflo(w[0]) * s0[0] + pg8::bfhi(w[0]) * s0[1] + pg8::bflo(w[1]) * s0[2] + pg8::bfhi(w[1]) * s0[3]
                       + pg8::bflo(w[2]) * s1[0] + pg8::bfhi(w[2]) * s1[1] + pg8::bflo(w[3]) * s1[2] + pg8::bfhi(w[3]) * s1[3]; }
                a[rr][bb] = wave_sum(t); }
        if (lane_ == 0) {
#pragma unroll
            for (int bb = 0; bb < 4; ++bb) { __hip_atomic_store(bias2 + bb * FF + f0, a[0][bb], __ATOMIC_RELAXED, __HIP_MEMORY_SCOPE_AGENT); if (has1) __hip_atomic_store(bias2 + bb * FF + f1, a[1][bb], __ATOMIC_RELAXED, __HIP_MEMORY_SCOPE_AGENT); } }
    }
}
__device__ __forceinline__ void p3b_scan(Frame& F, int bh, int j) {
    const int lane_ = pg8::lane_id_v(), tid_ = F.wave * 64 + lane_;
    if (tid_ >= 256) return;
    bf16* ST = (bf16*)(F.ws + WS_ST);
    const int e = j * 2048 + tid_ * 8; const float g = exp2f(256.0f * log2_gamma(bh & 3));
    const pg8::rsrc_t str_ = pg8::mk_rsrc(ST, 16 * NJ * DV * DK * 2);
    v4u kv[NJ];
#pragma unroll
    for (int J = 0; J < NJ; ++J) kv[J] = *(const GAS v4u*)(ST + ((size_t)(bh * NJ + J)) * (DV * DK) + e);
    float S[8];
#pragma unroll
    for (int i = 0; i < 8; ++i) S[i] = 0.f;
#pragma unroll
    for (int J = 0; J < NJ; ++J) { pg8::st16_wt(str_, (unsigned)((((size_t)(bh * NJ + J)) * (DV * DK) + e) * 2), (pg8::u32x4){cvtpk2(S[0], S[1]), cvtpk2(S[2], S[3]), cvtpk2(S[4], S[5]), cvtpk2(S[6], S[7])});
#pragma unroll
        for (int i = 0; i < 4; ++i) { S[2 * i] = S[2 * i] * g + pg8::bflo(kv[J][i]); S[2 * i + 1] = S[2 * i + 1] * g + pg8::bfhi(kv[J][i]); } }
}
#define DPP_ADD(v, ctrl) ((v) + __builtin_bit_cast(float, __builtin_amdgcn_update_dpp(0, __builtin_bit_cast(int, (v)), (ctrl), 0xf, 0xf, true)))
__device__ __forceinline__ float half_sum32(float v) {
    v = DPP_ADD(v, 0xB1); v = DPP_ADD(v, 0x4E); v = DPP_ADD(v, 0x124); v = DPP_ADD(v, 0x128);
    return v + __shfl_xor(v, 16);
}
constexpr int RC_ST = 0, RC_RING = 65536, RC_STG = 528;
#ifdef PH_RTPROBE
#define RT_STAMP(k) do { if (F.wave == PH_RTPROBE - 1) { const unsigned long long t_ = __builtin_amdgcn_s_memrealtime(); if (pg8::lane_id_v() == 0) *(LAS unsigned long long*)(F.lds + 139264 + 2048 + 8 * (k)) = t_; } } while (0)
#else
#define RT_STAMP(k) do { } while (0)
#endif
#ifndef RT_NT
#define RT_NT 2
#endif
__device__ __forceinline__ void p3c_retout(Frame& F, int unit, bf16* OUTP, bool dummy_out, unsigned* cntB, unsigned* tmoB, const bool nowbB) {
    const int lane = pg8::lane_id_v();
    const int bh = unit >> 4, J = unit & 15, b = bh >> 2, hd = bh & 3;
    const size_t panel_ = (size_t)b * 16 + J;
    const bf16* QK = (const bf16*)(F.ws + WS_QK) + panel_ * 262144; const bf16* V = (const bf16*)(F.ws + WS_V) + panel_ * 262144; const bf16* ST = (const bf16*)(F.ws + WS_ST) + (size_t)unit * (DV * DK);
    bf16* Rp = OUTP + panel_ * 1048576;
    const int w = F.wave, r = lane & 31, hh = lane >> 5;
    const int tg = w < 4 ? w : 11 - w;
    const float l2g = log2_gamma(hd);
    const size_t mbase = (size_t)b * SEQ + (size_t)J * SCH;
    const int lane_off = (4 * hh + ((lane & 15) >> 2)) * 64 + ((lane >> 4) & 1) * 32 + (lane & 3) * 8;
    LAS unsigned char* ring = F.lds + RC_RING;
    rt_dma_block<RT_NT>(QK, V, 0, hd, ring, w, lane); rt_dma_block<RT_NT>(QK, V, 32, hd, ring + RT_BLK, w, lane);
    bf16x8 qf[8];
    { const bf16* qp = QK + (size_t)(hd * 4) * 8192 + (32 * tg + r) * 32 + 8 * hh;
#pragma unroll
      for (int ks = 0; ks < 8; ++ks) qf[ks] = *(const GAS bf16x8*)(qp + (size_t)(ks >> 1) * 8192 + (ks & 1) * 16); }
    p3b_scan(F, bh, J);
    group_sync(cntB, 16u, tmoB, F.wave, nowbB);
#pragma unroll
    for (int i = 0; i < 8; ++i) { const int p = 8 * w + i, row = 4 * p + (lane >> 4), cp = lane & 15;
        __builtin_amdgcn_global_load_lds((const unsigned*)(ST + (size_t)row * DK + ((cp ^ (row & 15)) * 8)), (LAS unsigned*)(F.lds + RC_ST + p * 1024), 16, 0, RT_NT); }
    f32x16 acc[8];
#pragma unroll
    for (int c8 = 0; c8 < 8; ++c8)
#pragma unroll
        for (int i = 0; i < 16; ++i) acc[c8][i] = 0.f;
    RT_STAMP(0); RT_WAITBAR(0); RT_STAMP(1);
#pragma unroll
    for (int c8 = 0; c8 < 8; ++c8)
        {
#pragma unroll
          for (int ks = 0; ks < 8; ++ks) { const int row = 32 * c8 + r; const bf16x8 sf = *(const LAS bf16x8*)(F.lds + RC_ST + row * 256 + (((2 * ks + hh) ^ (row & 15)) * 16)); acc[c8] = MFMA32(qf[ks], sf, acc[c8]); } __builtin_amdgcn_sched_barrier(0); }
    int t1v = 32 * tg + 4 * hh + 1; asm volatile("" : "+v"(t1v));
#pragma unroll
    for (int i = 0; i < 16; ++i) { const float sc = __builtin_amdgcn_exp2f((float)(t1v + (i & 3) + 8 * (i >> 2)) * l2g);
#pragma unroll
        for (int c8 = 0; c8 < 8; ++c8) acc[c8][i] *= sc; }
    const int sbmax = tg | 1;
    __syncthreads();
    LAS unsigned char* qsl = F.lds + RC_ST + w * 8192 + lane * 16;
#pragma unroll
    for (int ks = 0; ks < 8; ++ks) *(LAS bf16x8*)(qsl + ks * 1024) = qf[ks];
    RT_STAMP(2);
    rt_dma_block<RT_NT>(QK, V, 64, hd, ring + 2 * RT_BLK, w, lane);
#pragma unroll
    for (int sb = 0; sb < 8; ++sb) {
        LAS unsigned char* buf = ring + (sb % 3) * RT_BLK;
        if (sb == 0) RT_WAITBAR(3); else if (sb < 7) RT_WAITBAR(3); else RT_WAITBAR(0);
        if (sb >= 1 && sb + 2 < 8) rt_dma_block<RT_NT>(QK, V, 32 * (sb + 2), hd, ring + ((sb + 2) % 3) * RT_BLK, w, lane);
        if (sb <= sbmax) {
            f32x16 X;
#pragma unroll
            for (int i = 0; i < 16; ++i) X[i] = 0.f;
#pragma unroll
            for (int ks = 0; ks < 8; ++ks) { const bf16x8 kf = *(const LAS bf16x8*)(buf + RT_K + (ks >> 1) * 2048 + r * 64 + (ks & 1) * 32 + hh * 16); const bf16x8 qv = *(const LAS bf16x8*)(qsl + ks * 1024); X = MFMA32(kf, qv, X); }
            int tcv = 32 * tg + r - 32 * sb - 4 * hh; asm volatile("" : "+v"(tcv));
#pragma unroll
            for (int i = 0; i < 16; ++i) { const int dt = tcv - ((i & 3) + 8 * (i >> 2)); X[i] *= __builtin_amdgcn_exp2f((float)(dt < 0 ? -dt : dt) * l2g); }
            bf16x8 pa[2];
#pragma unroll
            for (int s2 = 0; s2 < 2; ++s2) { v4u p; p[0] = cvtpk2(X[8 * s2], X[8 * s2 + 1]); p[1] = cvtpk2(X[8 * s2 + 2], X[8 * s2 + 3]); p[2] = cvtpk2(X[8 * s2 + 4], X[8 * s2 + 5]); p[3] = cvtpk2(X[8 * s2 + 6], X[8 * s2 + 7]);
                pa[s2] = __builtin_bit_cast(bf16x8, p); }
#pragma unroll
            for (int c4 = 0; c4 < 4; ++c4) {
                s16x4 lo[2][2], hi[2][2];
#pragma unroll
                for (int q = 0; q < 2; ++q)
#pragma unroll
                    for (int s2 = 0; s2 < 2; ++s2) tr_issue(lo[q][s2], hi[q][s2], buf + RT_V + (2 * c4 + q) * 2048 + s2 * 1024 + lane_off);
                asm volatile("s_waitcnt lgkmcnt(0)" : "+v"(lo[0][0]), "+v"(hi[0][0]), "+v"(lo[0][1]), "+v"(hi[0][1]), "+v"(lo[1][0]), "+v"(hi[1][0]), "+v"(lo[1][1]), "+v"(hi[1][1]) :: "memory");
#pragma unroll
                for (int q = 0; q < 2; ++q)
#pragma unroll
                    for (int s2 = 0; s2 < 2; ++s2) acc[2 * c4 + q] = MFMA32(pa[s2], TR_JOIN(lo[q][s2], hi[q][s2]), acc[2 * c4 + q]);
            }
        }
    }
    RT_STAMP(3);
    __syncthreads();
    RT_STAMP(4);
    bf16* ogp = Rp + (size_t)(hd * 8) * 8192 + (32 * tg + (lane >> 2)) * 32 + (lane & 3) * 8;
    v4u ogv[16];
#pragma unroll
    for (int i = 0; i < 16; ++i) ogv[i] = *(const GAS v4u*)(ogp + (size_t)(i >> 1) * 8192 + (i & 1) * 512);
    float gw8[8];
#pragma unroll
    for (int c8 = 0; c8 < 8; ++c8) gw8[c8] = F.ret_gn_w[hd * DV + 32 * c8 + r];
    LAS unsigned char* stg = F.lds + w * (32 * RC_STG);
    LAS unsigned char* stgl = stg + 4 * hh * RC_STG + 2 * r;
#pragma unroll
    for (int i = 0; i < 16; ++i) {
        float s = 0.f;
#pragma unroll
        for (int c8 = 0; c8 < 8; ++c8) s += acc[c8][i];
        s = half_sum32(s);
        const float mu = s * (1.0f / DV); float q = 0.f;
#pragma unroll
        for (int c8 = 0; c8 < 8; ++c8) { const float d = acc[c8][i] - mu; q += d * d; }
        q = half_sum32(q);
        const float rs = 1.0f / sqrtf(q * (1.0f / DV) + EPS);
        LAS unsigned short* srow = (LAS unsigned short*)(stgl + ((i & 3) + 8 * (i >> 2)) * RC_STG);
#pragma unroll
        for (int c8 = 0; c8 < 8; ++c8) srow[32 * c8] = (unsigned short)(cvtpk2((acc[c8][i] - mu) * rs * gw8[c8], 0.f) & 0xffffu);
    }
    RT_STAMP(5);
    LDS_WAIT(); asm volatile("" ::: "memory");
    LAS unsigned char* yp = stg + (lane >> 2) * RC_STG + (lane & 3) * 16;
#pragma unroll
    for (int i = 0; i < 16; ++i) {
        const v4u y = *(const LAS v4u*)(yp + (i & 1) * (16 * RC_STG) + (i >> 1) * 64); const v4u og = ogv[i]; v4u o;
#pragma unroll
        for (int j = 0; j < 4; ++j) o[j] = cvtpk2(pg8::bflo(y[j]) * pg8::bflo(og[j]), pg8::bfhi(y[j]) * pg8::bfhi(og[j]));
        *(GAS v4u*)(ogp + (size_t)(i >> 1) * 8192 + (i & 1) * 512) = o; }
    RT_STAMP(6);
    __syncthreads();
    RT_STAMP(7);
}
__device__ __forceinline__ void p8_final(Frame& F, float* outp) {
    const int lane_ = pg8::lane_id_v(), tid_ = F.wave * 64 + lane_; (void)tid_;
    const float* ssq = (const float*)(F.ws + WS_SSQ3);
    const int gw = F.vcu * NWAVES + F.wave, NGW = F.G * NWAVES;
    f32x4 wv[4];
#pragma unroll
    for (int j = 0; j < 4; ++j) wv[j] = *(const f32x4*)(F.final_norm_w + 4 * lane_ + 256 * j);
    for (int m = gw; m < M; m += NGW) {
        float s = (lane_ < 16) ? ssq[(size_t)m * 16 + lane_] : 0.f; s = wave_sum(s);
        const float rstd = 1.0f / sqrtf(s * (1.0f / D) + EPS);
        const GAS f32x4* xr = (const GAS f32x4*)(F.out + (size_t)m * D) + lane_; GAS f32x4* xo = (GAS f32x4*)(outp + (size_t)m * D) + lane_;
#pragma unroll
        for (int j = 0; j < 4; ++j) { const f32x4 v = xr[64 * j]; xo[64 * j] = v * rstd * wv[j]; }
    }
}

namespace pg8 {
struct EpiRes2Norm {
    static constexpr int EPI_ID = 6;
    static constexpr bool PERM = true, AFTER_DRAIN = true, HAS_MID = false;
    const bf16_t* hhat; float* out; const float* modf; const float* wf; float* ssq; unsigned* cnt; unsigned* tmo; bool same_l2; const float* norm2w;
    __device__ __forceinline__ void mid(f32x4 (&)[2][2][4][2], const Unit&, int, int, int, int) const {}
    __device__ __forceinline__ void fused(f32x4 (&acc)[2][2][4][2], const Unit& u, int wr, int wc, int fr_, int fq_, PG8_LAS unsigned char* lds, int wid, int lane) const {
        int fr = fr_, fq = fq_; asm volatile("" : "+v"(fr), "+v"(fq));
        const int rl0 = wr * 64 + fr, row0 = u.pm * BM + rl0, col0 = u.pn * BM + wc * 32 + 8 * fq, b = u.pm >> 4;
        PG8_LAS float* P = (PG8_LAS float*)lds;
        { f32x4 g2[2][2];
#pragma unroll
          for (int bj = 0; bj < 2; ++bj)
#pragma unroll
            for (int n = 0; n < 2; ++n) g2[bj][n] = *(const f32x4*)(modf + b * 6144 + 5120 + col0 + bj * HALF + 4 * n);
          u32x4 hw[2][4][2];
#pragma unroll
          for (int ai = 0; ai < 2; ++ai)
#pragma unroll
            for (int m = 0; m < 4; ++m)
#pragma unroll
                for (int bj = 0; bj < 2; ++bj) hw[ai][m][bj] = *(const u32x4*)(hhat + (size_t)u.pm * 262144 + (size_t)(u.pn * 8 + wc + 4 * bj) * 8192 + (size_t)(rl0 + ai * HALF + m * 16) * 32 + 8 * fq);
          f32x4 ic[2][2];
#pragma unroll
          for (int bj = 0; bj < 2; ++bj)
#pragma unroll
            for (int n = 0; n < 2; ++n) { const int c = col0 + bj * HALF + 4 * n; const f32x4 sc = *(const f32x4*)(modf + b * 6144 + 4096 + c), w = *(const f32x4*)(norm2w + c);
#pragma unroll
                for (int e = 0; e < 4; ++e) { const float cs = w[e] * (sc[e] + 1.0f); ic[bj][n][e] = fabsf(cs) > 1e-30f ? 1.0f / cs : 0.f; } }
          __builtin_amdgcn_sched_barrier(0);
#pragma unroll
          for (int ai = 0; ai < 2; ++ai)
#pragma unroll
            for (int m = 0; m < 4; ++m) { float q = 0.f;
#pragma unroll
                for (int bj = 0; bj < 2; ++bj) { const u32x4 w = hw[ai][m][bj]; const f32x4 x0 = (f32x4){bflo(w[0]), bfhi(w[0]), bflo(w[1]), bfhi(w[1])} * ic[bj][0], x1 = (f32x4){bflo(w[2]), bfhi(w[2]), bflo(w[3]), bfhi(w[3])} * ic[bj][1];
                    const f32x4 h0 = x0 + g2[bj][0] * acc[ai][bj][m][0], hb = x1 + g2[bj][1] * acc[ai][bj][m][1];
                    acc[ai][bj][m][0] = h0; acc[ai][bj][m][1] = hb;
                    q += (h0[0] * h0[0] + h0[1] * h0[1]) + (h0[2] * h0[2] + h0[3] * h0[3]) + (hb[0] * hb[0] + hb[1] * hb[1]) + (hb[2] * hb[2] + hb[3] * hb[3]); }
                q += __shfl_xor(q, 16); q += __shfl_xor(q, 32);
                if (fq == 0) P[(rl0 + ai * HALF + m * 16) * 4 + wc] = q; } }
        asm volatile("s_waitcnt lgkmcnt(0)" ::: "memory"); __builtin_amdgcn_s_barrier(); asm volatile("" ::: "memory");
        { const int t = wid * 64 + lane; if (t < 256) { const f32x4 p = *(const PG8_LAS f32x4*)(P + t * 4); ssq[(size_t)(u.pm * BM + t) * 4 + u.pn] = (p[0] + p[1]) + (p[2] + p[3]); } }
        group_sync(cnt, 4u, tmo, wid, same_l2);
        f32x4 wv[2][2];
#pragma unroll
        for (int bj = 0; bj < 2; ++bj)
#pragma unroll
            for (int n = 0; n < 2; ++n) wv[bj][n] = *(const f32x4*)(wf + col0 + bj * HALF + 4 * n);
        f32x4 pv[2][4];
#pragma unroll
        for (int ai = 0; ai < 2; ++ai)
#pragma unroll
            for (int m = 0; m < 4; ++m) pv[ai][m] = *(const f32x4*)(ssq + (size_t)(row0 + ai * HALF + m * 16) * 4);
        __builtin_amdgcn_sched_barrier(0);
#pragma unroll
        for (int ai = 0; ai < 2; ++ai)
#pragma unroll
            for (int m = 0; m < 4; ++m) { const int row = row0 + ai * HALF + m * 16; const f32x4 p = pv[ai][m];
                const float rs = 1.0f / sqrtf(((p[0] + p[1]) + (p[2] + p[3])) * (1.0f / 1024.0f) + 1e-6f); const size_t off = (size_t)row * 1024 + col0;
#pragma unroll
                for (int bj = 0; bj < 2; ++bj) { *(f32x4*)(out + off + bj * HALF) = acc[ai][bj][m][0] * rs * wv[bj][0]; *(f32x4*)(out + off + bj * HALF + 4) = acc[ai][bj][m][1] * rs * wv[bj][1]; } }
    }
};
}

#ifndef FF1_ALIGN
#define FF1_ALIGN true
#endif
#ifndef G1_ALIGN
#define G1_ALIGN true
#endif
#ifndef G1_SP2
#define G1_SP2 true
#endif
#ifndef NOWB_BH
#define NOWB_BH true
#endif
constexpr int N_PHASES = 10;
struct Args { const void* in[16]; float* out; unsigned char* ws; int ph_lo, ph_hi, use_bar, pad; };
__global__ void __launch_bounds__(NWAVES * 64, 2) hyb_fwd(Args args) {
    extern __shared__ __attribute__((aligned(16))) unsigned char lds[];
    Frame F;
    F.lds = (LAS unsigned char*)lds; F.MISC = (volatile LAS unsigned*)(F.lds + MISC_OFF);
    F.wave = __builtin_amdgcn_readfirstlane((int)threadIdx.x >> 6);
    F.G = gridDim.x; { const int bx = blockIdx.x; F.vcu = (F.G % 8 == 0) ? (bx % 8) * (F.G / 8) + bx / 8 : bx; }
    F.ws = args.ws; F.out = args.out; F.ctl = (gu32*)(args.ws + WS_CTL);
    F.x = (const float*)args.in[0]; F.c = (const float*)args.in[1]; F.positions = (const int*)args.in[2]; F.w_ada = (const float*)args.in[3]; F.b_ada = (const float*)args.in[4];
    F.norm1_w = (const float*)args.in[5]; F.w_in = (const float*)args.in[6]; F.ret_gn_w = (const float*)args.in[7]; F.conv_w = (const float*)args.in[8]; F.w_ret_out = (const float*)args.in[9];
    F.w_conv_out = (const float*)args.in[10]; F.w_o = (const float*)args.in[11]; F.norm2_w = (const float*)args.in[12]; F.w_ff1 = (const float*)args.in[13]; F.w_ff2 = (const float*)args.in[14];
    F.final_norm_w = (const float*)args.in[15];
    for (int u = F.wave * 64 + pg8::lane_id_v(); u < (LDS_BYTES - LDSCTL_OFF) / 4; u += NWAVES * 64) ((LAS unsigned*)(F.lds + LDSCTL_OFF))[u] = 0u;
    __syncthreads();
    XcdBarrier bar; bar.bar = (unsigned*)(F.ctl + CW_BAR); bar.x = 0; bar.st = nullptr;
#ifdef PH_MAXP0
    if (args.use_bar) bar = xcd_barrier_post((unsigned*)(F.ctl + CW_BAR), F.MISC + 8, F.wave);
#endif
    if (F.wave == 0 && pg8::lane_id_v() == 0) __hip_atomic_store((unsigned*)(F.ctl + CW_XCC + blockIdx.x), xb_xcc_id() + 1u, __ATOMIC_RELAXED, __HIP_MEMORY_SCOPE_AGENT);
    const int lo = args.ph_lo, hi = args.ph_hi;
#ifndef PH_MASK
#define PH_MASK 0x7ff
#endif
#define IN(k) (((PH_MASK >> (k)) & 1) && lo <= (k) && (k) < hi)
#ifndef PH_TWICE
#define PH_TWICE 0
#endif
#define REP(k) for (int rep_ = 0; rep_ < (((PH_TWICE >> (k)) & 1) ? 2 : 1); ++rep_)
#ifdef PH_TA
    unsigned long long ta_ = __builtin_amdgcn_s_memrealtime(), tb_ = ta_;
#define STAMP(id) do { if ((id) == PH_TA) ta_ = __builtin_amdgcn_s_memrealtime(); if ((id) == PH_TB) tb_ = __builtin_amdgcn_s_memrealtime(); } while (0)
#else
#define STAMP(id) do { } while (0)
#endif
#ifdef PH_XSYNC
#define GSYNC(stage) group_sync((unsigned*)(F.ctl + CW_GRP + ((stage) * 64 + 32 + (int)(blockIdx.x & 7)) * 64), 32u, (unsigned*)(F.ctl + CW_BAR + XB_TMO), F.wave)
#else
#define GSYNC(stage) group_sync((unsigned*)(F.ctl + CW_GRP + ((stage) * 64 + gpm_) * 64), 4u, (unsigned*)(F.ctl + CW_BAR + XB_TMO), F.wave, samex_)
#endif
#define SEAM(k) do { STAMP(2 * (k)); if (IN(k) && IN((k) + 1)) xcd_barrier(bar, F.wave); STAMP(2 * (k) + 1); } while (0)
    unsigned char* ws = args.ws;
    bf16* U = (bf16*)((unsigned char*)args.out + OUT_U);

    int gpm_ = 0, gpn_ = 0; { pg8::StaticOrder S; S.init(M, D, F.G, (int)blockIdx.x); pg8::Unit u0; if (S.next(0, u0)) { gpm_ = u0.pm; gpn_ = u0.pn; } }
#ifdef PH_MAXP0
    const unsigned long long tk0_ = __builtin_amdgcn_s_memrealtime();
    if (IN(0)) { p0_prologue(F); }
    if (F.wave == 0 && pg8::lane_id_v() == 0) __hip_atomic_store((unsigned*)(F.ctl + 16384 + blockIdx.x), (unsigned)(__builtin_amdgcn_s_memrealtime() - tk0_), __ATOMIC_RELAXED, __HIP_MEMORY_SCOPE_AGENT);
    SEAM(0);
    unsigned mx_ = 0, amx_ = 0;
    if (blockIdx.x == 0 && F.wave == 0) { for (int i = 0; i < (int)gridDim.x; ++i) { const unsigned v = __hip_atomic_load((unsigned*)(F.ctl + 16384 + i), __ATOMIC_RELAXED, __HIP_MEMORY_SCOPE_AGENT); if (v > mx_) { mx_ = v; amx_ = i; } } }
#else
    if (IN(0)) REP(0) { p0_prologue(F); } STAMP(0); STAMP(1);
#endif
    if (IN(1)) REP(1) { p1_unorm(F, 4 * gpm_ + gpn_); }
    bool samex_ = false;
#ifndef NO_SAMEL2
    { unsigned x0 = 0u, same = 1u;
#pragma unroll
      for (int j = 0; j < 4; ++j) { const unsigned v = __hip_atomic_load((unsigned*)(F.ctl + CW_XCC + (blockIdx.x & 63) + 64 * j), __ATOMIC_RELAXED, __HIP_MEMORY_SCOPE_AGENT); if (j == 0) x0 = v; same &= (v != 0u && v == x0) ? 1u : 0u; }
      samex_ = __builtin_amdgcn_readfirstlane((int)same) != 0; }
#endif
    if (IN(1) && IN(2)) {
        unsigned* cnt8_ = (unsigned*)(F.ctl + CW_GRP + (8 * 64 + gpm_) * 64); unsigned* tmo_ = (unsigned*)(F.ctl + CW_BAR + XB_TMO);
        asm volatile("s_waitcnt vmcnt(0)" ::: "memory"); __syncthreads();
        if (F.wave == 0 && pg8::lane_id_v() == 0) {
            if (!samex_) __builtin_amdgcn_fence(__ATOMIC_RELEASE, "agent");
            asm volatile("s_waitcnt vmcnt(0)" ::: "memory");
            (void)xb_add((unsigned*)(F.ctl + CW_P1), 1u); (void)xb_add(cnt8_, 1u);
            unsigned sp = 0u;
            while (xb_ld(cnt8_) < 4u || xb_ld((unsigned*)(F.ctl + CW_W)) < (unsigned)F.G) { __builtin_amdgcn_s_sleep(1); if ((++sp & 255u) == 0u) { if (xb_ld(tmo_)) break; if (sp > XB_SPIN_CAP) { atomicAdd(tmo_, 1u); break; } } }
            __builtin_amdgcn_fence(__ATOMIC_ACQUIRE, "agent"); asm volatile("s_waitcnt vmcnt(0)" ::: "memory"); }
        __syncthreads();
    }
    if (IN(2)) REP(2) {
        pg8::Gemm g{U, (const bf16*)(ws + WS_WIN), M, NPROJ, D, (size_t)256 * D * 2, 64, 32768, 32}; pg8::OrderG1 S; S.init(M, NPROJ, F.G, (int)blockIdx.x);
        pg8::EpiProj E{(bf16*)(ws + WS_QK), (bf16*)(ws + WS_V), (bf16*)(ws + WS_R), (bf16*)((unsigned char*)args.out + OUT_Z), F.positions, (bf16*)(ws + WS_HALO), F.conv_w, (LAS pg8::f32x4*)(F.lds + TAB_OFF), (unsigned*)(F.ctl + CW_GRP + (9 * 64 + gpm_) * 64), (bf16*)(ws + WS_CB01), samex_};
        pg8::gemm_phase<pg8::EpiProj, pg8::OrderG1, G1_ALIGN, G1_SP2>(F.lds + RING_OFF, g, S, E, F.wave);
    } STAMP(4); STAMP(5);
    if (IN(3)) {
        const int bh_ = (gpm_ >> 4) * 4 + gpn_, unit_ = bh_ * 16 + (gpm_ & 15); unsigned* tmo_ = (unsigned*)(F.ctl + CW_BAR + XB_TMO);
        group_sync((unsigned*)(F.ctl + CW_GRP + (6 * 64 + gpm_) * 64), 4u, tmo_, F.wave, samex_, (unsigned*)(F.ctl + CW_P1), (unsigned)F.G);
        REP(3) { p3a_kvsum(F, unit_); } STAMP(30);
        unsigned* cntA_ = (unsigned*)(F.ctl + CW_GRP + (4 * 64 + bh_) * 64);
        asm volatile("s_waitcnt vmcnt(0)" ::: "memory"); __syncthreads();
        if (F.wave == 0 && pg8::lane_id_v() == 0) (void)xb_add(cntA_, 1u);
        if (gpn_ == 0 && (gpm_ & 15) != 0) {
            if (F.wave == 0 && pg8::lane_id_v() == 0) { unsigned* cp = (unsigned*)(F.ctl + CW_GRP + (6 * 64 + gpm_ - 1) * 64); unsigned sp = 0u;
                while (xb_ld(cp) < 4u) { __builtin_amdgcn_s_sleep(1); if ((++sp & 255u) == 0u) { if (xb_ld(tmo_)) break; if (sp > XB_SPIN_CAP) { atomicAdd(tmo_, 1u); break; } } }
                __builtin_amdgcn_fence(__ATOMIC_ACQUIRE, "agent"); asm volatile("s_waitcnt vmcnt(0)" ::: "memory"); }
            __syncthreads();
            p3a_convfix(F, gpm_); }
        STAMP(31);
        REP(11) { p3a_bias2(F); }
        STAMP(6);
        asm volatile("s_waitcnt vmcnt(0)" ::: "memory"); __syncthreads();
        if (F.wave == 0 && pg8::lane_id_v() == 0) { unsigned sp = 0u; (void)xb_add((unsigned*)(F.ctl + CW_WAR), 1u);
            while (xb_ld(cntA_) < 16u) { __builtin_amdgcn_s_sleep(1); if ((++sp & 255u) == 0u) { if (xb_ld(tmo_)) break; if (sp > XB_SPIN_CAP) { atomicAdd(tmo_, 1u); break; } } }
            __builtin_amdgcn_fence(__ATOMIC_ACQUIRE, "agent"); asm volatile("s_waitcnt vmcnt(0)" ::: "memory"); }
        __syncthreads(); STAMP(7);
        STAMP(8); STAMP(9);
        p3c_retout(F, unit_, (bf16*)(ws + WS_R), false, (unsigned*)(F.ctl + CW_GRP + (5 * 64 + bh_) * 64), tmo_, NOWB_BH);
        STAMP(10); GSYNC(7); STAMP(11);
    }
#ifdef PH_STAG
    if (IN(6)) { const unsigned long long t0s_ = __builtin_amdgcn_s_memrealtime(), ds_ = (unsigned long long)((gpm_ % PH_STAG_S) * PH_STAG); while (__builtin_amdgcn_s_memrealtime() - t0s_ < ds_) __builtin_amdgcn_s_sleep(4); }
#endif
    if (IN(6)) REP(6) {
        pg8::Gemm g{(const bf16*)(ws + WS_R), (const bf16*)(ws + WS_WRC), M, D, 2 * D, (size_t)2 * MiB, 32, 32768, 8192};     pg8::StaticOrder S; S.init(M, D, F.G, (int)blockIdx.x);
        pg8::EpiMerge E{(const bf16*)(ws + WS_R), (bf16*)(ws + WS_MERGED)};
        pg8::gemm_phase<pg8::EpiMerge, pg8::StaticOrder, false, true>(F.lds + RING_OFF, g, S, E, F.wave);
    } if (IN(6) && IN(7)) { STAMP(12); GSYNC(0); STAMP(13); }
    if (IN(7)) { unsigned* tmo_ = (unsigned*)(F.ctl + CW_BAR + XB_TMO);
        if (F.wave == 0 && pg8::lane_id_v() == 0) { unsigned* cw = (unsigned*)(F.ctl + CW_WAR); unsigned sp = 0u;
            while (xb_ld(cw) < (unsigned)F.G) { __builtin_amdgcn_s_sleep(1); if ((++sp & 255u) == 0u) { if (xb_ld(tmo_)) break; if (sp > XB_SPIN_CAP) { atomicAdd(tmo_, 1u); break; } } } }
        __syncthreads();
    }
    if (IN(7)) REP(7) {
        pg8::Gemm g{(const bf16*)(ws + WS_MERGED), (const bf16*)(ws + WS_WO), M, D, D, (size_t)256 * D * 2, 32, 32768, 8192}; pg8::StaticOrder S; S.init(M, D, F.G, (int)blockIdx.x);
        pg8::EpiRes1 E{F.x, (bf16*)args.out, (bf16*)(ws + WS_HHAT), (const float*)(ws + WS_MODF), F.norm2_w, (float*)(ws + WS_SSQ2)};
        pg8::gemm_phase<pg8::EpiRes1, pg8::StaticOrder, false, true>(F.lds + RING_OFF, g, S, E, F.wave);
    } if (IN(7) && IN(8)) { STAMP(14); GSYNC(1); STAMP(15); }
    if (IN(8)) REP(8) {
        pg8::Gemm g{(const bf16*)(ws + WS_HHAT), (const bf16*)(ws + WS_W1), M, FF, D, (size_t)256 * D * 2, 32, 32768, 8192}; pg8::StaticOrder S; S.init(M, FF, F.G, (int)blockIdx.x);
        pg8::Unit u0; LAS float* tab = (LAS float*)(F.lds + TAB_OFF); const int tid_ = F.wave * 64 + pg8::lane_id_v();
        if (S.next(0, u0)) { if (tid_ < 256) { const float* sq = (const float*)(ws + WS_SSQ2) + (size_t)(u0.pm * 256 + tid_) * 16; const f32x4 a = *(const f32x4*)sq, b = *(const f32x4*)(sq + 4), c = *(const f32x4*)(sq + 8), d = *(const f32x4*)(sq + 12);
            const float s = ((a[0] + a[1]) + (a[2] + a[3])) + ((b[0] + b[1]) + (b[2] + b[3])) + ((c[0] + c[1]) + (c[2] + c[3])) + ((d[0] + d[1]) + (d[2] + d[3]));
            tab[tid_] = 1.0f / sqrtf(s * (1.0f / D) + EPS); } }
        __syncthreads();
        pg8::EpiFF1 E{(const float*)(ws + WS_BIAS2), (const LAS float*)tab, (bf16*)(ws + WS_HID)};
        pg8::gemm_phase<pg8::EpiFF1, pg8::StaticOrder, FF1_ALIGN, true>(F.lds + RING_OFF, g, S, E, F.wave);
    } if (IN(8) && IN(9)) { STAMP(16); GSYNC(2); STAMP(17); }
    if (IN(9)) {
        pg8::Gemm g{(const bf16*)(ws + WS_HID), (const bf16*)(ws + WS_W2), M, D, FF, (size_t)256 * FF * 2, 32, 32768, 8192};     pg8::StaticOrder S; S.init(M, D, F.G, (int)blockIdx.x);
        pg8::EpiRes2Norm E{(const bf16*)(ws + WS_HHAT), args.out, (const float*)(ws + WS_MODF), F.final_norm_w, (float*)(ws + WS_SSQ3), (unsigned*)(F.ctl + CW_GRP + (3 * 64 + gpm_) * 64), (unsigned*)(F.ctl + CW_BAR + XB_TMO), samex_, F.norm2_w};
        pg8::gemm_phase<pg8::EpiRes2Norm, pg8::StaticOrder, false, true>(F.lds + RING_OFF, g, S, E, F.wave);
    }
    STAMP(18); STAMP(19);
#ifdef PH_MAXP0
    if (blockIdx.x == 0 && F.wave == 0) { const unsigned long long te = __builtin_amdgcn_s_memrealtime(), d = (PH_MAXP0 == 1) ? (unsigned long long)mx_ * 4ull : (unsigned long long)amx_ * 100ull; while (__builtin_amdgcn_s_memrealtime() - te < d) __builtin_amdgcn_s_sleep(8); }
#endif
#if defined(PH_TA) && (defined(PH_GEMMPROBE) || defined(PH_RTPROBE))
    __syncthreads();
    if (PH_TA >= 40) ta_ = *(LAS unsigned long long*)(F.lds + 139264 + 2048 + 8 * (PH_TA - 40));
    if (PH_TB >= 40) tb_ = *(LAS unsigned long long*)(F.lds + 139264 + 2048 + 8 * (PH_TB - 40));
#endif
#ifdef PH_TA
    STAMP(20); STAMP(21);
    if ((int)blockIdx.x == PH_BLK && F.wave == 0) { const unsigned long long te = __builtin_amdgcn_s_memrealtime(), d = (tb_ - ta_) * 4ull; while (__builtin_amdgcn_s_memrealtime() - te < d) __builtin_amdgcn_s_sleep(8); }
#endif
#undef IN
#undef SEAM
}

#ifndef HYB_N_LAUNCHES
#define HYB_N_LAUNCHES 1
#endif
extern "C" void kernel_launch(void* const* d_in, const int* in_sizes, int n_in, void* d_out, int out_size, void* d_ws, size_t ws_size, hipStream_t stream) {
    static int grid = 0;
    if (grid == 0) {
        if (n_in != 16 || in_sizes[0] != M * D || out_size != M * D || ws_size < WS_END) { fprintf(stderr, "kernel_launch: unexpected shapes (n_in %d, in0 %d, out %d, ws %zu); nothing launched\n", n_in, n_in > 0 ? in_sizes[0] : -1, out_size, ws_size); grid = -1; return; }
        int dev = 0, cus = 0, per_cu = 0;
        if (hipGetDevice(&dev) != hipSuccess || hipDeviceGetAttribute(&cus, hipDeviceAttributeMultiprocessorCount, dev) != hipSuccess) { grid = -1; return; }
        if (hipFuncSetAttribute((const void*)hyb_fwd, hipFuncAttributeMaxDynamicSharedMemorySize, LDS_BYTES) != hipSuccess) { fprintf(stderr, "kernel_launch: hipFuncSetAttribute failed\n"); grid = -1; return; }
        if (hipOccupancyMaxActiveBlocksPerMultiprocessor(&per_cu, (const void*)hyb_fwd, NWAVES * 64, LDS_BYTES) != hipSuccess || per_cu < 1) { fprintf(stderr, "kernel_launch: occupancy query says %d workgroups per CU; nothing launched\n", per_cu); (void)hipGetLastError(); grid = -1; return; }
        { bool okp = true; pg8::StaticOrder S; for (int c = 0; c < cus && okp; ++c) { S.init(M, FF, cus, c); pg8::Unit u0, u; if (!S.next(0, u0)) continue; for (int i = 1; S.next(i, u); ++i) okp = okp && (u.pm == u0.pm); }
          if (!okp) { fprintf(stderr, "kernel_launch: FF1's unit order does not keep a workgroup inside one row panel on %d CUs; nothing launched\n", cus); grid = -1; return; } }
        { bool okp = true; pg8::StaticOrder S1, S4; for (int c = 0; c < cus && okp; ++c) { S1.init(M, D, cus, c); S4.init(M, FF, cus, c); pg8::Unit a, b2; okp = S1.next(0, a) && S4.next(0, b2) && a.pm == b2.pm && !S1.next(1, b2); if (okp) { pg8::StaticOrder Sm; pg8::Unit am; Sm.init(M, D, cus, c & 63); okp = Sm.next(0, am) && am.pm == a.pm && a.pn == (c >> 6); } }
          if (!okp || cus != 256) { fprintf(stderr, "kernel_launch: the row-panel chain needs 256 CUs with one N=1024 unit each in the panel of their FF1 units; nothing launched\n"); grid = -1; return; } }
        grid = cus;
        if (grid != 256) fprintf(stderr, "kernel_launch: %d CUs (built for 256)\n", grid);
    }
    if (grid < 0) return;
    (void)hipMemsetAsync((char*)d_ws + WS_CTL, 0, CTL_ZERO_BYTES, stream);
    Args a{};
    for (int i = 0; i < 16; ++i) a.in[i] = d_in[i];
    a.out = (float*)d_out; a.ws = (unsigned char*)d_ws;
#if HYB_N_LAUNCHES == 1
    a.ph_lo = 0; a.ph_hi = N_PHASES; a.use_bar = 1;
    hipLaunchKernelGGL(hyb_fwd, dim3(grid), dim3(NWAVES * 64), LDS_BYTES, stream, a);
#ifdef PH_WHOLE2
    (void)hipMemsetAsync((char*)d_ws + WS_CTL, 0, CTL_ZERO_BYTES, stream);
    hipLaunchKernelGGL(hyb_fwd, dim3(grid), dim3(NWAVES * 64), LDS_BYTES, stream, a);
#endif
#else
    for (int p = 0; p < N_PHASES; ++p) { a.ph_lo = p; a.ph_hi = p + 1; a.use_bar = 0; hipLaunchKernelGGL(hyb_fwd, dim3(grid), dim3(NWAVES * 64), LDS_BYTES, stream, a); }
#endif
}
```
